# Optimizing an MI355X kernel written in HIP

```python
import math, functools
import jax, jax.numpy as jnp
from jax import lax
import numpy as np

D_MODEL = 1024
BATCH = 8
SEQ = 2048
DEPTH = 1
DEC_BATCH = 128
DEC_SEQ = 4
PAST_LEN = 8192
PAGE_SIZE = 128

D_SSM = 512
SSM_GROUP = 16
N_GROUPS = D_SSM // SSM_GROUP
STATE_DIM = 64
N_HEADS = 8
N_KV = 2
HEAD_DIM = 64
Q_GROUP = N_HEADS // N_KV
D_ATTN = N_HEADS * HEAD_DIM
KV_DIM = N_KV * HEAD_DIM
WINDOW = 128
BLOCK = WINDOW
D_FF = 2816
CONV_W = 3
LN_EPS = 1e-5
ALPHA = (2 * DEPTH) ** 0.25
BETA = (8 * DEPTH) ** -0.25
D_IN = D_SSM + D_ATTN + 2 * KV_DIM + 2 * D_MODEL
SPLITS = [D_SSM, D_SSM + D_ATTN, D_SSM + D_ATTN + KV_DIM, D_SSM + D_ATTN + 2 * KV_DIM, D_SSM + D_ATTN + 2 * KV_DIM + D_MODEL]

kernel_name = 'hybrid_s5_swa_sink_convglu_deepnorm_step'


def layer_norm(x, g, b):
    xf = x.astype(jnp.float32)
    mu = jnp.mean(xf, -1, keepdims=True)
    var = jnp.mean(jnp.square(xf - mu), -1, keepdims=True)
    return ((xf - mu) * lax.rsqrt(var + LN_EPS) * g + b).astype(x.dtype)


def sink_attend(q, k, v, mask, sinks):
    s = jnp.einsum('...qkgd,...skd->...kgqs', q, k).astype(jnp.float32) * (HEAD_DIM ** -0.5)
    s = jnp.where(mask, s, -jnp.inf)
    sink = sinks.astype(jnp.float32).reshape(N_KV, Q_GROUP, 1, 1)
    m = jnp.maximum(jnp.max(s, -1, keepdims=True), sink)
    p = jnp.exp(s - m)
    p = (p / (jnp.sum(p, -1, keepdims=True) + jnp.exp(sink - m))).astype(v.dtype)
    return jnp.einsum('...kgqs,...skd->...qkgd', p, v)


def window_attn_prompt(q, k, v, sinks):
    B, L = q.shape[:2]
    nb = L // BLOCK
    qb = q.reshape(B, nb, BLOCK, N_KV, Q_GROUP, HEAD_DIM)

    def band(t):
        tb = t.reshape(B, nb, BLOCK, N_KV, HEAD_DIM)
        prev = jnp.pad(tb, ((0, 0), (1, 0), (0, 0), (0, 0), (0, 0)))[:, :-1]
        return jnp.concatenate([prev, tb], axis=2)

    kb, vb = band(k), band(v)
    qi = jnp.arange(BLOCK)[:, None]
    sj = jnp.arange(2 * BLOCK)[None, :]
    rel = qi + BLOCK - sj
    local = (rel >= 0) & (rel < WINDOW)
    has_prev = (jnp.arange(nb) > 0)[:, None, None] | (sj >= BLOCK)[None]
    mask = (local[None] & has_prev)[:, None, None]
    o = sink_attend(qb, kb, vb, mask, sinks)
    return o.reshape(B, L, D_ATTN), k[:, -WINDOW:], v[:, -WINDOW:]


def window_attn_sample(q, k, v, sinks, k_cache, v_cache):
    B, T = q.shape[:2]
    W = k_cache.shape[1]
    kk = jnp.concatenate([k_cache.astype(k.dtype), k], axis=1)
    vv = jnp.concatenate([v_cache.astype(v.dtype), v], axis=1)
    qpos = jnp.arange(T)[:, None]
    kpos = jnp.arange(W + T)[None, :] - W
    mask = (kpos <= qpos) & (qpos - kpos < WINDOW)
    o = sink_attend(q, kk, vv, mask, sinks)
    return o.reshape(B, T, D_ATTN), kk[:, -W:], vv[:, -W:]


def s5_scan(u, h0_re, h0_im, lam_re, lam_im, log_dt, b_re, b_im, c_re, c_im, d_skip):
    f32 = jnp.float32
    Bsz, L, _ = u.shape
    uf = u.astype(f32)
    lr, li = lam_re.astype(f32), lam_im.astype(f32)
    dt = jnp.exp(log_dt.astype(f32))[:, None]
    mag = jnp.exp(lr * dt)
    ang = li * dt
    ab_re, ab_im = mag * jnp.cos(ang), mag * jnp.sin(ang)
    den = lr * lr + li * li
    nr = ab_re - 1.0
    coef_re = (nr * lr + ab_im * li) / den
    coef_im = (ab_im * lr - nr * li) / den
    br, bi = b_re.astype(f32), b_im.astype(f32)
    bb_re = coef_re[..., None] * br - coef_im[..., None] * bi
    bb_im = coef_re[..., None] * bi + coef_im[..., None] * br
    ug = uf.reshape(Bsz, L, N_GROUPS, SSM_GROUP)
    x_re = jnp.einsum('blgc,gpc->blgp', ug, bb_re)
    x_im = jnp.einsum('blgc,gpc->blgp', ug, bb_im)
    h_re, h_im = h0_re.astype(f32), h0_im.astype(f32)
    x_re = x_re.at[:, 0].add(ab_re * h_re - ab_im * h_im)
    x_im = x_im.at[:, 0].add(ab_re * h_im + ab_im * h_re)
    a_re = jnp.broadcast_to(ab_re, x_re.shape)
    a_im = jnp.broadcast_to(ab_im, x_im.shape)

    def combine(l, r):
        ar1, ai1, br1, bi1 = l
        ar2, ai2, br2, bi2 = r
        return (ar1 * ar2 - ai1 * ai2, ar1 * ai2 + ai1 * ar2,
                ar2 * br1 - ai2 * bi1 + br2, ar2 * bi1 + ai2 * br1 + bi2)

    _, _, s_re, s_im = lax.associative_scan(combine, (a_re, a_im, x_re, x_im), axis=1)
    y = (jnp.einsum('blgp,gcp->blgc', s_re, c_re.astype(f32))
         - jnp.einsum('blgp,gcp->blgc', s_im, c_im.astype(f32)))
    y = y.reshape(Bsz, L, D_SSM) + d_skip.astype(f32) * uf
    return y.astype(u.dtype), s_re[:, -1], s_im[:, -1]


def conv_glu_ffn(x, conv_state, w_up, conv_w, conv_b, w_down):
    L = x.shape[1]
    a, g = jnp.split(x @ w_up, 2, axis=-1)
    ext = jnp.concatenate([conv_state.astype(a.dtype), a], axis=1)
    conv = conv_b
    for j in range(CONV_W):
        conv = conv + ext[:, j:j + L] * conv_w[j]
    h = jax.nn.gelu(conv) * g
    return h @ w_down, ext[:, -(CONV_W - 1):]


def hybrid_layer(x, attn_fn, h_re, h_im, conv_state, lp):
    Bsz, L, _ = x.shape
    u, q, k, v, g_s, g_a = jnp.split(x @ lp['w_in'], SPLITS, axis=-1)
    y, h_re_new, h_im_new = s5_scan(u, h_re, h_im, lp['lam_re'], lp['lam_im'], lp['log_dt'],
                                    lp['b_re'], lp['b_im'], lp['c_re'], lp['c_im'], lp['d'])
    ya, yb = jnp.split(jax.nn.gelu(y) @ lp['w_glu'], 2, axis=-1)
    branch_s = ya * jax.nn.sigmoid(yb)
    q = q.reshape(Bsz, L, N_KV, Q_GROUP, HEAD_DIM)
    k = k.reshape(Bsz, L, N_KV, HEAD_DIM)
    v = v.reshape(Bsz, L, N_KV, HEAD_DIM)
    o, k_new, v_new = attn_fn(q, k, v, lp['sinks'])
    branch_a = o @ lp['w_attn_br']
    merged = jax.nn.sigmoid(g_s) * branch_s + jax.nn.sigmoid(g_a) * branch_a
    x = layer_norm(ALPHA * x + merged @ lp['w_o'], lp['ln1_g'], lp['ln1_b'])
    f, conv_new = conv_glu_ffn(x, conv_state, lp['w_up'], lp['conv_w'], lp['conv_b'], lp['w_down'])
    x = layer_norm(ALPHA * x + f, lp['ln2_g'], lp['ln2_b'])
    return x, k_new, v_new, h_re_new, h_im_new, conv_new


def setup_inputs(seed: int = 0) -> dict:
    key = jax.random.key(seed)
    ks = jax.random.split(key, 32)
    f32 = jnp.float32

    def nrm(k, shape, scale):
        return jax.random.normal(k, shape, f32) * scale

    win = min(WINDOW, PAST_LEN)
    pidx = jnp.arange(STATE_DIM, dtype=f32)
    return {
        'x_prompt': nrm(ks[0], (BATCH, SEQ, D_MODEL), 1.0),
        'x_sample': nrm(ks[1], (DEC_BATCH, DEC_SEQ, D_MODEL), 1.0),
        'cache_k_win': nrm(ks[2], (DEPTH, DEC_BATCH, win, N_KV, HEAD_DIM), 1.0),
        'cache_v_win': nrm(ks[3], (DEPTH, DEC_BATCH, win, N_KV, HEAD_DIM), 1.0),
        'state_ssm_re': nrm(ks[4], (DEPTH, DEC_BATCH, N_GROUPS, STATE_DIM), 0.1),
        'state_ssm_im': nrm(ks[5], (DEPTH, DEC_BATCH, N_GROUPS, STATE_DIM), 0.1),
        'state_ffn_conv': nrm(ks[6], (DEPTH, DEC_BATCH, CONV_W - 1, D_FF), 1.0),
        'w_in': nrm(ks[7], (DEPTH, D_MODEL, D_IN), D_MODEL ** -0.5),
        'ssm_lam_re': -0.5 * jnp.exp(nrm(ks[8], (DEPTH, N_GROUPS, STATE_DIM), 0.05)),
        'ssm_lam_im': math.pi * pidx + nrm(ks[9], (DEPTH, N_GROUPS, STATE_DIM), 0.05),
        'ssm_log_dt': jax.random.uniform(ks[10], (DEPTH, N_GROUPS), f32, math.log(1e-3), math.log(1e-1)),
        'ssm_b_re': nrm(ks[11], (DEPTH, N_GROUPS, STATE_DIM, SSM_GROUP), (2 * SSM_GROUP) ** -0.5),
        'ssm_b_im': nrm(ks[12], (DEPTH, N_GROUPS, STATE_DIM, SSM_GROUP), (2 * SSM_GROUP) ** -0.5),
        'ssm_c_re': nrm(ks[13], (DEPTH, N_GROUPS, SSM_GROUP, STATE_DIM), (2 * STATE_DIM) ** -0.5),
        'ssm_c_im': nrm(ks[14], (DEPTH, N_GROUPS, SSM_GROUP, STATE_DIM), (2 * STATE_DIM) ** -0.5),
        'ssm_d': nrm(ks[15], (DEPTH, D_SSM), 1.0),
        'w_glu': nrm(ks[16], (DEPTH, D_SSM, 2 * D_MODEL), D_SSM ** -0.5),
        'attn_sinks': nrm(ks[17], (DEPTH, N_HEADS), 0.5),
        'w_attn_br': nrm(ks[18], (DEPTH, D_ATTN, D_MODEL), D_ATTN ** -0.5),
        'w_o': nrm(ks[19], (DEPTH, D_MODEL, D_MODEL), BETA * D_MODEL ** -0.5),
        'ln1_g': 1.0 + nrm(ks[20], (DEPTH, D_MODEL), 0.02),
        'ln1_b': nrm(ks[21], (DEPTH, D_MODEL), 0.02),
        'w_up': nrm(ks[22], (DEPTH, D_MODEL, 2 * D_FF), D_MODEL ** -0.5),
        'conv_w': nrm(ks[23], (DEPTH, CONV_W, D_FF), CONV_W ** -0.5),
        'conv_b': nrm(ks[24], (DEPTH, D_FF), 0.02),
        'w_down': nrm(ks[25], (DEPTH, D_FF, D_MODEL), BETA * D_FF ** -0.5),
        'ln2_g': 1.0 + nrm(ks[26], (DEPTH, D_MODEL), 0.02),
        'ln2_b': nrm(ks[27], (DEPTH, D_MODEL), 0.02),
    }


def reference(x_prompt, x_sample, cache_k_win, cache_v_win, state_ssm_re, state_ssm_im, state_ffn_conv,
              w_in, ssm_lam_re, ssm_lam_im, ssm_log_dt, ssm_b_re, ssm_b_im, ssm_c_re, ssm_c_im, ssm_d,
              w_glu, attn_sinks, w_attn_br, w_o, ln1_g, ln1_b, w_up, conv_w, conv_b, w_down, ln2_g, ln2_b):
    yp, ys = x_prompt, x_sample
    kp_l, vp_l, hrp_l, hip_l, cp_l = [], [], [], [], []
    ks_l, vs_l, hrs_l, his_l, cs_l = [], [], [], [], []
    for i in range(DEPTH):
        lp = {'w_in': w_in[i], 'lam_re': ssm_lam_re[i], 'lam_im': ssm_lam_im[i], 'log_dt': ssm_log_dt[i],
              'b_re': ssm_b_re[i], 'b_im': ssm_b_im[i], 'c_re': ssm_c_re[i], 'c_im': ssm_c_im[i], 'd': ssm_d[i],
              'w_glu': w_glu[i], 'sinks': attn_sinks[i], 'w_attn_br': w_attn_br[i], 'w_o': w_o[i],
              'ln1_g': ln1_g[i], 'ln1_b': ln1_b[i], 'w_up': w_up[i], 'conv_w': conv_w[i], 'conv_b': conv_b[i],
              'w_down': w_down[i], 'ln2_g': ln2_g[i], 'ln2_b': ln2_b[i]}
        h0 = jnp.zeros((yp.shape[0], N_GROUPS, STATE_DIM), jnp.float32)
        c0 = jnp.zeros((yp.shape[0], CONV_W - 1, D_FF), yp.dtype)
        yp, kp, vp, hrp, hip, cp = hybrid_layer(yp, window_attn_prompt, h0, h0, c0, lp)
        attn_s = functools.partial(window_attn_sample, k_cache=cache_k_win[i], v_cache=cache_v_win[i])
        ys, kss, vss, hrs, his, css = hybrid_layer(ys, attn_s, state_ssm_re[i], state_ssm_im[i],
                                                  state_ffn_conv[i], lp)
        kp_l.append(kp); vp_l.append(vp); hrp_l.append(hrp); hip_l.append(hip); cp_l.append(cp)
        ks_l.append(kss); vs_l.append(vss); hrs_l.append(hrs); his_l.append(his); cs_l.append(css)
    return (yp, ys,
            jnp.stack(kp_l), jnp.stack(vp_l), jnp.stack(ks_l), jnp.stack(vs_l),
            jnp.stack(hrp_l), jnp.stack(hip_l), jnp.stack(hrs_l), jnp.stack(his_l),
            jnp.stack(cp_l), jnp.stack(cs_l))
```

```cpp
#include <hip/hip_runtime.h>
#include <hip/hip_cooperative_groups.h>
#include <cstdio>
#include <cstdint>
namespace cg = cooperative_groups;

typedef unsigned short bf16_t;
typedef short bf16x8 __attribute__((ext_vector_type(8)));
typedef short bf16x4 __attribute__((ext_vector_type(4)));
typedef float f32x4 __attribute__((ext_vector_type(4)));
typedef unsigned u32x2 __attribute__((ext_vector_type(2)));
typedef unsigned u32x4 __attribute__((ext_vector_type(4)));

constexpr int MP = 16384, MS = 512, MT = MP + MS;
constexpr int DM = 1024, DIN = 3328, PW = 3072, DFF = 2816;
constexpr int NRB = MP / 64;
constexpr float ALPHA_F = 1.189207115002721f;
constexpr float LN_EPS_F = 1e-5f;

constexpr size_t O_YP = 0, O_YS = 16777216, O_KP = 17301504, O_VP = 17432576, O_KS = 17563648, O_VS = 19660800,
                 O_HRP = 21757952, O_HIP = 21774336, O_HRS = 21790720, O_HIS = 22052864, O_CP = 22315008, O_CS = 22360064;

constexpr size_t OFF_P = 0;
constexpr size_t OFF_H = 0;
constexpr size_t OFF_B = (size_t)MT * PW * 2;
constexpr size_t OFF_GY = OFF_B, OFF_O = OFF_B + (size_t)MT * 512 * 2;
constexpr size_t OFF_C = OFF_B + (size_t)MT * DM * 2;
constexpr size_t OFF_MG = OFF_C;
constexpr size_t OFF_X1B = OFF_C + (size_t)MT * DM * 2;
constexpr size_t OFF_KP = OFF_C + (size_t)MT * DM * 2;
constexpr size_t OFF_VTP = OFF_KP + (size_t)8 * 2048 * 128 * 2;
constexpr size_t OFF_KS = OFF_VTP + (size_t)8 * 2048 * 128 * 2;
constexpr size_t OFF_VTS = OFF_KS + (size_t)128 * 144 * 128 * 2;
constexpr size_t OFF_W = OFF_C + (size_t)MT * DM * 4;
constexpr size_t OFF_WIN = OFF_W;
constexpr size_t OFF_WGLU = OFF_WIN + (size_t)DIN * 1024 * 2;
constexpr size_t OFF_WATT = OFF_WGLU + (size_t)2048 * 512 * 2;
constexpr size_t OFF_WO = OFF_WATT + (size_t)1024 * 512 * 2;
constexpr size_t OFF_WUP = OFF_WO + (size_t)1024 * 1024 * 2;
constexpr size_t OFF_WDN = OFF_WUP + (size_t)5632 * 1024 * 2;
constexpr size_t OFF_SSM = OFF_WDN + (size_t)1024 * DFF * 2;
constexpr size_t OFF_AR = OFF_SSM, OFF_AI = OFF_SSM + 8192, OFF_BB = OFF_SSM + 16384;
constexpr size_t OFF_E = OFF_BB + 131072;
constexpr size_t OFF_HA0 = OFF_E + (size_t)8 * 32 * 16 * 128 * 4;
constexpr size_t OFF_HG0 = OFF_HA0 + (size_t)NRB * 2 * DFF * 4;
constexpr size_t OFF_HA1 = OFF_HG0 + (size_t)NRB * 2 * DFF * 4;
constexpr size_t WS_END = OFF_HA1 + (size_t)NRB * 2 * DFF * 4;
static_assert(OFF_VTS + (size_t)128 * 144 * 128 * 2 <= OFF_W, "KV overlay overflow");
static_assert(WS_END <= (size_t)256 * 1024 * 1024, "workspace too large");

constexpr size_t OFF_BAR = WS_END;
constexpr size_t WS_TOTAL = OFF_BAR + 16384;
static_assert(WS_TOTAL <= (size_t)256 * 1024 * 1024, "workspace too large");
constexpr size_t OFF_SLAB_WO = OFF_P;
constexpr size_t OFF_SLAB_DN = OFF_B;
static_assert((size_t)11 * MS * DM * 4 <= (size_t)MT * DM * 2, "down slabs must fit the X1b region");
constexpr size_t OFF_SLAB_GLU = OFF_KP;
constexpr size_t OFF_SLAB_ATT = OFF_KP + (size_t)4 * MS * 2048 * 4;
static_assert(OFF_SLAB_ATT + (size_t)4 * MS * DM * 4 <= OFF_W, "GLU/attn slabs must fit the dead K/V + x1 region");
constexpr size_t OFF_PRE1 = OFF_B;
constexpr size_t OFF_PRE2 = OFF_C;
constexpr int GEMM_LDS = 131072;
constexpr int LDS_BYTES = GEMM_LDS + 16;
constexpr int NTHR = 512, NWAVE = 8;

struct Params {
  const float* in[28];
  float* out;
  unsigned char* ws;
};

typedef __bf16 bf16v2_t __attribute__((ext_vector_type(2)));
typedef float f32x2 __attribute__((ext_vector_type(2)));
__device__ __forceinline__ unsigned pk2(float lo, float hi) { f32x2 v = {lo, hi}; bf16v2_t b = __builtin_convertvector(v, bf16v2_t); return __builtin_bit_cast(unsigned, b); }
__device__ __forceinline__ bf16_t f2bf(float x) { return (bf16_t)(pk2(x, 0.f) & 0xffffu); }
__device__ __forceinline__ float bf2f(unsigned v16) { return __uint_as_float(v16 << 16); }
__device__ __forceinline__ float bflo(unsigned w) { return __uint_as_float(w << 16); }
__device__ __forceinline__ float bfhi(unsigned w) { return __uint_as_float(w & 0xffff0000u); }
__device__ __forceinline__ float rcp_nr(float d) { const float r = __builtin_amdgcn_rcpf(d); return fmaf(r, fmaf(-d, r, 1.f), r); }
__device__ __forceinline__ float sigmoidf_(float x) { return rcp_nr(1.f + __expf(fminf(-x, 80.f))); }
__device__ __forceinline__ float gelu_tanh(float x) { float z = 1.5957691216057308f * (x + 0.044715f * x * x * x); return x * rcp_nr(1.f + __expf(fminf(-z, 80.f))); }
__device__ __forceinline__ float wave_sum(float v) {
#pragma unroll
  for (int o = 1; o < 64; o <<= 1) v += __shfl_xor(v, o);
  return v;
}
__device__ __forceinline__ u32x2 pk4(f32x4 v) { u32x2 r; r.x = pk2(v.x, v.y); r.y = pk2(v.z, v.w); return r; }
__device__ __forceinline__ f32x4 unpk4(u32x2 w) { f32x4 r; r.x = bflo(w.x); r.y = bfhi(w.x); r.z = bflo(w.y); r.w = bfhi(w.y); return r; }


#define LAS __attribute__((address_space(3)))
namespace pg8 {
constexpr int BM = 256, BK = 64, HALF = 128, HTB = HALF * BK * 2, NXCD = 8, WGM = 8;
__device__ __forceinline__ int lds_byte(int r, int c) { const int st = (r >> 4) * 2 + (c >> 5), rr = r & 15, cc = c & 31, ob = rr * 64 + cc * 2; return st * 1024 + (ob ^ (((ob >> 9) & 1) << 5)); }
__device__ __forceinline__ void stage_rc(int b, int& R, int& C) { const int st = b / 1024, sb = b % 1024, swz = sb ^ (((sb >> 9) & 1) << 5); R = (st >> 1) * 16 + swz / 64; C = (st & 1) * 32 + (swz % 64) / 2; }
struct Unit { int pm, pn, k0, nk, slice; };
struct StaticOrder {
    int nM, nN, nwg, G, c;
    __device__ __forceinline__ void init(int M, int N, int G_, int c_) { nM = M / BM; nN = N / BM; nwg = nM * nN; G = G_; c = c_; }
    int nsplit, nslice_items, nt, glu;
    __device__ __forceinline__ bool next(int i, int& pm, int& pn, int& k0, int& nk, int& slice, int& src) const {
        const long L = (long)i * G + c;
        pm = 0; pn = 0; k0 = 0; nk = nt; slice = -1; src = 0;
        if (L < nwg) {
            int wgid = (int)L; { const int q = nwg / NXCD, r = nwg % NXCD, xcd = wgid % NXCD, off = wgid / NXCD; wgid = (xcd < r ? xcd * (q + 1) : r * (q + 1) + (xcd - r) * q) + off; }
            const int nig = WGM * nN, gid = wgid / nig, fm = gid * WGM, gsz = (nM - fm) < WGM ? (nM - fm) : WGM;
            pm = fm + ((wgid % nig) % gsz); pn = (wgid % nig) / gsz; return true;
        }
        if (nsplit == 0) return false;
        int sidx = (int)(L - nwg);
        if (sidx >= nslice_items) return false;
        int ncol = nN;
        if (glu && sidx >= 64) { sidx -= 64; src = 1; ncol = 4; }
        const int tl = sidx / nsplit; slice = sidx - tl * nsplit; pm = 64 + tl / ncol; pn = tl % ncol; nk = nt / nsplit; k0 = slice * nk; return true;
    }
};
}

enum { EPI_IN = 0, EPI_GLU = 1, EPI_ATT = 2, EPI_WO = 3, EPI_UP = 4, EPI_DOWN = 5 };

__device__ __forceinline__ float dpp_ror1(float v) { return __int_as_float(__builtin_amdgcn_update_dpp(0, __float_as_int(v), 0x121, 0xf, 0xf, false)); }
__device__ __forceinline__ float dpp_ror2(float v) { return __int_as_float(__builtin_amdgcn_update_dpp(0, __float_as_int(v), 0x122, 0xf, 0xf, false)); }
__device__ __forceinline__ f32x4 ror1v(f32x4 v) { return f32x4{dpp_ror1(v.x), dpp_ror1(v.y), dpp_ror1(v.z), dpp_ror1(v.w)}; }
__device__ __forceinline__ f32x4 ror2v(f32x4 v) { return f32x4{dpp_ror2(v.x), dpp_ror2(v.y), dpp_ror2(v.z), dpp_ror2(v.w)}; }

template <int EPI>
__device__ __forceinline__ void epilogue(const Params& p, f32x4 (&acc)[2][2][4][2], const int pm, const int pn, const int wr, const int wc, const int fr, const int fq) {
  unsigned char* ws = p.ws;
  bf16_t* P = (bf16_t*)(ws + OFF_P);
  if constexpr (EPI == EPI_IN) {
    bf16_t* Kp = (bf16_t*)(ws + OFF_KP); bf16_t* Ks = (bf16_t*)(ws + OFF_KS);
    bf16_t* Vtp = (bf16_t*)(ws + OFF_VTP); bf16_t* Vts = (bf16_t*)(ws + OFF_VTS);
#pragma unroll
    for (int bj = 0; bj < 2; ++bj) {
      const int col0 = pn * 256 + bj * 128;
#pragma unroll
      for (int ai = 0; ai < 2; ++ai)
#pragma unroll
        for (int m = 0; m < 4; ++m) {
          const int row = pm * 256 + ai * 128 + wr * 64 + m * 16 + fr;
#pragma unroll
          for (int n = 0; n < 2; ++n) {
            const int col = col0 + wc * 32 + n * 16 + fq * 4;
            f32x4 v = acc[ai][bj][m][n];
            if (col0 < 1024) {
              *(u32x2*)(P + (size_t)row * PW + col) = pk4(v);
            } else if (col0 >= 1280) {
              v.x = sigmoidf_(v.x); v.y = sigmoidf_(v.y); v.z = sigmoidf_(v.z); v.w = sigmoidf_(v.w);
              *(u32x2*)(P + (size_t)row * PW + col - 256) = pk4(v);
            } else if (col0 == 1024) {
              const int cc = col - 1024;
              if (row < MP) {
                *(u32x2*)(Kp + (size_t)row * 128 + cc) = pk4(v);
                const int pos = row & 2047;
                if (pos >= 1920) *(f32x4*)(p.out + O_KP + ((size_t)(row >> 11) * 128 + (pos - 1920)) * 128 + cc) = v;
              } else {
                const int s = row - MP, b = s >> 2, tt = s & 3;
                *(u32x2*)(Ks + ((size_t)b * 144 + 128 + tt) * 128 + cc) = pk4(v);
                *(f32x4*)(p.out + O_KS + ((size_t)b * 128 + 124 + tt) * 128 + cc) = v;
              }
            } else {
              const int cc = col - 1152, kv = cc >> 6, d = cc & 63;
              if (row < MP) {
                const int b = row >> 11, pos = row & 2047;
                bf16_t* dst = Vtp + ((size_t)(b * 2 + kv) * 64 + d) * 2048 + pos;
                dst[0] = f2bf(v.x); dst[2048] = f2bf(v.y); dst[4096] = f2bf(v.z); dst[6144] = f2bf(v.w);
                if (pos >= 1920) *(f32x4*)(p.out + O_VP + ((size_t)b * 128 + (pos - 1920)) * 128 + cc) = v;
              } else {
                const int s = row - MP, b = s >> 2, tt = s & 3;
                bf16_t* dst = Vts + ((size_t)(b * 2 + kv) * 64 + d) * 144 + 128 + tt;
                dst[0] = f2bf(v.x); dst[144] = f2bf(v.y); dst[288] = f2bf(v.z); dst[432] = f2bf(v.w);
                *(f32x4*)(p.out + O_VS + ((size_t)b * 128 + 124 + tt) * 128 + cc) = v;
              }
            }
          }
        }
    }
  } else if constexpr (EPI == EPI_GLU) {
    bf16_t* Mg = (bf16_t*)(ws + OFF_MG);
#pragma unroll
    for (int ai = 0; ai < 2; ++ai)
#pragma unroll
      for (int m = 0; m < 4; ++m) {
        const int row = pm * 256 + ai * 128 + wr * 64 + m * 16 + fr;
#pragma unroll
        for (int bj = 0; bj < 2; ++bj) {
          const int j0 = pn * 128 + bj * 64 + wc * 16 + fq * 4;
          const f32x4 ya = acc[ai][bj][m][0], yb = acc[ai][bj][m][1];
          const f32x4 gs = unpk4(*(const u32x2*)(P + (size_t)row * PW + 1024 + j0));
          f32x4 sv;
          sv.x = gs.x * ya.x * sigmoidf_(yb.x); sv.y = gs.y * ya.y * sigmoidf_(yb.y);
          sv.z = gs.z * ya.z * sigmoidf_(yb.z); sv.w = gs.w * ya.w * sigmoidf_(yb.w);
          *(u32x2*)(Mg + (size_t)row * DM + j0) = pk4(sv);
        }
      }
  } else if constexpr (EPI == EPI_ATT) {
    bf16_t* Mg = (bf16_t*)(ws + OFF_MG);
#pragma unroll
    for (int ai = 0; ai < 2; ++ai)
#pragma unroll
      for (int m = 0; m < 4; ++m) {
        const int row = pm * 256 + ai * 128 + wr * 64 + m * 16 + fr;
#pragma unroll
        for (int bj = 0; bj < 2; ++bj)
#pragma unroll
          for (int n = 0; n < 2; ++n) {
            const int col = pn * 256 + bj * 128 + wc * 32 + n * 16 + fq * 4;
            const f32x4 ga = unpk4(*(const u32x2*)(P + (size_t)row * PW + 2048 + col));
            const f32x4 sv = unpk4(*(const u32x2*)(Mg + (size_t)row * DM + col));
            f32x4 v = acc[ai][bj][m][n];
            v.x = sv.x + ga.x * v.x; v.y = sv.y + ga.y * v.y; v.z = sv.z + ga.z * v.z; v.w = sv.w + ga.w * v.w;
            *(u32x2*)(Mg + (size_t)row * DM + col) = pk4(v);
          }
      }
  } else if constexpr (EPI == EPI_WO || EPI == EPI_DOWN) {
    const bf16_t* X1b = (const bf16_t*)(ws + OFF_X1B);
#pragma unroll
    for (int ai = 0; ai < 2; ++ai)
#pragma unroll
      for (int m = 0; m < 4; ++m) {
        const int row = pm * 256 + ai * 128 + wr * 64 + m * 16 + fr;
#pragma unroll
        for (int bj = 0; bj < 2; ++bj)
#pragma unroll
          for (int n = 0; n < 2; ++n) {
            const int col = pn * 256 + bj * 128 + wc * 32 + n * 16 + fq * 4;
            f32x4 x;
            if constexpr (EPI == EPI_WO) x = *(const f32x4*)(p.in[0] + (size_t)row * DM + col);
            else x = unpk4(*(const u32x2*)(X1b + (size_t)row * DM + col));
            f32x4 v = acc[ai][bj][m][n];
            v.x += ALPHA_F * x.x; v.y += ALPHA_F * x.y; v.z += ALPHA_F * x.z; v.w += ALPHA_F * x.w;
            *(u32x2*)((bf16_t*)(ws + (EPI == EPI_WO ? OFF_PRE1 : OFF_PRE2)) + (size_t)row * DM + col) = pk4(v);
          }
      }
  } else {
    bf16_t* H = (bf16_t*)(ws + OFF_H);
    float* HA0 = (float*)(ws + OFF_HA0); float* HG0 = (float*)(ws + OFF_HG0); float* HA1 = (float*)(ws + OFF_HA1);
    const bool prompt = (pm < MP / 256);
#pragma unroll
    for (int bj = 0; bj < 2; ++bj) {
      const int j0 = pn * 128 + bj * 64 + wc * 16 + fq * 4;
      const f32x4 w0 = *(const f32x4*)(p.in[23] + j0), w1 = *(const f32x4*)(p.in[23] + DFF + j0), w2 = *(const f32x4*)(p.in[23] + 2 * DFF + j0);
      const f32x4 cb = *(const f32x4*)(p.in[24] + j0);
#pragma unroll
      for (int ai = 0; ai < 2; ++ai) {
        const int rblk = pm * 256 + ai * 128 + wr * 64;
#pragma unroll
        for (int m = 0; m < 4; ++m) {
          const int row = rblk + m * 16 + fr;
          const f32x4 a0 = acc[ai][bj][m][0], g = acc[ai][bj][m][1];
          const f32x4 s1 = ror1v(a0), s2 = ror2v(a0);
          f32x4 q1 = s1, q2 = s2;
          if (m > 0) { q1 = ror1v(acc[ai][bj][m > 0 ? m - 1 : 0][0]); q2 = ror2v(acc[ai][bj][m > 0 ? m - 1 : 0][0]); }
          f32x4 am1, am2; bool defer = false;
          if (prompt) {
            am1 = (fr >= 1) ? s1 : q1; am2 = (fr >= 2) ? s2 : q2;
            if (m == 0 && fr < 2) {
              if ((row & 2047) < 2) { am2 = f32x4{0.f, 0.f, 0.f, 0.f}; if (fr == 0) am1 = am2; }
              else defer = true;
            }
            if (m == 3 && fr >= 14) *(f32x4*)(HA1 + ((size_t)(rblk >> 6) * 2 + (fr - 14)) * DFF + j0) = a0;
            const int pos = row & 2047;
            if (pos >= 2046) *(f32x4*)(p.out + O_CP + ((size_t)(row >> 11) * 2 + (pos - 2046)) * DFF + j0) = a0;
          } else {
            const int sidx = row - MP, b = sidx >> 2, tt = sidx & 3;
            const f32x4 st0 = *(const f32x4*)(p.in[6] + ((size_t)b * 2 + 0) * DFF + j0);
            const f32x4 st1 = *(const f32x4*)(p.in[6] + ((size_t)b * 2 + 1) * DFF + j0);
            am1 = (tt >= 1) ? s1 : st1;
            am2 = (tt >= 2) ? s2 : ((tt == 1) ? st1 : st0);
            if (tt >= 2) *(f32x4*)(p.out + O_CS + ((size_t)b * 2 + (tt - 2)) * DFF + j0) = a0;
          }
          if (!defer) {
            f32x4 h;
            h.x = gelu_tanh(cb.x + w0.x * am2.x + w1.x * am1.x + w2.x * a0.x) * g.x;
            h.y = gelu_tanh(cb.y + w0.y * am2.y + w1.y * am1.y + w2.y * a0.y) * g.y;
            h.z = gelu_tanh(cb.z + w0.z * am2.z + w1.z * am1.z + w2.z * a0.z) * g.z;
            h.w = gelu_tanh(cb.w + w0.w * am2.w + w1.w * am1.w + w2.w * a0.w) * g.w;
            *(u32x2*)(H + (size_t)row * DFF + j0) = pk4(h);
          } else {
            *(f32x4*)(HA0 + ((size_t)(rblk >> 6) * 2 + fr) * DFF + j0) = a0;
            *(f32x4*)(HG0 + ((size_t)(rblk >> 6) * 2 + fr) * DFF + j0) = g;
          }
        }
      }
    }
  }
}

template <int EPI>
__device__ __forceinline__ void gemm_phase(const Params& p, const bf16_t* __restrict__ gA, const bf16_t* __restrict__ gBt, const int K, const int N, LAS unsigned char* lds,
                                           const bf16_t* __restrict__ gA2 = nullptr, const bf16_t* __restrict__ gBt2 = nullptr) {
    using namespace pg8;
    int tid_ = threadIdx.x; asm volatile("" : "+v"(tid_));
    const int tid = tid_, wid = __builtin_amdgcn_readfirstlane(tid >> 6), lane = tid & 63, wr = wid >> 2, wc = wid & 3, fr = lane & 15, fq = lane >> 4;
    const int nt = K / BK;
    constexpr bool SPLIT = (EPI == EPI_WO || EPI == EPI_DOWN || EPI == EPI_GLU);
    constexpr bool PROMPT_ONLY = SPLIT || (EPI == EPI_ATT);
    constexpr int NSPLIT = (EPI == EPI_WO) ? 8 : (EPI == EPI_DOWN ? 11 : 4);
    StaticOrder S; S.init(PROMPT_ONLY ? MP : MT, N, gridDim.x, blockIdx.x);
    const int nN_ = N / BM;
    S.nt = nt; S.nsplit = SPLIT ? NSPLIT : 0; S.glu = (EPI == EPI_GLU) ? 1 : 0;
    S.nslice_items = (EPI == EPI_GLU) ? 96 : 2 * nN_ * NSPLIT;
    unsigned voff[2];
#pragma unroll
    for (int i = 0; i < 2; ++i) { int R, C; stage_rc(tid * 16 + i * 8192, R, C); voff[i] = (unsigned)(R * K + C) * 2u; }
    const size_t kstep = (size_t)(BK * 2);
    const size_t hstep = (size_t)HALF * K * 2;
    const size_t tstep = 2 * hstep;
    const unsigned ldsw = (unsigned)wid * 1024u;
    const int aoff = lds_byte(wr * 64 + fr, fq * 8), boff = lds_byte(wc * 32 + fr, fq * 8);
#define PG8_SA(b, h) (((b) * 2 + (h)) * HTB)
#define PG8_SB(b, h) ((4 + (b) * 2 + (h)) * HTB)
#define PG8_STAGE(bufoff, gbase) do { _Pragma("unroll") for (int _i = 0; _i < 2; ++_i) \
        __builtin_amdgcn_global_load_lds((const unsigned*)((const char*)(gbase) + voff[_i]), (LAS unsigned*)(lds + (bufoff) + ldsw + _i * 8192), 16, 0, 0); } while (0)
#define PG8_LDA(dst, b, h) do { _Pragma("unroll") for (int m = 0; m < 4; ++m) _Pragma("unroll") for (int k = 0; k < 2; ++k) dst[m][k] = *(const LAS bf16x8*)(lds + PG8_SA(b, h) + aoff + m * 2048 + k * 1024); } while (0)
#define PG8_LDB(dst, b, h) do { _Pragma("unroll") for (int n = 0; n < 2; ++n) _Pragma("unroll") for (int k = 0; k < 2; ++k) dst[n][k] = *(const LAS bf16x8*)(lds + PG8_SB(b, h) + boff + n * 2048 + k * 1024); } while (0)
#define PG8_MMA(ai, bj, At, Bt) do { __builtin_amdgcn_s_setprio(1); _Pragma("unroll") for (int m = 0; m < 4; ++m) _Pragma("unroll") for (int n = 0; n < 2; ++n) _Pragma("unroll") for (int k = 0; k < 2; ++k) \
        acc[ai][bj][m][n] = __builtin_amdgcn_mfma_f32_16x16x32_bf16(Bt[n][k], At[m][k], acc[ai][bj][m][n], 0, 0, 0); __builtin_amdgcn_s_setprio(0); } while (0)
#define PG8_WAIT_V(n) asm volatile("s_waitcnt vmcnt(" #n ")" ::: "memory")
#define PG8_WAIT_L(n) asm volatile("s_waitcnt lgkmcnt(" #n ")" ::: "memory")
#define PG8_BAR __builtin_amdgcn_s_barrier()
#define PG8_SCHED __builtin_amdgcn_sched_barrier(0)
    int ui = 0, cur_pm, cur_pn, cur_k0, cur_nk, cur_slice, cur_src, nxt_pm, nxt_pn, nxt_k0, nxt_nk, nxt_slice, nxt_src;
    if (!S.next(0, cur_pm, cur_pn, cur_k0, cur_nk, cur_slice, cur_src)) return;
    f32x4 acc[2][2][4][2];
#pragma unroll
    for (int a = 0; a < 2; ++a)
#pragma unroll
        for (int b = 0; b < 2; ++b)
#pragma unroll
            for (int m = 0; m < 4; ++m)
#pragma unroll
                for (int n = 0; n < 2; ++n) acc[a][b][m][n] = (f32x4){0.f, 0.f, 0.f, 0.f};
    bf16x8 At[4][2], B0[2][2], B1[2][2];
    const char* cA = (const char*)((EPI == EPI_GLU && cur_src) ? gA2 : gA) + (size_t)cur_pm * tstep + (size_t)cur_k0 * kstep;
    const char* cB = (const char*)((EPI == EPI_GLU && cur_src) ? gBt2 : gBt) + (size_t)cur_pn * tstep + (size_t)cur_k0 * kstep;
    PG8_STAGE(PG8_SB(0, 0), cB); PG8_STAGE(PG8_SB(0, 1), cB + hstep); PG8_STAGE(PG8_SA(0, 0), cA); PG8_STAGE(PG8_SA(0, 1), cA + hstep);
    if (wr == 1) PG8_BAR;
    PG8_WAIT_V(2); PG8_BAR;
    PG8_STAGE(PG8_SB(1, 0), cB + kstep); PG8_STAGE(PG8_SA(1, 0), cA + kstep); PG8_STAGE(PG8_SB(1, 1), cB + hstep + kstep);
    PG8_WAIT_V(6); PG8_BAR;
    for (;;) {
        const bool has_next = S.next(ui + 1, nxt_pm, nxt_pn, nxt_k0, nxt_nk, nxt_slice, nxt_src);
        const char* nA = has_next ? (const char*)((EPI == EPI_GLU && nxt_src) ? gA2 : gA) + (size_t)nxt_pm * tstep + (size_t)nxt_k0 * kstep : cA;
        const char* nB = has_next ? (const char*)((EPI == EPI_GLU && nxt_src) ? gBt2 : gBt) + (size_t)nxt_pn * tstep + (size_t)nxt_k0 * kstep : cB;
        const int cnk = cur_nk;
        for (int t = 0; t < cnk; t += 2) {
            const bool last = (t == cnk - 2);
            const char* a1 = cA + (size_t)(t + 1) * kstep;
            const char* a2 = last ? nA : cA + (size_t)(t + 2) * kstep; const char* b2 = last ? nB : cB + (size_t)(t + 2) * kstep;
            const char* a3 = a2 + kstep; const char* b3 = b2 + kstep;
            PG8_LDB(B0, 0, 0); PG8_LDB(B1, 0, 1); PG8_SCHED; PG8_LDA(At, 0, 0); PG8_STAGE(PG8_SA(1, 1), a1 + hstep);
            PG8_WAIT_V(8); PG8_WAIT_L(0); PG8_BAR; PG8_MMA(0, 0, At, B0); PG8_MMA(0, 1, At, B1); PG8_BAR; PG8_SCHED;
            PG8_LDA(At, 0, 1); PG8_STAGE(PG8_SB(0, 0), b2); PG8_STAGE(PG8_SB(0, 1), b2 + hstep); PG8_STAGE(PG8_SA(0, 0), a2);
            PG8_WAIT_V(8); PG8_WAIT_L(0); PG8_BAR; PG8_MMA(1, 0, At, B0); PG8_MMA(1, 1, At, B1); PG8_BAR; PG8_SCHED;
            PG8_LDB(B0, 1, 0); PG8_LDB(B1, 1, 1); PG8_SCHED; PG8_LDA(At, 1, 0); PG8_STAGE(PG8_SA(0, 1), a2 + hstep);
            PG8_WAIT_V(8); PG8_WAIT_L(0); PG8_BAR; PG8_MMA(0, 0, At, B0); PG8_MMA(0, 1, At, B1); PG8_BAR; PG8_SCHED;
            PG8_LDA(At, 1, 1); PG8_STAGE(PG8_SB(1, 0), b3); PG8_STAGE(PG8_SB(1, 1), b3 + hstep); PG8_STAGE(PG8_SA(1, 0), a3);
            PG8_WAIT_V(8); PG8_WAIT_L(0); PG8_BAR; PG8_MMA(1, 0, At, B0); PG8_MMA(1, 1, At, B1); PG8_BAR; PG8_SCHED;
        }
        if (wr == 0) PG8_BAR;
        if (SPLIT && cur_slice >= 0) {
            const int ldc = (EPI == EPI_GLU && cur_src == 0) ? 2048 : DM;
            float* SL = (float*)(p.ws + (EPI == EPI_WO ? OFF_SLAB_WO : (EPI == EPI_DOWN ? OFF_SLAB_DN : (cur_src ? OFF_SLAB_ATT : OFF_SLAB_GLU)))) + (size_t)cur_slice * MS * ldc;
#pragma unroll
            for (int ai = 0; ai < 2; ++ai)
#pragma unroll
                for (int m = 0; m < 4; ++m) {
                    const int rs = (cur_pm - 64) * 256 + ai * 128 + wr * 64 + m * 16 + fr;
#pragma unroll
                    for (int bj = 0; bj < 2; ++bj)
#pragma unroll
                        for (int n = 0; n < 2; ++n) *(f32x4*)(SL + (size_t)rs * ldc + cur_pn * 256 + bj * 128 + wc * 32 + n * 16 + fq * 4) = acc[ai][bj][m][n];
                }
        } else epilogue<EPI>(p, acc, cur_pm, cur_pn, wr, wc, fr, fq);
        if (!has_next) break;
#pragma unroll
        for (int a = 0; a < 2; ++a)
#pragma unroll
            for (int b = 0; b < 2; ++b)
#pragma unroll
                for (int m = 0; m < 4; ++m)
#pragma unroll
                    for (int n = 0; n < 2; ++n) acc[a][b][m][n] = (f32x4){0.f, 0.f, 0.f, 0.f};
        cur_pm = nxt_pm; cur_pn = nxt_pn; cur_k0 = nxt_k0; cur_nk = nxt_nk; cur_slice = nxt_slice; cur_src = nxt_src; cA = nA; cB = nB; ++ui;
        if (wr == 1) PG8_BAR;
    }
    PG8_WAIT_V(0);
    PG8_BAR;
#undef PG8_SA
#undef PG8_SB
#undef PG8_STAGE
#undef PG8_LDA
#undef PG8_LDB
#undef PG8_MMA
#undef PG8_WAIT_V
#undef PG8_WAIT_L
#undef PG8_BAR
#undef PG8_SCHED
}

template <int MODE>
__device__ __forceinline__ int dest_row(int n, int HH) {
  if (MODE == 0) return n;
  const int part = n >= HH ? 1 : 0, j = n - part * HH;
  const int tj = j >> 7, jl = j & 127, bj = jl >> 6, wcj = (jl >> 4) & 3, w = jl & 15;
  return tj * 256 + bj * 128 + wcj * 32 + part * 16 + w;
}
template <int MODE>
__device__ __forceinline__ void transpose_item(const float* __restrict__ W, int K, int N, bf16_t* __restrict__ WT, int HH, float* scr, int item, int lane) {
  const int nblk = N / 32, kb = item / nblk, nb = item - kb * nblk, k0 = 64 * kb, n0 = 32 * nb;
#pragma unroll 8
  for (int i = 0; i < 32; ++i) { const int kk = 2 * i + (lane >> 5); scr[kk * 33 + (lane & 31)] = W[(size_t)(k0 + kk) * N + n0 + (lane & 31)]; }
  asm volatile("s_waitcnt lgkmcnt(0)" ::: "memory");
  const int c = lane & 7;
#pragma unroll
  for (int j = 0; j < 4; ++j) {
    const int n = (lane >> 3) + 8 * j; const float* s = scr + (8 * c) * 33 + n;
    u32x4 o; o.x = pk2(s[0], s[33]); o.y = pk2(s[66], s[99]); o.z = pk2(s[132], s[165]); o.w = pk2(s[198], s[231]);
    *(u32x4*)(WT + (size_t)dest_row<MODE>(n0 + n, HH) * K + k0 + 8 * c) = o;
  }
  asm volatile("s_waitcnt lgkmcnt(0)" ::: "memory");
}

__device__ __forceinline__ void prep_phase(const Params& p, char* lds) {
  unsigned char* ws = p.ws;
  const int tid = threadIdx.x, lane = tid & 63, wid = tid >> 6;
  const int gt = blockIdx.x * NTHR + tid, NGT = gridDim.x * NTHR;
  const int gw = blockIdx.x * NWAVE + wid, NGW = gridDim.x * NWAVE;
  {
    bf16_t* Xb = (bf16_t*)(ws + OFF_B);
    const int nchunk = MT * DM / 8, npc = MP * DM / 8;
    for (int i0 = gt; i0 < nchunk / 4; i0 += NGT) {
      f32x4 a[4], b[4];
#pragma unroll
      for (int q = 0; q < 4; ++q) {
        const int i = i0 + q * (nchunk / 4);
        const float* sp = (i < npc) ? p.in[0] + (size_t)i * 8 : p.in[1] + (size_t)(i - npc) * 8;
        a[q] = *(const f32x4*)sp; b[q] = *(const f32x4*)(sp + 4);
      }
#pragma unroll
      for (int q = 0; q < 4; ++q) {
        const int i = i0 + q * (nchunk / 4);
        u32x4 o; o.x = pk2(a[q].x, a[q].y); o.y = pk2(a[q].z, a[q].w); o.z = pk2(b[q].x, b[q].y); o.w = pk2(b[q].z, b[q].w);
        *(u32x4*)(Xb + (size_t)i * 8) = o;
      }
    }
  }
  {
    float* scr = (float*)(lds + wid * 8704);
    constexpr int I_IN = 16 * 104, I_GLU = 8 * 64, I_ATT = 8 * 32, I_O = 16 * 32, I_UP = 16 * 176, I_DN = 44 * 32;
    constexpr int NIT = I_IN + I_GLU + I_ATT + I_O + I_UP + I_DN;
    for (int it = gw; it < NIT; it += NGW) {
      int r = it;
      if (r < I_IN) { transpose_item<0>(p.in[7], 1024, DIN, (bf16_t*)(ws + OFF_WIN), 0, scr, r, lane); continue; } r -= I_IN;
      if (r < I_GLU) { transpose_item<1>(p.in[16], 512, 2048, (bf16_t*)(ws + OFF_WGLU), 1024, scr, r, lane); continue; } r -= I_GLU;
      if (r < I_ATT) { transpose_item<0>(p.in[18], 512, 1024, (bf16_t*)(ws + OFF_WATT), 0, scr, r, lane); continue; } r -= I_ATT;
      if (r < I_O) { transpose_item<0>(p.in[19], 1024, 1024, (bf16_t*)(ws + OFF_WO), 0, scr, r, lane); continue; } r -= I_O;
      if (r < I_UP) { transpose_item<1>(p.in[22], 1024, 5632, (bf16_t*)(ws + OFF_WUP), DFF, scr, r, lane); continue; } r -= I_UP;
      transpose_item<0>(p.in[25], DFF, 1024, (bf16_t*)(ws + OFF_WDN), 0, scr, r, lane);
    }
  }
  {
    bf16_t* Ks = (bf16_t*)(ws + OFF_KS); bf16_t* Vts = (bf16_t*)(ws + OFF_VTS);
    const float* ck = p.in[2]; const float* cv = p.in[3];
    for (int i = gt; i < 128 * 128 * 16; i += NGT) {
      const int c8 = i & 15, w = (i >> 4) & 127, b = i >> 11;
      const float* s = ck + ((size_t)b * 128 + w) * 128 + c8 * 8;
      const f32x4 a = *(const f32x4*)s, bq = *(const f32x4*)(s + 4);
      u32x4 o; o.x = pk2(a.x, a.y); o.y = pk2(a.z, a.w); o.z = pk2(bq.x, bq.y); o.w = pk2(bq.z, bq.w);
      *(u32x4*)(Ks + ((size_t)b * 144 + w) * 128 + c8 * 8) = o;
    }
    for (int i = gt; i < 128 * 12 * 16; i += NGT) {
      const int c8 = i & 15, r = (i >> 4) % 12, b = i / 192;
      *(u32x4*)(Ks + ((size_t)b * 144 + 132 + r) * 128 + c8 * 8) = u32x4{0u, 0u, 0u, 0u};
    }
    for (int i = gt; i < 128 * 16 * 128; i += NGT) {
      const int kvd = i & 127, w8 = (i >> 7) & 15, b = i >> 11;
      const float* s = cv + ((size_t)b * 128 + w8 * 8) * 128 + kvd;
      u32x4 o; o.x = pk2(s[0], s[128]); o.y = pk2(s[256], s[384]); o.z = pk2(s[512], s[640]); o.w = pk2(s[768], s[896]);
      *(u32x4*)(Vts + ((size_t)b * 128 + kvd) * 144 + w8 * 8) = o;
    }
    for (int i = gt; i < 128 * 128 * 3; i += NGT) {
      const int q = i % 3, r = i / 3;
      *(u32x2*)(Vts + (size_t)r * 144 + 132 + q * 4) = u32x2{0u, 0u};
    }
    for (int i = gt; i < 128 * 124 * 32; i += NGT) {
      const int c4 = i & 31, w = (i >> 5) % 124, b = i / (124 * 32);
      const size_t so = ((size_t)b * 128 + w + 4) * 128 + c4 * 4, dof = ((size_t)b * 128 + w) * 128 + c4 * 4;
      *(f32x4*)(p.out + O_KS + dof) = *(const f32x4*)(ck + so);
      *(f32x4*)(p.out + O_VS + dof) = *(const f32x4*)(cv + so);
    }
  }
  {
    float* AR = (float*)(ws + OFF_AR); float* AI = (float*)(ws + OFF_AI); bf16_t* BB = (bf16_t*)(ws + OFF_BB);
    for (int i = gt; i < 2048; i += NGT) {
      const int g = i >> 6, pp = i & 63;
      const float lr = p.in[8][i], li = p.in[9][i], dt = expf(p.in[10][g]);
      const float mag = expf(lr * dt), ang = li * dt;
      const float abr = mag * cosf(ang), abi = mag * sinf(ang);
      const float den = lr * lr + li * li, nr = abr - 1.f;
      const float cr = (nr * lr + abi * li) / den, ci = (abi * lr - nr * li) / den;
      AR[i] = abr; AI[i] = abi;
      const float* br = p.in[11] + (size_t)i * 16; const float* bi = p.in[12] + (size_t)i * 16;
      bf16_t* dre = BB + ((size_t)g * 128 + pp) * 16; bf16_t* dim_ = BB + ((size_t)g * 128 + 64 + pp) * 16;
#pragma unroll
      for (int c = 0; c < 16; ++c) {
        dre[c] = f2bf(cr * br[c] - ci * bi[c]);
        dim_[c] = f2bf(cr * bi[c] + ci * br[c]);
      }
    }
  }
}

#define CMUL_ACC(dr, di, ar_, ai_, br_, bi_) do { const float t_r = (ar_) * (br_) - (ai_) * (bi_); const float t_i = (ar_) * (bi_) + (ai_) * (br_); dr += t_r; di += t_i; } while (0)

template <int MODE>
__device__ __forceinline__ void scan_unit(const Params& p, int u, int lane, bf16_t* Hs) {
  unsigned char* ws = p.ws;
  const int pl = lane & 15, q4 = lane >> 4;
  const bf16_t* P = (const bf16_t*)(ws + OFF_P);
  const float* AR = (const float*)(ws + OFF_AR); const float* AI = (const float*)(ws + OFF_AI);
  const bf16_t* BB = (const bf16_t*)(ws + OFF_BB);
  float* E = (float*)(ws + OFF_E);
  int g, s = 0, c = 0, R0, ntile;
  if (MODE == 2) { g = u & 31; const int ti = u >> 5; R0 = MP + ti * 16; ntile = 1; s = ti; }
  else { c = u & 15; g = (u >> 4) & 31; s = u >> 9; R0 = s * 2048 + c * 128; ntile = 8; }
  float ar[4], ai[4], a4r[4], a4i[4], a8r[4], a8i[4], a128r[4], a128i[4];
#pragma unroll
  for (int q = 0; q < 4; ++q) {
    const float r1 = AR[g * 64 + q * 16 + pl], i1 = AI[g * 64 + q * 16 + pl];
    ar[q] = r1; ai[q] = i1;
    const float r2 = r1 * r1 - i1 * i1, i2 = 2.f * r1 * i1;
    const float r4 = r2 * r2 - i2 * i2, i4 = 2.f * r2 * i2;
    const float r8 = r4 * r4 - i4 * i4, i8 = 2.f * r4 * i4;
    a4r[q] = r4; a4i[q] = i4; a8r[q] = r8; a8i[q] = i8;
    const float r16 = r8 * r8 - i8 * i8, i16 = 2.f * r8 * i8;
    const float r32 = r16 * r16 - i16 * i16, i32 = 2.f * r16 * i16;
    const float r64 = r32 * r32 - i32 * i32, i64 = 2.f * r32 * i32;
    a128r[q] = r64 * r64 - i64 * i64; a128i[q] = 2.f * r64 * i64;
  }
  bf16x4 bb[8];
#pragma unroll
  for (int pt = 0; pt < 8; ++pt) bb[pt] = *(const bf16x4*)(BB + ((size_t)g * 128 + pt * 16 + pl) * 16 + q4 * 4);
  bf16x8 cm[4]; bf16x4 dmv;
  if (MODE != 0) {
#pragma unroll
    for (int ks = 0; ks < 4; ++ks) {
      const float* src = ((ks < 2) ? p.in[13] : p.in[14]) + ((size_t)g * 16 + pl) * 64 + (ks & 1) * 32 + q4 * 8;
      const float sg = (ks < 2) ? 1.f : -1.f;
      const f32x4 x0 = *(const f32x4*)src, x1 = *(const f32x4*)(src + 4);
      u32x4 o; o.x = pk2(sg * x0.x, sg * x0.y); o.y = pk2(sg * x0.z, sg * x0.w); o.z = pk2(sg * x1.x, sg * x1.y); o.w = pk2(sg * x1.z, sg * x1.w);
      cm[ks] = __builtin_bit_cast(bf16x8, o);
    }
    const float dv = p.in[15][g * 16 + pl];
    u32x2 o;
    o.x = pk2((q4 * 4 + 0 == pl) ? dv : 0.f, (q4 * 4 + 1 == pl) ? dv : 0.f);
    o.y = pk2((q4 * 4 + 2 == pl) ? dv : 0.f, (q4 * 4 + 3 == pl) ? dv : 0.f);
    dmv = __builtin_bit_cast(bf16x4, o);
  }
  float hr[4], hi[4];
#pragma unroll
  for (int q = 0; q < 4; ++q) { hr[q] = 0.f; hi[q] = 0.f; }
  if (MODE == 1) {
    const float* Eb = E + ((size_t)(s * 32 + g) * 16) * 128;
#pragma unroll
    for (int bt = 0; bt < 3; ++bt) {
      if (bt * 5 < c) {
        float er[5][4], ei[5][4];
#pragma unroll
        for (int k = 0; k < 5; ++k)
#pragma unroll
          for (int q = 0; q < 4; ++q) { er[k][q] = Eb[(bt * 5 + k) * 128 + q * 16 + pl]; ei[k][q] = Eb[(bt * 5 + k) * 128 + 64 + q * 16 + pl]; }
#pragma unroll
        for (int k = 0; k < 5; ++k) {
          const bool on = (bt * 5 + k) < c;
#pragma unroll
          for (int q = 0; q < 4; ++q) {
            const float nr_ = a128r[q] * hr[q] - a128i[q] * hi[q] + er[k][q];
            const float ni_ = a128r[q] * hi[q] + a128i[q] * hr[q] + ei[k][q];
            hr[q] = on ? nr_ : hr[q]; hi[q] = on ? ni_ : hi[q];
          }
        }
      }
    }
  }
  if (MODE == 2) {
    const int b = s * 4 + q4;
#pragma unroll
    for (int q = 0; q < 4; ++q) {
      hr[q] = p.in[4][((size_t)b * 32 + g) * 64 + q * 16 + pl];
      hi[q] = p.in[5][((size_t)b * 32 + g) * 64 + q * 16 + pl];
    }
  }
  const bf16_t* up = P + (size_t)(R0 + pl) * PW + g * 16 + q4 * 4;
  bf16x4 uf_next = *(const bf16x4*)up;
#pragma unroll 2
  for (int tile = 0; tile < ntile; ++tile) {
    const int Rt = R0 + tile * 16;
    const bf16x4 uf = uf_next;
    if (tile + 1 < ntile) uf_next = *(const bf16x4*)(up + (size_t)(tile + 1) * 16 * PW);
    f32x4 xr[4], xi[4];
    const f32x4 z4 = f32x4{0.f, 0.f, 0.f, 0.f};
#pragma unroll
    for (int q = 0; q < 4; ++q) {
      xr[q] = __builtin_amdgcn_mfma_f32_16x16x16bf16_1k(uf, bb[q], z4, 0, 0, 0);
      xi[q] = __builtin_amdgcn_mfma_f32_16x16x16bf16_1k(uf, bb[q + 4], z4, 0, 0, 0);
    }
#pragma unroll
    for (int q = 0; q < 4; ++q) {
      float s0r = xr[q].x, s0i = xi[q].x, s1r = xr[q].y, s1i = xi[q].y, s2r = xr[q].z, s2i = xi[q].z, s3r = xr[q].w, s3i = xi[q].w;
      if (MODE == 2 || q4 == 0) CMUL_ACC(s0r, s0i, ar[q], ai[q], hr[q], hi[q]);
      CMUL_ACC(s1r, s1i, ar[q], ai[q], s0r, s0i);
      CMUL_ACC(s2r, s2i, ar[q], ai[q], s1r, s1i);
      CMUL_ACC(s3r, s3i, ar[q], ai[q], s2r, s2i);
      if (MODE != 2) {
        float Ir = s3r, Ii = s3i;
        float tr = __shfl_up(Ir, 16), ti = __shfl_up(Ii, 16);
        if (q4 >= 1) CMUL_ACC(Ir, Ii, a4r[q], a4i[q], tr, ti);
        tr = __shfl_up(Ir, 32); ti = __shfl_up(Ii, 32);
        if (q4 >= 2) CMUL_ACC(Ir, Ii, a8r[q], a8i[q], tr, ti);
        float cr = __shfl_up(Ir, 16), ci = __shfl_up(Ii, 16);
        if (q4 == 0) { cr = 0.f; ci = 0.f; }
        float t1r = ar[q] * cr - ai[q] * ci, t1i = ar[q] * ci + ai[q] * cr; s0r += t1r; s0i += t1i;
        float t2r = ar[q] * t1r - ai[q] * t1i, t2i = ar[q] * t1i + ai[q] * t1r; s1r += t2r; s1i += t2i;
        float t3r = ar[q] * t2r - ai[q] * t2i, t3i = ar[q] * t2i + ai[q] * t2r; s2r += t3r; s2i += t3i;
        float t4r = ar[q] * t3r - ai[q] * t3i, t4i = ar[q] * t3i + ai[q] * t3r; s3r += t4r; s3i += t4i;
        hr[q] = __shfl(s3r, 48 + pl); hi[q] = __shfl(s3i, 48 + pl);
      } else {
        hr[q] = s3r; hi[q] = s3i;
      }
      xr[q] = f32x4{s0r, s1r, s2r, s3r}; xi[q] = f32x4{s0i, s1i, s2i, s3i};
    }
    if (MODE != 0) {
#pragma unroll
      for (int q = 0; q < 4; ++q) {
        Hs[(q4 * 4 + 0) * 136 + q * 16 + pl] = f2bf(xr[q].x); Hs[(q4 * 4 + 1) * 136 + q * 16 + pl] = f2bf(xr[q].y);
        Hs[(q4 * 4 + 2) * 136 + q * 16 + pl] = f2bf(xr[q].z); Hs[(q4 * 4 + 3) * 136 + q * 16 + pl] = f2bf(xr[q].w);
        Hs[(q4 * 4 + 0) * 136 + 64 + q * 16 + pl] = f2bf(xi[q].x); Hs[(q4 * 4 + 1) * 136 + 64 + q * 16 + pl] = f2bf(xi[q].y);
        Hs[(q4 * 4 + 2) * 136 + 64 + q * 16 + pl] = f2bf(xi[q].z); Hs[(q4 * 4 + 3) * 136 + 64 + q * 16 + pl] = f2bf(xi[q].w);
      }
      asm volatile("s_waitcnt lgkmcnt(0)" ::: "memory");
      f32x4 y = z4;
#pragma unroll
      for (int ks = 0; ks < 4; ++ks) {
        const bf16x8 hf = *(const bf16x8*)(Hs + pl * 136 + ks * 32 + q4 * 8);
        y = __builtin_amdgcn_mfma_f32_16x16x32_bf16(hf, cm[ks], y, 0, 0, 0);
      }
      y = __builtin_amdgcn_mfma_f32_16x16x16bf16_1k(uf, dmv, y, 0, 0, 0);
      asm volatile("s_waitcnt lgkmcnt(0)" ::: "memory");
      bf16_t* GY = (bf16_t*)(ws + OFF_GY);
      bf16_t* dst = GY + (size_t)(Rt + q4 * 4) * 512 + g * 16 + pl;
      dst[0] = f2bf(gelu_tanh(y.x)); dst[512] = f2bf(gelu_tanh(y.y)); dst[1024] = f2bf(gelu_tanh(y.z)); dst[1536] = f2bf(gelu_tanh(y.w));
    }
  }
  if (MODE == 0) {
    if (q4 == 0) {
      float* Eb = E + ((size_t)(s * 32 + g) * 16 + c) * 128;
#pragma unroll
      for (int q = 0; q < 4; ++q) { Eb[q * 16 + pl] = hr[q]; Eb[64 + q * 16 + pl] = hi[q]; }
    }
  } else if (MODE == 1) {
    if (c == 15 && q4 == 0) {
#pragma unroll
      for (int q = 0; q < 4; ++q) {
        p.out[O_HRP + ((size_t)s * 32 + g) * 64 + q * 16 + pl] = hr[q];
        p.out[O_HIP + ((size_t)s * 32 + g) * 64 + q * 16 + pl] = hi[q];
      }
    }
  } else {
    const int b = s * 4 + q4;
#pragma unroll
    for (int q = 0; q < 4; ++q) {
      p.out[O_HRS + ((size_t)b * 32 + g) * 64 + q * 16 + pl] = hr[q];
      p.out[O_HIS + ((size_t)b * 32 + g) * 64 + q * 16 + pl] = hi[q];
    }
  }
}

template <bool SAMPLE>
__device__ __forceinline__ void scan_full_unit(const Params& p, int u, int lane, bf16_t* Hs) {
  unsigned char* ws = p.ws;
  const int pl = lane & 15, q4 = lane >> 4;
  const bf16_t* P = (const bf16_t*)(ws + OFF_P);
  const float* AR = (const float*)(ws + OFF_AR); const float* AI = (const float*)(ws + OFF_AI);
  const bf16_t* BB = (const bf16_t*)(ws + OFF_BB);
  const float* E = (const float*)(ws + OFF_E);
  int g, s, c = 0, R0, ntile;
  if (SAMPLE) { g = u & 31; s = u >> 5; R0 = MP + s * 16; ntile = 1; }
  else { c = u & 15; g = (u >> 4) & 31; s = u >> 9; R0 = s * 2048 + c * 128; ntile = 8; }
  float ar[4], ai[4], m1r[4], m1i[4], m2r[4], m2i[4], w4r[4], w4i[4], a128r[4], a128i[4];
  const float mex = (q4 >= 1) ? 1.f : 0.f;
#pragma unroll
  for (int q = 0; q < 4; ++q) {
    const float r1 = AR[g * 64 + q * 16 + pl], i1 = AI[g * 64 + q * 16 + pl];
    ar[q] = r1; ai[q] = i1;
    const float r2 = r1 * r1 - i1 * i1, i2 = 2.f * r1 * i1;
    const float r4 = r2 * r2 - i2 * i2, i4 = 2.f * r2 * i2;
    const float r8 = r4 * r4 - i4 * i4, i8 = 2.f * r4 * i4;
    const float r12 = r8 * r4 - i8 * i4, i12 = r8 * i4 + i8 * r4;
    m1r[q] = (q4 >= 1) ? r4 : 0.f; m1i[q] = (q4 >= 1) ? i4 : 0.f;
    m2r[q] = (q4 >= 2) ? r8 : 0.f; m2i[q] = (q4 >= 2) ? i8 : 0.f;
    w4r[q] = (q4 == 0) ? 1.f : (q4 == 1) ? r4 : (q4 == 2) ? r8 : r12;
    w4i[q] = (q4 == 0) ? 0.f : (q4 == 1) ? i4 : (q4 == 2) ? i8 : i12;
    const float r16 = r8 * r8 - i8 * i8, i16 = 2.f * r8 * i8;
    const float r32 = r16 * r16 - i16 * i16, i32 = 2.f * r16 * i16;
    const float r64 = r32 * r32 - i32 * i32, i64 = 2.f * r32 * i32;
    a128r[q] = r64 * r64 - i64 * i64; a128i[q] = 2.f * r64 * i64;
  }
  bf16x4 bb[8];
#pragma unroll
  for (int pt = 0; pt < 8; ++pt) bb[pt] = *(const bf16x4*)(BB + ((size_t)g * 128 + pt * 16 + pl) * 16 + q4 * 4);
  bf16x8 cm[4];
#pragma unroll
  for (int ks = 0; ks < 4; ++ks) {
    const float* cre = p.in[13] + ((size_t)g * 16 + pl) * 64 + ks * 4 + q4;
    const float* cim = p.in[14] + ((size_t)g * 16 + pl) * 64 + ks * 4 + q4;
    u32x4 o;
    o.x = pk2(cre[0], -cim[0]); o.y = pk2(cre[16], -cim[16]); o.z = pk2(cre[32], -cim[32]); o.w = pk2(cre[48], -cim[48]);
    cm[ks] = __builtin_bit_cast(bf16x8, o);
  }
  bf16x4 dmv;
  {
    const float dv = p.in[15][g * 16 + pl];
    u32x2 o;
    o.x = pk2((q4 * 4 + 0 == pl) ? dv : 0.f, (q4 * 4 + 1 == pl) ? dv : 0.f);
    o.y = pk2((q4 * 4 + 2 == pl) ? dv : 0.f, (q4 * 4 + 3 == pl) ? dv : 0.f);
    dmv = __builtin_bit_cast(bf16x4, o);
  }
  float hr[4], hi[4];
#pragma unroll
  for (int q = 0; q < 4; ++q) { hr[q] = 0.f; hi[q] = 0.f; }
  if (!SAMPLE) {
    const float* Eb = E + ((size_t)(s * 32 + g) * 16) * 128;
#pragma unroll
    for (int bt = 0; bt < 3; ++bt) {
      if (bt * 5 < c) {
        float er[5][4], ei[5][4];
#pragma unroll
        for (int k = 0; k < 5; ++k)
#pragma unroll
          for (int q = 0; q < 4; ++q) { er[k][q] = Eb[(bt * 5 + k) * 128 + q * 16 + pl]; ei[k][q] = Eb[(bt * 5 + k) * 128 + 64 + q * 16 + pl]; }
#pragma unroll
        for (int k = 0; k < 5; ++k) {
          const bool on = (bt * 5 + k) < c;
#pragma unroll
          for (int q = 0; q < 4; ++q) {
            const float nr_ = a128r[q] * hr[q] - a128i[q] * hi[q] + er[k][q];
            const float ni_ = a128r[q] * hi[q] + a128i[q] * hr[q] + ei[k][q];
            hr[q] = on ? nr_ : hr[q]; hi[q] = on ? ni_ : hi[q];
          }
        }
      }
    }
  } else {
    const int b = s * 4 + q4;
#pragma unroll
    for (int q = 0; q < 4; ++q) {
      hr[q] = p.in[4][((size_t)b * 32 + g) * 64 + q * 16 + pl];
      hi[q] = p.in[5][((size_t)b * 32 + g) * 64 + q * 16 + pl];
    }
  }
  const bf16_t* up = P + (size_t)(R0 + pl) * PW + g * 16 + q4 * 4;
  bf16x4 uf_next = *(const bf16x4*)up;
  const f32x4 z4 = f32x4{0.f, 0.f, 0.f, 0.f};
#pragma unroll 2
  for (int tile = 0; tile < ntile; ++tile) {
    const int Rt = R0 + tile * 16;
    const bf16x4 uf = uf_next;
    if (tile + 1 < ntile) uf_next = *(const bf16x4*)(up + (size_t)(tile + 1) * 16 * PW);
    f32x4 sr4[4], si4[4];
#pragma unroll
    for (int q = 0; q < 4; ++q) {
      const f32x4 xr = __builtin_amdgcn_mfma_f32_16x16x16bf16_1k(uf, bb[q], z4, 0, 0, 0);
      const f32x4 xi = __builtin_amdgcn_mfma_f32_16x16x16bf16_1k(uf, bb[q + 4], z4, 0, 0, 0);
      float cr, ci;
      if (SAMPLE) { cr = hr[q]; ci = hi[q]; }
      else {
        float tr = xr.x, ti = xi.x, nr_, ni_;
        nr_ = ar[q] * tr - ai[q] * ti + xr.y; ni_ = ar[q] * ti + ai[q] * tr + xi.y; tr = nr_; ti = ni_;
        nr_ = ar[q] * tr - ai[q] * ti + xr.z; ni_ = ar[q] * ti + ai[q] * tr + xi.z; tr = nr_; ti = ni_;
        nr_ = ar[q] * tr - ai[q] * ti + xr.w; ni_ = ar[q] * ti + ai[q] * tr + xi.w; tr = nr_; ti = ni_;
        float ur = __shfl_up(tr, 16), ui = __shfl_up(ti, 16);
        nr_ = tr + (m1r[q] * ur - m1i[q] * ui); ni_ = ti + (m1r[q] * ui + m1i[q] * ur); tr = nr_; ti = ni_;
        ur = __shfl_up(tr, 32); ui = __shfl_up(ti, 32);
        nr_ = tr + (m2r[q] * ur - m2i[q] * ui); ni_ = ti + (m2r[q] * ui + m2i[q] * ur); tr = nr_; ti = ni_;
        ur = __shfl_up(tr, 16); ui = __shfl_up(ti, 16);
        cr = mex * ur + (w4r[q] * hr[q] - w4i[q] * hi[q]);
        ci = mex * ui + (w4r[q] * hi[q] + w4i[q] * hr[q]);
      }
      const float s0r = ar[q] * cr - ai[q] * ci + xr.x, s0i = ar[q] * ci + ai[q] * cr + xi.x;
      const float s1r = ar[q] * s0r - ai[q] * s0i + xr.y, s1i = ar[q] * s0i + ai[q] * s0r + xi.y;
      const float s2r = ar[q] * s1r - ai[q] * s1i + xr.z, s2i = ar[q] * s1i + ai[q] * s1r + xi.z;
      const float s3r = ar[q] * s2r - ai[q] * s2i + xr.w, s3i = ar[q] * s2i + ai[q] * s2r + xi.w;
      if (SAMPLE) { hr[q] = s3r; hi[q] = s3i; }
      else { hr[q] = __shfl(s3r, 48 + pl); hi[q] = __shfl(s3i, 48 + pl); }
      sr4[q] = f32x4{s0r, s1r, s2r, s3r}; si4[q] = f32x4{s0i, s1i, s2i, s3i};
    }
#pragma unroll
    for (int r = 0; r < 4; ++r) {
      u32x4 o;
      o.x = pk2(sr4[0][r], si4[0][r]); o.y = pk2(sr4[1][r], si4[1][r]); o.z = pk2(sr4[2][r], si4[2][r]); o.w = pk2(sr4[3][r], si4[3][r]);
      *(u32x4*)(Hs + (q4 * 4 + r) * 136 + pl * 8) = o;
    }
    asm volatile("s_waitcnt lgkmcnt(0)" ::: "memory");
    f32x4 y = z4;
#pragma unroll
    for (int ks = 0; ks < 4; ++ks) {
      const bf16x8 hf = *(const bf16x8*)(Hs + pl * 136 + ks * 32 + q4 * 8);
      y = __builtin_amdgcn_mfma_f32_16x16x32_bf16(hf, cm[ks], y, 0, 0, 0);
    }
    y = __builtin_amdgcn_mfma_f32_16x16x16bf16_1k(uf, dmv, y, 0, 0, 0);
    asm volatile("s_waitcnt lgkmcnt(0)" ::: "memory");
    bf16_t* GY = (bf16_t*)(ws + OFF_GY);
    bf16_t* dst = GY + (size_t)(Rt + q4 * 4) * 512 + g * 16 + pl;
    dst[0] = f2bf(gelu_tanh(y.x)); dst[512] = f2bf(gelu_tanh(y.y)); dst[1024] = f2bf(gelu_tanh(y.z)); dst[1536] = f2bf(gelu_tanh(y.w));
  }
  if (!SAMPLE) {
    if (c == 15 && q4 == 0) {
#pragma unroll
      for (int q = 0; q < 4; ++q) {
        p.out[O_HRP + ((size_t)s * 32 + g) * 64 + q * 16 + pl] = hr[q];
        p.out[O_HIP + ((size_t)s * 32 + g) * 64 + q * 16 + pl] = hi[q];
      }
    }
  } else {
    const int b = s * 4 + q4;
#pragma unroll
    for (int q = 0; q < 4; ++q) {
      p.out[O_HRS + ((size_t)b * 32 + g) * 64 + q * 16 + pl] = hr[q];
      p.out[O_HIS + ((size_t)b * 32 + g) * 64 + q * 16 + pl] = hi[q];
    }
  }
}

__device__ __forceinline__ void scan_end_unit(const Params& p, int u, int lane) {
  unsigned char* ws = p.ws;
  const int pl = lane & 15, q4 = lane >> 4;
  const bf16_t* P = (const bf16_t*)(ws + OFF_P);
  const float* AR = (const float*)(ws + OFF_AR); const float* AI = (const float*)(ws + OFF_AI);
  const bf16_t* BB = (const bf16_t*)(ws + OFF_BB);
  float* E = (float*)(ws + OFF_E);
  const int c = u & 15, g = (u >> 4) & 31, s = u >> 9, R0 = s * 2048 + c * 128;
  float ar[4], ai[4], wr_[4], wi_[4], a16r[4], a16i[4];
#pragma unroll
  for (int q = 0; q < 4; ++q) {
    const float r1 = AR[g * 64 + q * 16 + pl], i1 = AI[g * 64 + q * 16 + pl];
    ar[q] = r1; ai[q] = i1;
    const float r2 = r1 * r1 - i1 * i1, i2 = 2.f * r1 * i1;
    const float r4 = r2 * r2 - i2 * i2, i4 = 2.f * r2 * i2;
    const float r8 = r4 * r4 - i4 * i4, i8 = 2.f * r4 * i4;
    const float r12 = r8 * r4 - i8 * i4, i12 = r8 * i4 + i8 * r4;
    a16r[q] = r8 * r8 - i8 * i8; a16i[q] = 2.f * r8 * i8;
    wr_[q] = (q4 == 0) ? r12 : (q4 == 1) ? r8 : (q4 == 2) ? r4 : 1.f;
    wi_[q] = (q4 == 0) ? i12 : (q4 == 1) ? i8 : (q4 == 2) ? i4 : 0.f;
  }
  bf16x4 bb[8];
#pragma unroll
  for (int pt = 0; pt < 8; ++pt) bb[pt] = *(const bf16x4*)(BB + ((size_t)g * 128 + pt * 16 + pl) * 16 + q4 * 4);
  float er[4], ei[4];
#pragma unroll
  for (int q = 0; q < 4; ++q) { er[q] = 0.f; ei[q] = 0.f; }
  const bf16_t* up = P + (size_t)(R0 + pl) * PW + g * 16 + q4 * 4;
  bf16x4 uf_next = *(const bf16x4*)up;
  const f32x4 z4 = f32x4{0.f, 0.f, 0.f, 0.f};
#pragma unroll 2
  for (int tile = 0; tile < 8; ++tile) {
    const bf16x4 uf = uf_next;
    if (tile + 1 < 8) uf_next = *(const bf16x4*)(up + (size_t)(tile + 1) * 16 * PW);
#pragma unroll
    for (int q = 0; q < 4; ++q) {
      const f32x4 xr = __builtin_amdgcn_mfma_f32_16x16x16bf16_1k(uf, bb[q], z4, 0, 0, 0);
      const f32x4 xi = __builtin_amdgcn_mfma_f32_16x16x16bf16_1k(uf, bb[q + 4], z4, 0, 0, 0);
      float tr = xr.x, ti = xi.x, nr_, ni_;
      nr_ = ar[q] * tr - ai[q] * ti + xr.y; ni_ = ar[q] * ti + ai[q] * tr + xi.y; tr = nr_; ti = ni_;
      nr_ = ar[q] * tr - ai[q] * ti + xr.z; ni_ = ar[q] * ti + ai[q] * tr + xi.z; tr = nr_; ti = ni_;
      nr_ = ar[q] * tr - ai[q] * ti + xr.w; ni_ = ar[q] * ti + ai[q] * tr + xi.w; tr = nr_; ti = ni_;
      float sr = wr_[q] * tr - wi_[q] * ti, si = wr_[q] * ti + wi_[q] * tr;
      sr += __shfl_xor(sr, 16); si += __shfl_xor(si, 16);
      sr += __shfl_xor(sr, 32); si += __shfl_xor(si, 32);
      nr_ = a16r[q] * er[q] - a16i[q] * ei[q] + sr; ni_ = a16r[q] * ei[q] + a16i[q] * er[q] + si;
      er[q] = nr_; ei[q] = ni_;
    }
  }
  if (q4 == 0) {
    float* Eb = E + ((size_t)(s * 32 + g) * 16 + c) * 128;
#pragma unroll
    for (int q = 0; q < 4; ++q) { Eb[q * 16 + pl] = er[q]; Eb[64 + q * 16 + pl] = ei[q]; }
  }
}

template <bool LDSRC>
__device__ __forceinline__ void attn_core(const Params& p, const int lane, const char* kptr, const int kstride, const char* vptr, const int vstride,
                                          const int kt0, const int has_prev, const int row_q, const int h_q, const int i_q) {
  unsigned char* ws = p.ws;
  const int pl = lane & 15, q4 = lane >> 4;
  const bf16_t* P = (const bf16_t*)(ws + OFF_P);
  const float sink = p.in[17][h_q];
  const bf16_t* qp = P + (size_t)row_q * PW + 512 + h_q * 64 + q4 * 8;
  const bf16x8 qf0 = *(const bf16x8*)qp, qf1 = *(const bf16x8*)(qp + 32);
  u32x4 vfr[LDSRC ? 1 : 5][4];
  if constexpr (!LDSRC) {
#pragma unroll
    for (int pp = 0; pp < 5; ++pp) {
      int TA = kt0 + 2 * pp, TB = kt0 + ((2 * pp + 1 < 9) ? 2 * pp + 1 : 2 * pp);
      if (!has_prev) { if (TA < 8) TA = 8; if (TB < 8) TB = 8; }
#pragma unroll
      for (int dt = 0; dt < 4; ++dt) {
        const char* vp = vptr + (dt * 16 + pl) * vstride + q4 * 8;
        const u32x2 va = *(const u32x2*)(vp + TA * 32), vb = *(const u32x2*)(vp + TB * 32);
        vfr[pp][dt] = u32x4{va.x, va.y, vb.x, vb.y};
      }
    }
  }
  f32x4 sa[9];
#pragma unroll
  for (int kt = 0; kt < 9; ++kt) {
    int T = kt0 + kt; if (!has_prev && T < 8) T = 8;
    const char* kp = kptr + (T * 16 + pl) * kstride + q4 * 16;
    bf16x8 k0, k1;
    if constexpr (LDSRC) { k0 = *(const LAS bf16x8*)(const LAS char*)kp; k1 = *(const LAS bf16x8*)(const LAS char*)(kp + 64); }
    else { k0 = *(const bf16x8*)kp; k1 = *(const bf16x8*)(kp + 64); }
    f32x4 a = f32x4{0.f, 0.f, 0.f, 0.f};
    a = __builtin_amdgcn_mfma_f32_16x16x32_bf16(k0, qf0, a, 0, 0, 0);
    a = __builtin_amdgcn_mfma_f32_16x16x32_bf16(k1, qf1, a, 0, 0, 0);
    sa[kt] = a;
  }
  float mx = -INFINITY;
#pragma unroll
  for (int kt = 0; kt < 9; ++kt) {
#pragma unroll
    for (int r = 0; r < 4; ++r) {
      const int sj = (kt0 + kt) * 16 + q4 * 4 + r;
      const bool valid = (sj > i_q) && (sj <= i_q + 128) && (has_prev || sj >= 128);
      const float v = valid ? sa[kt][r] * 0.125f : -INFINITY;
      sa[kt][r] = v; mx = fmaxf(mx, v);
    }
  }
  mx = fmaxf(mx, __shfl_xor(mx, 16)); mx = fmaxf(mx, __shfl_xor(mx, 32));
  mx = fmaxf(mx, sink);
  float sum = 0.f;
#pragma unroll
  for (int kt = 0; kt < 9; ++kt) {
#pragma unroll
    for (int r = 0; r < 4; ++r) { const float e = __expf(sa[kt][r] - mx); sa[kt][r] = e; sum += e; }
  }
  sum += __shfl_xor(sum, 16); sum += __shfl_xor(sum, 32);
  const float inv = 1.f / (sum + __expf(sink - mx));
  f32x4 oa[4];
#pragma unroll
  for (int dt = 0; dt < 4; ++dt) oa[dt] = f32x4{0.f, 0.f, 0.f, 0.f};
#pragma unroll
  for (int pp = 0; pp < 5; ++pp) {
    const int kA = 2 * pp, kB = (2 * pp + 1 < 9) ? 2 * pp + 1 : 2 * pp;
    u32x4 pw;
    pw.x = pk2(sa[kA][0] * inv, sa[kA][1] * inv); pw.y = pk2(sa[kA][2] * inv, sa[kA][3] * inv);
    if (2 * pp + 1 < 9) { pw.z = pk2(sa[kB][0] * inv, sa[kB][1] * inv); pw.w = pk2(sa[kB][2] * inv, sa[kB][3] * inv); }
    else { pw.z = 0u; pw.w = 0u; }
    const bf16x8 pf = __builtin_bit_cast(bf16x8, pw);
    if constexpr (LDSRC) {
      int TA = kt0 + 2 * pp, TB = kt0 + ((2 * pp + 1 < 9) ? 2 * pp + 1 : 2 * pp);
      if (!has_prev) { if (TA < 8) TA = 8; if (TB < 8) TB = 8; }
#pragma unroll
      for (int dt = 0; dt < 4; ++dt) {
        const char* vp = vptr + (dt * 16 + pl) * vstride + q4 * 8;
        const u32x2 va = *(const LAS u32x2*)(const LAS char*)(vp + TA * 32), vb = *(const LAS u32x2*)(const LAS char*)(vp + TB * 32);
        oa[dt] = __builtin_amdgcn_mfma_f32_16x16x32_bf16(__builtin_bit_cast(bf16x8, u32x4{va.x, va.y, vb.x, vb.y}), pf, oa[dt], 0, 0, 0);
      }
    } else {
#pragma unroll
      for (int dt = 0; dt < 4; ++dt) oa[dt] = __builtin_amdgcn_mfma_f32_16x16x32_bf16(__builtin_bit_cast(bf16x8, vfr[pp][dt]), pf, oa[dt], 0, 0, 0);
    }
  }
  bf16_t* O = (bf16_t*)(ws + OFF_O);
#pragma unroll
  for (int dt = 0; dt < 4; ++dt) *(u32x2*)(O + (size_t)row_q * 512 + h_q * 64 + dt * 16 + q4 * 4) = pk4(oa[dt]);
}

__device__ __forceinline__ void attn_sample_unit(const Params& p, int us, int lane) {
  const int pl = lane & 15, kv = us & 1, b = us >> 1, tt = pl >> 2, g = pl & 3;
  const bf16_t* Ks = (const bf16_t*)(p.ws + OFF_KS); const bf16_t* Vts = (const bf16_t*)(p.ws + OFF_VTS);
  attn_core<false>(p, lane, (const char*)(Ks + (size_t)b * 144 * 128 + kv * 64), 256, (const char*)(Vts + (size_t)(b * 2 + kv) * 64 * 144), 288,
                   0, 1, MP + b * 4 + tt, kv * 4 + g, tt);
}

constexpr int ATT_KSTR = 144, ATT_VSTR = 528, ATT_VOFF = 256 * ATT_KSTR;
__device__ __forceinline__ void attn_block_unit(const Params& p, int bu, char* lds, int tid) {
  const int b = bu >> 5, kv = (bu >> 4) & 1, blk = bu & 15, lane = tid & 63, wid = tid >> 6;
  const bf16_t* Kp = (const bf16_t*)(p.ws + OFF_KP); const bf16_t* Vtp = (const bf16_t*)(p.ws + OFF_VTP);
  char* K_l = lds; char* Vt_l = lds + ATT_VOFF;
  u32x4 kr[4], vr[4];
#pragma unroll
  for (int i = 0; i < 4; ++i) {
    const int piece = tid + i * NTHR, key = piece >> 3, c = piece & 7;
    if (blk > 0 || key >= 128) kr[i] = *(const u32x4*)(Kp + ((size_t)b * 2048 + (size_t)(blk - 1) * 128 + key) * 128 + kv * 64 + c * 8);
    const int d = piece >> 5, c2 = piece & 31;
    if (blk > 0 || c2 >= 16) vr[i] = *(const u32x4*)(Vtp + ((size_t)(b * 2 + kv) * 64 + d) * 2048 + (size_t)(blk - 1) * 128 + c2 * 8);
  }
#pragma unroll
  for (int i = 0; i < 4; ++i) {
    const int piece = tid + i * NTHR, key = piece >> 3, c = piece & 7;
    if (blk > 0 || key >= 128) *(u32x4*)(K_l + key * ATT_KSTR + c * 16) = kr[i];
    const int d = piece >> 5, c2 = piece & 31;
    if (blk > 0 || c2 >= 16) *(u32x4*)(Vt_l + d * ATT_VSTR + c2 * 16) = vr[i];
  }
  __syncthreads();
  const int pl = lane & 15;
#pragma unroll 1
  for (int g = 0; g < 4; ++g) {
    asm volatile("" ::: "memory");
    attn_core<true>(p, lane, K_l, ATT_KSTR, Vt_l, ATT_VSTR, wid, blk > 0, b * 2048 + blk * 128 + wid * 16 + pl, kv * 4 + g, wid * 16 + pl);
  }
  __syncthreads();
}

template <int WHICH>
__device__ __forceinline__ void ln_phase(const Params& p) {
  const int lane = threadIdx.x & 63, wid = threadIdx.x >> 6;
  const int gw = blockIdx.x * NWAVE + wid, NGW = gridDim.x * NWAVE;
  const float* gam = p.in[WHICH == 1 ? 20 : 26]; const float* bet = p.in[WHICH == 1 ? 21 : 27];
  f32x4 gv[4], bv[4];
#pragma unroll
  for (int j = 0; j < 4; ++j) { gv[j] = *(const f32x4*)(gam + j * 256 + lane * 4); bv[j] = *(const f32x4*)(bet + j * 256 + lane * 4); }
  bf16_t* X1b = (bf16_t*)(p.ws + OFF_X1B);
  for (int rp = gw; rp < MT / 2; rp += NGW) {
    f32x4 v[2][4];
#pragma unroll
    for (int h = 0; h < 2; ++h) {
      const int row = rp * 2 + h;
      if (row < MP) {
        const bf16_t* xr = (const bf16_t*)(p.ws + (WHICH == 1 ? OFF_PRE1 : OFF_PRE2)) + (size_t)row * DM;
#pragma unroll
        for (int j = 0; j < 4; ++j) v[h][j] = unpk4(*(const u32x2*)(xr + j * 256 + lane * 4));
      } else {
        const float* SL = (const float*)(p.ws + (WHICH == 1 ? OFF_SLAB_WO : OFF_SLAB_DN)) + (size_t)(row - MP) * DM;
        constexpr int NS = (WHICH == 1) ? 8 : 11;
#pragma unroll
        for (int j = 0; j < 4; ++j) {
          f32x4 a;
          if (WHICH == 1) a = *(const f32x4*)(p.in[1] + (size_t)(row - MP) * DM + j * 256 + lane * 4) * ALPHA_F;
          else a = unpk4(*(const u32x2*)(X1b + (size_t)row * DM + j * 256 + lane * 4)) * ALPHA_F;
#pragma unroll
          for (int q = 0; q < NS; ++q) a += *(const f32x4*)(SL + (size_t)q * MS * DM + j * 256 + lane * 4);
          v[h][j] = a;
        }
      }
    }
    float s[2], s2[2];
#pragma unroll
    for (int h = 0; h < 2; ++h) { s[h] = 0.f;
#pragma unroll
      for (int j = 0; j < 4; ++j) s[h] += (v[h][j].x + v[h][j].y) + (v[h][j].z + v[h][j].w); }
#pragma unroll
    for (int o = 1; o < 64; o <<= 1) { s[0] += __shfl_xor(s[0], o); s[1] += __shfl_xor(s[1], o); }
#pragma unroll
    for (int h = 0; h < 2; ++h) { const float mean = s[h] * (1.f / DM); s2[h] = 0.f;
#pragma unroll
      for (int j = 0; j < 4; ++j) { v[h][j] = v[h][j] - mean; s2[h] += (v[h][j].x * v[h][j].x + v[h][j].y * v[h][j].y) + (v[h][j].z * v[h][j].z + v[h][j].w * v[h][j].w); } }
#pragma unroll
    for (int o = 1; o < 64; o <<= 1) { s2[0] += __shfl_xor(s2[0], o); s2[1] += __shfl_xor(s2[1], o); }
#pragma unroll
    for (int h = 0; h < 2; ++h) {
      const int row = rp * 2 + h;
      const float rstd = rsqrtf(s2[h] * (1.f / DM) + LN_EPS_F);
#pragma unroll
      for (int j = 0; j < 4; ++j) {
        const f32x4 o = v[h][j] * rstd * gv[j] + bv[j];
        if (WHICH == 1) *(u32x2*)(X1b + (size_t)row * DM + j * 256 + lane * 4) = pk4(o);
        else *(f32x4*)(p.out + (size_t)row * DM + j * 256 + lane * 4) = o;
      }
    }
  }
}

__device__ __forceinline__ void fixup_phase(const Params& p) {
  unsigned char* ws = p.ws;
  const int gt = blockIdx.x * NTHR + threadIdx.x, NGT = gridDim.x * NTHR;
  const float* HA0 = (const float*)(ws + OFF_HA0); const float* HG0 = (const float*)(ws + OFF_HG0); const float* HA1 = (const float*)(ws + OFF_HA1);
  bf16_t* H = (bf16_t*)(ws + OFF_H);
  constexpr int NJ4 = DFF / 4;
  for (int i = gt; i < NRB * 2 * NJ4; i += NGT) {
    const int j4 = i % NJ4, rl = (i / NJ4) & 1, rb = i / (2 * NJ4);
    if ((rb & 31) == 0) continue;
    const int j0 = j4 * 4;
    const f32x4 a0 = *(const f32x4*)(HA0 + ((size_t)rb * 2 + rl) * DFF + j0);
    const f32x4 g = *(const f32x4*)(HG0 + ((size_t)rb * 2 + rl) * DFF + j0);
    const f32x4 pm1 = *(const f32x4*)(HA1 + ((size_t)(rb - 1) * 2 + 1) * DFF + j0);
    const f32x4 pm2 = *(const f32x4*)(HA1 + ((size_t)(rb - 1) * 2 + 0) * DFF + j0);
    f32x4 am1, am2;
    if (rl == 0) { am1 = pm1; am2 = pm2; }
    else { am1 = *(const f32x4*)(HA0 + ((size_t)rb * 2 + 0) * DFF + j0); am2 = pm1; }
    const f32x4 w0 = *(const f32x4*)(p.in[23] + j0), w1 = *(const f32x4*)(p.in[23] + DFF + j0), w2 = *(const f32x4*)(p.in[23] + 2 * DFF + j0);
    const f32x4 cb = *(const f32x4*)(p.in[24] + j0);
    f32x4 h;
    h.x = gelu_tanh(cb.x + w0.x * am2.x + w1.x * am1.x + w2.x * a0.x) * g.x;
    h.y = gelu_tanh(cb.y + w0.y * am2.y + w1.y * am1.y + w2.y * a0.y) * g.y;
    h.z = gelu_tanh(cb.z + w0.z * am2.z + w1.z * am1.z + w2.z * a0.z) * g.z;
    h.w = gelu_tanh(cb.w + w0.w * am2.w + w1.w * am1.w + w2.w * a0.w) * g.w;
    *(u32x2*)(H + ((size_t)rb * 64 + rl) * DFF + j0) = pk4(h);
  }
}

#define XB_TMO      128
#define XB_XCNT(j)  (256  + 64 * (j))
#define XB_XSUB(j)  (1280 + 64 * (j))
#define XB_XGEN(j)  (2304 + 64 * (j))
#define XB_TOP      3328
#define XB_TOPGEN   3392
#define XCD_BAR_WORDS 3456
#define XB_SPIN_CAP (1u << 18)
__device__ __forceinline__ unsigned xb_ld(unsigned* p)              { return __hip_atomic_load(p, __ATOMIC_RELAXED, __HIP_MEMORY_SCOPE_AGENT); }
__device__ __forceinline__ unsigned xb_add(unsigned* p, unsigned v) { return __hip_atomic_fetch_add(p, v, __ATOMIC_RELAXED, __HIP_MEMORY_SCOPE_AGENT); }
__device__ __forceinline__ unsigned xb_xcc_id() { return (unsigned)__builtin_amdgcn_s_getreg((3 << 11) | 20) & 0xFu; }
#define XB_SPIN(cond, bar) do { unsigned _sp = 0; while (cond) { __builtin_amdgcn_s_sleep(1); \
    if ((++_sp & 255u) == 0u) { if (xb_ld(&(bar)[XB_TMO])) break; if (_sp > XB_SPIN_CAP) { atomicAdd(&(bar)[XB_TMO], 1u); break; } } } } while (0)
#define XB_EXIT 64
__device__ unsigned g_xbar[XCD_BAR_WORDS + 64];
struct XcdBarrier { unsigned* bar; unsigned x; volatile LAS unsigned* st; };
__device__ __forceinline__ XcdBarrier xcd_barrier_post(unsigned* bar, volatile LAS unsigned* st) {
    XcdBarrier b; b.bar = bar; b.x = xb_xcc_id(); b.st = st;
    if (threadIdx.x == 0) (void)xb_add(&bar[XB_XCNT(b.x)], 1u);
    return b;
}
__device__ __forceinline__ void xcd_barrier_complete(unsigned* bar, unsigned x, unsigned& nloc, unsigned& nx) {
    const unsigned G = gridDim.x * gridDim.y * gridDim.z;
    unsigned sum, cnt, mine, sp = 0u;
    for (;;) {
        sum = 0u; cnt = 0u; mine = 0u;
#pragma unroll
        for (unsigned j = 0; j < 16; ++j) { const unsigned c = xb_ld(&bar[XB_XCNT(j)]); sum += c; cnt += (c > 0u) ? 1u : 0u; mine = (j == x) ? c : mine; }
        if (sum == G) break;
        __builtin_amdgcn_s_sleep(1);
        if ((++sp & 255u) == 0u) { if (xb_ld(&bar[XB_TMO])) break; if (sp > XB_SPIN_CAP) { atomicAdd(&bar[XB_TMO], 1u); break; } }
    }
    nloc = mine > 0u ? mine : 1u; nx = cnt > 0u ? cnt : 1u;
}
__device__ __forceinline__ void xcd_barrier(const XcdBarrier& b) {
    asm volatile("s_waitcnt vmcnt(0)" ::: "memory");
    __syncthreads();
    if (threadIdx.x == 0) {
        unsigned* bar = b.bar;
        __builtin_amdgcn_s_waitcnt(0);
        unsigned nloc = b.st[0], nx = b.st[1];
        if (nloc == 0u) { xcd_barrier_complete(bar, b.x, nloc, nx); b.st[0] = nloc; b.st[1] = nx; }
        const unsigned old = xb_add(&bar[XB_XSUB(b.x)], 1u);
        const unsigned gen = old / nloc;
        if (old + 1u == (gen + 1u) * nloc) {
            __builtin_amdgcn_fence(__ATOMIC_RELEASE, "agent");
            asm volatile("s_waitcnt vmcnt(0)" ::: "memory");
            const unsigned og = xb_add(&bar[XB_TOP], 1u);
            const unsigned tg = og / nx;
            if (og + 1u == (tg + 1u) * nx) xb_add(&bar[XB_TOPGEN], 1u);
            else XB_SPIN(xb_ld(&bar[XB_TOPGEN]) == tg, bar);
            __builtin_amdgcn_fence(__ATOMIC_ACQUIRE, "agent");
            xb_add(&bar[XB_XGEN(b.x)], 1u);
            asm volatile("s_waitcnt vmcnt(0)" ::: "memory");
        } else {
            XB_SPIN(xb_ld(&bar[XB_XGEN(b.x)]) == gen, bar);
            __builtin_amdgcn_fence(__ATOMIC_ACQUIRE, "agent");
            asm volatile("s_waitcnt vmcnt(0)" ::: "memory");
        }
    }
    __syncthreads();
}
#define GSYNC() xcd_barrier(xb)

__device__ __forceinline__ void sample_merge(const Params& p) {
  unsigned char* ws = p.ws;
  const bf16_t* P = (const bf16_t*)(ws + OFF_P); bf16_t* Mg = (bf16_t*)(ws + OFF_MG);
  const float* SLG = (const float*)(ws + OFF_SLAB_GLU); const float* SLA = (const float*)(ws + OFF_SLAB_ATT);
  for (int i = blockIdx.x * NTHR + threadIdx.x; i < MS * (DM / 4); i += gridDim.x * NTHR) {
    const int r = i >> 8, j = (i & 255) * 4;
    const int tj = j >> 7, jl = j & 127, va = tj * 256 + (jl >> 6) * 128 + ((jl >> 4) & 3) * 32 + (jl & 15);
    f32x4 ya = f32x4{0.f, 0.f, 0.f, 0.f}, yb = ya, at = ya;
#pragma unroll
    for (int q = 0; q < 4; ++q) {
      ya += *(const f32x4*)(SLG + ((size_t)q * MS + r) * 2048 + va);
      yb += *(const f32x4*)(SLG + ((size_t)q * MS + r) * 2048 + va + 16);
      at += *(const f32x4*)(SLA + ((size_t)q * MS + r) * DM + j);
    }
    const size_t row = (size_t)MP + r;
    const f32x4 gs = unpk4(*(const u32x2*)(P + row * PW + 1024 + j)), ga = unpk4(*(const u32x2*)(P + row * PW + 2048 + j));
    f32x4 sv;
    sv.x = gs.x * ya.x * sigmoidf_(yb.x); sv.y = gs.y * ya.y * sigmoidf_(yb.y); sv.z = gs.z * ya.z * sigmoidf_(yb.z); sv.w = gs.w * ya.w * sigmoidf_(yb.w);
    sv = unpk4(pk4(sv));
    sv.x += ga.x * at.x; sv.y += ga.y * at.y; sv.z += ga.z * at.z; sv.w += ga.w * at.w;
    *(u32x2*)(Mg + row * DM + j) = pk4(sv);
  }
}

__global__ void __launch_bounds__(512) fwd_megakernel(Params p) {
  extern __shared__ __attribute__((aligned(16))) char lds[];
  cg::grid_group grid = cg::this_grid();
  volatile LAS unsigned* xst = (volatile LAS unsigned*)(lds + GEMM_LDS);
  if (threadIdx.x == 0) { xst[0] = 0u; xst[1] = 0u; }
  __syncthreads();
  XcdBarrier xb = xcd_barrier_post(g_xbar, xst);
  if (p.ws == nullptr) grid.sync();
  unsigned char* ws = p.ws;
  LAS unsigned char* glds = (LAS unsigned char*)lds;
  const int lane = threadIdx.x & 63, wid = threadIdx.x >> 6;
  const int gw = blockIdx.x * NWAVE + wid, NGW = gridDim.x * NWAVE;

  prep_phase(p, lds);
  GSYNC();
  gemm_phase<EPI_IN>(p, (const bf16_t*)(ws + OFF_B), (const bf16_t*)(ws + OFF_WIN), 1024, DIN, glds);
  GSYNC();
  {
    for (int bu = blockIdx.x; bu < 256; bu += gridDim.x) attn_block_unit(p, bu, lds, threadIdx.x);
    bf16_t* Hs = (bf16_t*)(lds + wid * 4352);
    constexpr int N_S1 = 8 * 32 * 16, N_SS = 32 * 32, N_AT = 256;
    for (int u = gw; u < N_S1 + N_SS + N_AT; u += NGW) {
      if (u < N_S1) { if ((u & 15) != 15) scan_end_unit(p, u, lane); }
      else if (u < N_S1 + N_SS) scan_full_unit<true>(p, u - N_S1, lane, Hs);
      else attn_sample_unit(p, u - N_S1 - N_SS, lane);
    }
  }
  GSYNC();
  {
    bf16_t* Hs = (bf16_t*)(lds + wid * 4352);
    for (int u = gw; u < 8 * 32 * 16; u += NGW) scan_unit<1>(p, u, lane, Hs);
  }
  GSYNC();
  gemm_phase<EPI_GLU>(p, (const bf16_t*)(ws + OFF_GY), (const bf16_t*)(ws + OFF_WGLU), 512, 2048, glds, (const bf16_t*)(ws + OFF_O), (const bf16_t*)(ws + OFF_WATT));
  GSYNC();
  gemm_phase<EPI_ATT>(p, (const bf16_t*)(ws + OFF_O), (const bf16_t*)(ws + OFF_WATT), 512, 1024, glds);
  sample_merge(p);
  GSYNC();
  gemm_phase<EPI_WO>(p, (const bf16_t*)(ws + OFF_MG), (const bf16_t*)(ws + OFF_WO), 1024, 1024, glds);
  GSYNC();
  ln_phase<1>(p);
  GSYNC();
  gemm_phase<EPI_UP>(p, (const bf16_t*)(ws + OFF_X1B), (const bf16_t*)(ws + OFF_WUP), 1024, 5632, glds);
  GSYNC();
  fixup_phase(p);
  GSYNC();
  gemm_phase<EPI_DOWN>(p, (const bf16_t*)(ws + OFF_H), (const bf16_t*)(ws + OFF_WDN), DFF, 1024, glds);
  GSYNC();
  ln_phase<2>(p);
  __syncthreads();
  if (threadIdx.x == 0) {
    unsigned* bar = g_xbar;
    const unsigned old = xb_add(&bar[XB_EXIT], 1u);
    if (old == gridDim.x - 1u) {
#pragma unroll
      for (int j = 0; j < 16; ++j) {
        __hip_atomic_store(&bar[XB_XCNT(j)], 0u, __ATOMIC_RELAXED, __HIP_MEMORY_SCOPE_AGENT);
        __hip_atomic_store(&bar[XB_XSUB(j)], 0u, __ATOMIC_RELAXED, __HIP_MEMORY_SCOPE_AGENT);
        __hip_atomic_store(&bar[XB_XGEN(j)], 0u, __ATOMIC_RELAXED, __HIP_MEMORY_SCOPE_AGENT);
      }
      __hip_atomic_store(&bar[XB_TOP], 0u, __ATOMIC_RELAXED, __HIP_MEMORY_SCOPE_AGENT);
      __hip_atomic_store(&bar[XB_TOPGEN], 0u, __ATOMIC_RELAXED, __HIP_MEMORY_SCOPE_AGENT);
      __hip_atomic_store(&bar[XB_TMO], 0u, __ATOMIC_RELAXED, __HIP_MEMORY_SCOPE_AGENT);
      __hip_atomic_store(&bar[XB_EXIT], 0u, __ATOMIC_RELAXED, __HIP_MEMORY_SCOPE_AGENT);
    }
  }
}

extern "C" void kernel_launch(void* const* d_in, const int* in_sizes, int n_in, void* d_out, int out_size, void* d_ws, size_t ws_size, hipStream_t stream) {
  static int grid_blocks = 0;
  if (grid_blocks == 0) {
    if (n_in != 28 || ws_size < WS_TOTAL) { fprintf(stderr, "kernel_launch: unexpected n_in %d or ws_size %zu (< %zu)\n", n_in, ws_size, (size_t)WS_TOTAL); grid_blocks = -1; return; }
    int dev = 0, cus = 0, per_cu = 0;
    (void)hipGetDevice(&dev);
    (void)hipDeviceGetAttribute(&cus, hipDeviceAttributeMultiprocessorCount, dev);
    (void)hipFuncSetAttribute((const void*)fwd_megakernel, hipFuncAttributeMaxDynamicSharedMemorySize, LDS_BYTES);
    (void)hipOccupancyMaxActiveBlocksPerMultiprocessor(&per_cu, (const void*)fwd_megakernel, NTHR, LDS_BYTES);
    if (per_cu < 1) { fprintf(stderr, "kernel_launch: occupancy query returned %d\n", per_cu); per_cu = 1; }
    if (per_cu > 1) per_cu = 1;
    grid_blocks = cus * per_cu;
    fprintf(stderr, "kernel_launch: cus %d per_cu %d grid %d\n", cus, per_cu, grid_blocks);
  }
  if (grid_blocks < 0) return;
  Params p{};
  for (int i = 0; i < 28; ++i) p.in[i] = (const float*)d_in[i];
  p.out = (float*)d_out; p.ws = (unsigned char*)d_ws;
  void* args[] = {&p};
  hipError_t e = hipLaunchCooperativeKernel((const void*)fwd_megakernel, dim3(grid_blocks), dim3(NTHR), args, LDS_BYTES, stream);
  if (e != hipSuccess) fprintf(stderr, "cooperative launch failed: %s (grid %d)\n", hipGetErrorString(e), grid_blocks);
}
```

```cpp
#include <hip/hip_runtime.h>
#include <hip/hip_cooperative_groups.h>
#include <cstdio>
#include <cstdint>
namespace cg = cooperative_groups;

typedef unsigned short bf16_t;
typedef short bf16x8 __attribute__((ext_vector_type(8)));
typedef short bf16x4 __attribute__((ext_vector_type(4)));
typedef float f32x4 __attribute__((ext_vector_type(4)));
typedef unsigned u32x2 __attribute__((ext_vector_type(2)));
typedef unsigned u32x4 __attribute__((ext_vector_type(4)));

constexpr int MP = 16384, MS = 512, MT = MP + MS;
constexpr int DM = 1024, DIN = 3328, PW = 3072, DFF = 2816;
constexpr int NRB = MP / 64;
constexpr float ALPHA_F = 1.189207115002721f;
constexpr float LN_EPS_F = 1e-5f;

constexpr size_t O_YP = 0, O_YS = 16777216, O_KP = 17301504, O_VP = 17432576, O_KS = 17563648, O_VS = 19660800,
                 O_HRP = 21757952, O_HIP = 21774336, O_HRS = 21790720, O_HIS = 22052864, O_CP = 22315008, O_CS = 22360064;

constexpr size_t OFF_P = 0;
constexpr size_t OFF_H = 0;
constexpr size_t OFF_B = (size_t)MT * PW * 2;
constexpr size_t OFF_GY = OFF_B, OFF_O = OFF_B + (size_t)MT * 512 * 2;
constexpr size_t OFF_C = OFF_B + (size_t)MT * DM * 2;
constexpr size_t OFF_MG = OFF_C;
constexpr size_t OFF_X1B = OFF_C + (size_t)MT * DM * 2;
constexpr size_t OFF_KP = OFF_C + (size_t)MT * DM * 2;
constexpr size_t OFF_VTP = OFF_KP + (size_t)8 * 2048 * 128 * 2;
constexpr size_t OFF_KS = OFF_VTP + (size_t)8 * 2048 * 128 * 2;
constexpr size_t OFF_VTS = OFF_KS + (size_t)128 * 144 * 128 * 2;
constexpr size_t OFF_W = OFF_C + (size_t)MT * DM * 4;
constexpr size_t OFF_WIN = OFF_W;
constexpr size_t OFF_WGLU = OFF_WIN + (size_t)DIN * 1024 * 2;
constexpr size_t OFF_WATT = OFF_WGLU + (size_t)2048 * 512 * 2;
constexpr size_t OFF_WO = OFF_WATT + (size_t)1024 * 512 * 2;
constexpr size_t OFF_WUP = OFF_WO + (size_t)1024 * 1024 * 2;
constexpr size_t OFF_WDN = OFF_WUP + (size_t)5632 * 1024 * 2;
constexpr size_t OFF_SSM = OFF_WDN + (size_t)1024 * DFF * 2;
constexpr size_t OFF_AR = OFF_SSM, OFF_AI = OFF_SSM + 8192, OFF_BB = OFF_SSM + 16384;
constexpr size_t OFF_E = OFF_BB + 131072;
constexpr size_t OFF_HA0 = OFF_E + (size_t)8 * 32 * 16 * 128 * 4;
constexpr size_t OFF_HG0 = OFF_HA0 + (size_t)NRB * 2 * DFF * 4;
constexpr size_t OFF_HA1 = OFF_HG0 + (size_t)NRB * 2 * DFF * 4;
constexpr size_t WS_END = OFF_HA1 + (size_t)NRB * 2 * DFF * 4;
static_assert(OFF_VTS + (size_t)128 * 144 * 128 * 2 <= OFF_W, "KV overlay overflow");
static_assert(WS_END <= (size_t)256 * 1024 * 1024, "workspace too large");

constexpr size_t OFF_BAR = WS_END;
constexpr size_t WS_TOTAL = OFF_BAR + 16384;
static_assert(WS_TOTAL <= (size_t)256 * 1024 * 1024, "workspace too large");
constexpr size_t OFF_SLAB_WO = OFF_P;
constexpr size_t OFF_SLAB_DN = OFF_B;
static_assert((size_t)11 * MS * DM * 4 <= (size_t)MT * DM * 2, "down slabs must fit the X1b region");
constexpr size_t OFF_SLAB_GLU = OFF_KP;
constexpr size_t OFF_SLAB_ATT = OFF_KP + (size_t)4 * MS * 2048 * 4;
static_assert(OFF_SLAB_ATT + (size_t)4 * MS * DM * 4 <= OFF_W, "GLU/attn slabs must fit the dead K/V + x1 region");
constexpr size_t OFF_PRE1 = OFF_B;
constexpr size_t OFF_PRE2 = OFF_C;
constexpr int GEMM_LDS = 131072;
constexpr int LDS_BYTES = GEMM_LDS + 16;
constexpr int NTHR = 512, NWAVE = 8;

struct Params {
  const float* in[28];
  float* out;
  unsigned char* ws;
};

typedef __bf16 bf16v2_t __attribute__((ext_vector_type(2)));
typedef float f32x2 __attribute__((ext_vector_type(2)));
__device__ __forceinline__ unsigned pk2(float lo, float hi) { f32x2 v = {lo, hi}; bf16v2_t b = __builtin_convertvector(v, bf16v2_t); return __builtin_bit_cast(unsigned, b); }
__device__ __forceinline__ bf16_t f2bf(float x) { return (bf16_t)(pk2(x, 0.f) & 0xffffu); }
__device__ __forceinline__ float bf2f(unsigned v16) { return __uint_as_float(v16 << 16); }
__device__ __forceinline__ float bflo(unsigned w) { return __uint_as_float(w << 16); }
__device__ __forceinline__ float bfhi(unsigned w) { return __uint_as_float(w & 0xffff0000u); }
__device__ __forceinline__ float rcp_nr(float d) { const float r = __builtin_amdgcn_rcpf(d); return fmaf(r, fmaf(-d, r, 1.f), r); }
__device__ __forceinline__ float sigmoidf_(float x) { return rcp_nr(1.f + __expf(fminf(-x, 80.f))); }
__device__ __forceinline__ float gelu_tanh(float x) { float z = 1.5957691216057308f * (x + 0.044715f * x * x * x); return x * rcp_nr(1.f + __expf(fminf(-z, 80.f))); }
__device__ __forceinline__ float wave_sum(float v) {
#pragma unroll
  for (int o = 1; o < 64; o <<= 1) v += __shfl_xor(v, o);
  return v;
}
__device__ __forceinline__ u32x2 pk4(f32x4 v) { u32x2 r; r.x = pk2(v.x, v.y); r.y = pk2(v.z, v.w); return r; }
__device__ __forceinline__ f32x4 unpk4(u32x2 w) { f32x4 r; r.x = bflo(w.x); r.y = bfhi(w.x); r.z = bflo(w.y); r.w = bfhi(w.y); return r; }


#define LAS __attribute__((address_space(3)))
namespace pg8 {
constexpr int BM = 256, BK = 64, HALF = 128, HTB = HALF * BK * 2, NXCD = 8, WGM = 8;
__device__ __forceinline__ int lds_byte(int r, int c) { const int st = (r >> 4) * 2 + (c >> 5), rr = r & 15, cc = c & 31, ob = rr * 64 + cc * 2; return st * 1024 + (ob ^ (((ob >> 9) & 1) << 5)); }
__device__ __forceinline__ void stage_rc(int b, int& R, int& C) { const int st = b / 1024, sb = b % 1024, swz = sb ^ (((sb >> 9) & 1) << 5); R = (st >> 1) * 16 + swz / 64; C = (st & 1) * 32 + (swz % 64) / 2; }
struct Unit { int pm, pn, k0, nk, slice; };
struct StaticOrder {
    int nM, nN, nwg, G, c;
    __device__ __forceinline__ void init(int M, int N, int G_, int c_) { nM = M / BM; nN = N / BM; nwg = nM * nN; G = G_; c = c_; }
    int nsplit, nslice_items, nt, glu;
    __device__ __forceinline__ bool next(int i, int& pm, int& pn, int& k0, int& nk, int& slice, int& src) const {
        const long L = (long)i * G + c;
        pm = 0; pn = 0; k0 = 0; nk = nt; slice = -1; src = 0;
        if (L < nwg) {
            int wgid = (int)L; { const int q = nwg / NXCD, r = nwg % NXCD, xcd = wgid % NXCD, off = wgid / NXCD; wgid = (xcd < r ? xcd * (q + 1) : r * (q + 1) + (xcd - r) * q) + off; }
            const int nig = WGM * nN, gid = wgid / nig, fm = gid * WGM, gsz = (nM - fm) < WGM ? (nM - fm) : WGM;
            pm = fm + ((wgid % nig) % gsz); pn = (wgid % nig) / gsz; return true;
        }
        if (nsplit == 0) return false;
        int sidx = (int)(L - nwg);
        if (sidx >= nslice_items) return false;
        int ncol = nN;
        if (glu && sidx >= 64) { sidx -= 64; src = 1; ncol = 4; }
        const int tl = sidx / nsplit; slice = sidx - tl * nsplit; pm = 64 + tl / ncol; pn = tl % ncol; nk = nt / nsplit; k0 = slice * nk; return true;
    }
};
}

enum { EPI_IN = 0, EPI_GLU = 1, EPI_ATT = 2, EPI_WO = 3, EPI_UP = 4, EPI_DOWN = 5 };

__device__ __forceinline__ float dpp_ror1(float v) { return __int_as_float(__builtin_amdgcn_update_dpp(0, __float_as_int(v), 0x121, 0xf, 0xf, false)); }
__device__ __forceinline__ float dpp_ror2(float v) { return __int_as_float(__builtin_amdgcn_update_dpp(0, __float_as_int(v), 0x122, 0xf, 0xf, false)); }
__device__ __forceinline__ float dpp_shr1_old(float old, float v) { return __int_as_float(__builtin_amdgcn_update_dpp(__float_as_int(old), __float_as_int(v), 0x111, 0xf, 0xf, false)); }
__device__ __forceinline__ float dpp_shr2_old(float old, float v) { return __int_as_float(__builtin_amdgcn_update_dpp(__float_as_int(old), __float_as_int(v), 0x112, 0xf, 0xf, false)); }
__device__ __forceinline__ f32x4 shr1v(f32x4 o, f32x4 v) { return f32x4{dpp_shr1_old(o.x, v.x), dpp_shr1_old(o.y, v.y), dpp_shr1_old(o.z, v.z), dpp_shr1_old(o.w, v.w)}; }
__device__ __forceinline__ f32x4 shr2v(f32x4 o, f32x4 v) { return f32x4{dpp_shr2_old(o.x, v.x), dpp_shr2_old(o.y, v.y), dpp_shr2_old(o.z, v.z), dpp_shr2_old(o.w, v.w)}; }
__device__ __forceinline__ f32x4 ror1v(f32x4 v) { return f32x4{dpp_ror1(v.x), dpp_ror1(v.y), dpp_ror1(v.z), dpp_ror1(v.w)}; }
__device__ __forceinline__ f32x4 ror2v(f32x4 v) { return f32x4{dpp_ror2(v.x), dpp_ror2(v.y), dpp_ror2(v.z), dpp_ror2(v.w)}; }

template <int EPI>
__device__ __forceinline__ void epilogue(const Params& p, f32x4 (&acc)[2][2][4][2], const int pm, const int pn, const int wr, const int wc, const int fr, const int fq) {
  unsigned char* ws = p.ws;
  bf16_t* P = (bf16_t*)(ws + OFF_P);
  if constexpr (EPI == EPI_IN) {
    bf16_t* Kp = (bf16_t*)(ws + OFF_KP); bf16_t* Ks = (bf16_t*)(ws + OFF_KS);
    bf16_t* Vtp = (bf16_t*)(ws + OFF_VTP); bf16_t* Vts = (bf16_t*)(ws + OFF_VTS);
#pragma unroll
    for (int bj = 0; bj < 2; ++bj) {
      const int col0 = pn * 256 + bj * 128;
#pragma unroll
      for (int ai = 0; ai < 2; ++ai)
#pragma unroll
        for (int m = 0; m < 4; ++m) {
          const int row = pm * 256 + ai * 128 + wr * 64 + m * 16 + fr;
#pragma unroll
          for (int n = 0; n < 2; ++n) {
            const int col = col0 + wc * 32 + n * 16 + fq * 4;
            f32x4 v = acc[ai][bj][m][n];
            if (col0 < 1024) {
              *(u32x2*)(P + (size_t)row * PW + col) = pk4(v);
            } else if (col0 >= 1280) {
              v.x = sigmoidf_(v.x); v.y = sigmoidf_(v.y); v.z = sigmoidf_(v.z); v.w = sigmoidf_(v.w);
              *(u32x2*)(P + (size_t)row * PW + col - 256) = pk4(v);
            } else if (col0 == 1024) {
              const int cc = col - 1024;
              if (row < MP) {
                *(u32x2*)(Kp + (size_t)row * 128 + cc) = pk4(v);
                const int pos = row & 2047;
                if (pos >= 1920) *(f32x4*)(p.out + O_KP + ((size_t)(row >> 11) * 128 + (pos - 1920)) * 128 + cc) = v;
              } else {
                const int s = row - MP, b = s >> 2, tt = s & 3;
                *(u32x2*)(Ks + ((size_t)b * 144 + 128 + tt) * 128 + cc) = pk4(v);
                *(f32x4*)(p.out + O_KS + ((size_t)b * 128 + 124 + tt) * 128 + cc) = v;
              }
            } else {
              const int cc = col - 1152, kv = cc >> 6, d = cc & 63;
              if (row < MP) {
                const int b = row >> 11, pos = row & 2047;
                bf16_t* dst = Vtp + ((size_t)(b * 2 + kv) * 64 + d) * 2048 + pos;
                dst[0] = f2bf(v.x); dst[2048] = f2bf(v.y); dst[4096] = f2bf(v.z); dst[6144] = f2bf(v.w);
                if (pos >= 1920) *(f32x4*)(p.out + O_VP + ((size_t)b * 128 + (pos - 1920)) * 128 + cc) = v;
              } else {
                const int s = row - MP, b = s >> 2, tt = s & 3;
                bf16_t* dst = Vts + ((size_t)(b * 2 + kv) * 64 + d) * 144 + 128 + tt;
                dst[0] = f2bf(v.x); dst[144] = f2bf(v.y); dst[288] = f2bf(v.z); dst[432] = f2bf(v.w);
                *(f32x4*)(p.out + O_VS + ((size_t)b * 128 + 124 + tt) * 128 + cc) = v;
              }
            }
          }
        }
    }
  } else if constexpr (EPI == EPI_GLU) {
    bf16_t* Mg = (bf16_t*)(ws + OFF_MG);
#pragma unroll
    for (int ai = 0; ai < 2; ++ai)
#pragma unroll
      for (int m = 0; m < 4; ++m) {
        const int row = pm * 256 + ai * 128 + wr * 64 + m * 16 + fr;
#pragma unroll
        for (int bj = 0; bj < 2; ++bj) {
          const int j0 = pn * 128 + bj * 64 + wc * 16 + fq * 4;
          const f32x4 ya = acc[ai][bj][m][0], yb = acc[ai][bj][m][1];
          const f32x4 gs = unpk4(*(const u32x2*)(P + (size_t)row * PW + 1024 + j0));
          f32x4 sv;
          sv.x = gs.x * ya.x * sigmoidf_(yb.x); sv.y = gs.y * ya.y * sigmoidf_(yb.y);
          sv.z = gs.z * ya.z * sigmoidf_(yb.z); sv.w = gs.w * ya.w * sigmoidf_(yb.w);
          *(u32x2*)(Mg + (size_t)row * DM + j0) = pk4(sv);
        }
      }
  } else if constexpr (EPI == EPI_ATT) {
    bf16_t* Mg = (bf16_t*)(ws + OFF_MG);
#pragma unroll
    for (int ai = 0; ai < 2; ++ai)
#pragma unroll
      for (int m = 0; m < 4; ++m) {
        const int row = pm * 256 + ai * 128 + wr * 64 + m * 16 + fr;
#pragma unroll
        for (int bj = 0; bj < 2; ++bj)
#pragma unroll
          for (int n = 0; n < 2; ++n) {
            const int col = pn * 256 + bj * 128 + wc * 32 + n * 16 + fq * 4;
            const f32x4 ga = unpk4(*(const u32x2*)(P + (size_t)row * PW + 2048 + col));
            const f32x4 sv = unpk4(*(const u32x2*)(Mg + (size_t)row * DM + col));
            f32x4 v = acc[ai][bj][m][n];
            v.x = sv.x + ga.x * v.x; v.y = sv.y + ga.y * v.y; v.z = sv.z + ga.z * v.z; v.w = sv.w + ga.w * v.w;
            *(u32x2*)(Mg + (size_t)row * DM + col) = pk4(v);
          }
      }
  } else if constexpr (EPI == EPI_WO || EPI == EPI_DOWN) {
    const bf16_t* X1b = (const bf16_t*)(ws + OFF_X1B);
#pragma unroll
    for (int ai = 0; ai < 2; ++ai)
#pragma unroll
      for (int m = 0; m < 4; ++m) {
        const int row = pm * 256 + ai * 128 + wr * 64 + m * 16 + fr;
#pragma unroll
        for (int bj = 0; bj < 2; ++bj)
#pragma unroll
          for (int n = 0; n < 2; ++n) {
            const int col = pn * 256 + bj * 128 + wc * 32 + n * 16 + fq * 4;
            f32x4 x;
            if constexpr (EPI == EPI_WO) x = *(const f32x4*)(p.in[0] + (size_t)row * DM + col);
            else x = unpk4(*(const u32x2*)(X1b + (size_t)row * DM + col));
            f32x4 v = acc[ai][bj][m][n];
            v.x += ALPHA_F * x.x; v.y += ALPHA_F * x.y; v.z += ALPHA_F * x.z; v.w += ALPHA_F * x.w;
            *(u32x2*)((bf16_t*)(ws + (EPI == EPI_WO ? OFF_PRE1 : OFF_PRE2)) + (size_t)row * DM + col) = pk4(v);
          }
      }
  } else {
    bf16_t* H = (bf16_t*)(ws + OFF_H);
    float* HA0 = (float*)(ws + OFF_HA0); float* HG0 = (float*)(ws + OFF_HG0); float* HA1 = (float*)(ws + OFF_HA1);
    const bool prompt = (pm < MP / 256);
#pragma unroll
    for (int bj = 0; bj < 2; ++bj) {
      const int j0 = pn * 128 + bj * 64 + wc * 16 + fq * 4;
      const f32x4 w0 = *(const f32x4*)(p.in[23] + j0), w1 = *(const f32x4*)(p.in[23] + DFF + j0), w2 = *(const f32x4*)(p.in[23] + 2 * DFF + j0);
      const f32x4 cb = *(const f32x4*)(p.in[24] + j0);
#pragma unroll
      for (int ai = 0; ai < 2; ++ai) {
        const int rblk = pm * 256 + ai * 128 + wr * 64;
#pragma unroll
        for (int m = 0; m < 4; ++m) {
          const int row = rblk + m * 16 + fr;
          const f32x4 a0 = acc[ai][bj][m][0], g = acc[ai][bj][m][1];
          f32x4 am1, am2; bool defer = false;
          if (prompt) {
            f32x4 o1 = f32x4{0.f, 0.f, 0.f, 0.f}, o2 = o1;
            if (m > 0) { o1 = ror1v(acc[ai][bj][m > 0 ? m - 1 : 0][0]); o2 = ror2v(acc[ai][bj][m > 0 ? m - 1 : 0][0]); }
            am1 = shr1v(o1, a0); am2 = shr2v(o2, a0);
            if (m == 0 && fr < 2 && (row & 2047) >= 2) defer = true;
            if (m == 3 && fr >= 14) *(f32x4*)(HA1 + ((size_t)(rblk >> 6) * 2 + (fr - 14)) * DFF + j0) = a0;
            const int pos = row & 2047;
            if (pos >= 2046) *(f32x4*)(p.out + O_CP + ((size_t)(row >> 11) * 2 + (pos - 2046)) * DFF + j0) = a0;
          } else {
            const int sidx = row - MP, b = sidx >> 2, tt = sidx & 3;
            const f32x4 st0 = *(const f32x4*)(p.in[6] + ((size_t)b * 2 + 0) * DFF + j0);
            const f32x4 st1 = *(const f32x4*)(p.in[6] + ((size_t)b * 2 + 1) * DFF + j0);
            const f32x4 s1 = ror1v(a0), s2 = ror2v(a0);
            am1 = (tt >= 1) ? s1 : st1;
            am2 = (tt >= 2) ? s2 : ((tt == 1) ? st1 : st0);
            if (tt >= 2) *(f32x4*)(p.out + O_CS + ((size_t)b * 2 + (tt - 2)) * DFF + j0) = a0;
          }
          if (!defer) {
            f32x4 h;
            h.x = gelu_tanh(cb.x + w0.x * am2.x + w1.x * am1.x + w2.x * a0.x) * g.x;
            h.y = gelu_tanh(cb.y + w0.y * am2.y + w1.y * am1.y + w2.y * a0.y) * g.y;
            h.z = gelu_tanh(cb.z + w0.z * am2.z + w1.z * am1.z + w2.z * a0.z) * g.z;
            h.w = gelu_tanh(cb.w + w0.w * am2.w + w1.w * am1.w + w2.w * a0.w) * g.w;
            *(u32x2*)(H + (size_t)row * DFF + j0) = pk4(h);
          } else {
            *(f32x4*)(HA0 + ((size_t)(rblk >> 6) * 2 + fr) * DFF + j0) = a0;
            *(f32x4*)(HG0 + ((size_t)(rblk >> 6) * 2 + fr) * DFF + j0) = g;
          }
        }
      }
    }
  }
}

template <int EPI>
__device__ __forceinline__ void gemm_phase(const Params& p, const bf16_t* __restrict__ gA, const bf16_t* __restrict__ gBt, const int K, const int N, LAS unsigned char* lds,
                                           const bf16_t* __restrict__ gA2 = nullptr, const bf16_t* __restrict__ gBt2 = nullptr) {
    using namespace pg8;
    int tid_ = threadIdx.x; asm volatile("" : "+v"(tid_));
    const int tid = tid_, wid = __builtin_amdgcn_readfirstlane(tid >> 6), lane = tid & 63, wr = wid >> 2, wc = wid & 3, fr = lane & 15, fq = lane >> 4;
    const int nt = K / BK;
    constexpr bool SPLIT = (EPI == EPI_WO || EPI == EPI_DOWN || EPI == EPI_GLU);
    constexpr bool PROMPT_ONLY = SPLIT || (EPI == EPI_ATT);
    constexpr int NSPLIT = (EPI == EPI_WO) ? 8 : (EPI == EPI_DOWN ? 11 : 4);
    StaticOrder S; S.init(PROMPT_ONLY ? MP : MT, N, gridDim.x, blockIdx.x);
    const int nN_ = N / BM;
    S.nt = nt; S.nsplit = SPLIT ? NSPLIT : 0; S.glu = (EPI == EPI_GLU) ? 1 : 0;
    S.nslice_items = (EPI == EPI_GLU) ? 96 : 2 * nN_ * NSPLIT;
    unsigned voff[2];
#pragma unroll
    for (int i = 0; i < 2; ++i) { int R, C; stage_rc(tid * 16 + i * 8192, R, C); voff[i] = (unsigned)(R * K + C) * 2u; }
    const size_t kstep = (size_t)(BK * 2);
    const size_t hstep = (size_t)HALF * K * 2;
    const size_t tstep = 2 * hstep;
    const unsigned ldsw = (unsigned)wid * 1024u;
    const int aoff = lds_byte(wr * 64 + fr, fq * 8), boff = lds_byte(wc * 32 + fr, fq * 8);
#define PG8_SA(b, h) (((b) * 2 + (h)) * HTB)
#define PG8_SB(b, h) ((4 + (b) * 2 + (h)) * HTB)
#define PG8_STAGE(bufoff, gbase) do { _Pragma("unroll") for (int _i = 0; _i < 2; ++_i) \
        __builtin_amdgcn_global_load_lds((const unsigned*)((const char*)(gbase) + voff[_i]), (LAS unsigned*)(lds + (bufoff) + ldsw + _i * 8192), 16, 0, 0); } while (0)
#define PG8_LDA(dst, b, h) do { _Pragma("unroll") for (int m = 0; m < 4; ++m) _Pragma("unroll") for (int k = 0; k < 2; ++k) dst[m][k] = *(const LAS bf16x8*)(lds + PG8_SA(b, h) + aoff + m * 2048 + k * 1024); } while (0)
#define PG8_LDB(dst, b, h) do { _Pragma("unroll") for (int n = 0; n < 2; ++n) _Pragma("unroll") for (int k = 0; k < 2; ++k) dst[n][k] = *(const LAS bf16x8*)(lds + PG8_SB(b, h) + boff + n * 2048 + k * 1024); } while (0)
#define PG8_MMA(ai, bj, At, Bt) do { __builtin_amdgcn_s_setprio(1); _Pragma("unroll") for (int m = 0; m < 4; ++m) _Pragma("unroll") for (int n = 0; n < 2; ++n) _Pragma("unroll") for (int k = 0; k < 2; ++k) \
        acc[ai][bj][m][n] = __builtin_amdgcn_mfma_f32_16x16x32_bf16(Bt[n][k], At[m][k], acc[ai][bj][m][n], 0, 0, 0); __builtin_amdgcn_s_setprio(0); } while (0)
#define PG8_WAIT_V(n) asm volatile("s_waitcnt vmcnt(" #n ")" ::: "memory")
#define PG8_WAIT_L(n) asm volatile("s_waitcnt lgkmcnt(" #n ")" ::: "memory")
#define PG8_BAR __builtin_amdgcn_s_barrier()
#define PG8_SCHED __builtin_amdgcn_sched_barrier(0)
    int ui = 0, cur_pm, cur_pn, cur_k0, cur_nk, cur_slice, cur_src, nxt_pm, nxt_pn, nxt_k0, nxt_nk, nxt_slice, nxt_src;
    if (!S.next(0, cur_pm, cur_pn, cur_k0, cur_nk, cur_slice, cur_src)) return;
    f32x4 acc[2][2][4][2];
#pragma unroll
    for (int a = 0; a < 2; ++a)
#pragma unroll
        for (int b = 0; b < 2; ++b)
#pragma unroll
            for (int m = 0; m < 4; ++m)
#pragma unroll
                for (int n = 0; n < 2; ++n) acc[a][b][m][n] = (f32x4){0.f, 0.f, 0.f, 0.f};
    bf16x8 At[4][2], B0[2][2], B1[2][2];
    const char* cA = (const char*)((EPI == EPI_GLU && cur_src) ? gA2 : gA) + (size_t)cur_pm * tstep + (size_t)cur_k0 * kstep;
    const char* cB = (const char*)((EPI == EPI_GLU && cur_src) ? gBt2 : gBt) + (size_t)cur_pn * tstep + (size_t)cur_k0 * kstep;
    PG8_STAGE(PG8_SB(0, 0), cB); PG8_STAGE(PG8_SB(0, 1), cB + hstep); PG8_STAGE(PG8_SA(0, 0), cA); PG8_STAGE(PG8_SA(0, 1), cA + hstep);
    if (wr == 1) PG8_BAR;
    PG8_WAIT_V(2); PG8_BAR;
    PG8_STAGE(PG8_SB(1, 0), cB + kstep); PG8_STAGE(PG8_SA(1, 0), cA + kstep); PG8_STAGE(PG8_SB(1, 1), cB + hstep + kstep);
    PG8_WAIT_V(6); PG8_BAR;
    for (;;) {
        const bool has_next = S.next(ui + 1, nxt_pm, nxt_pn, nxt_k0, nxt_nk, nxt_slice, nxt_src);
        const char* nA = has_next ? (const char*)((EPI == EPI_GLU && nxt_src) ? gA2 : gA) + (size_t)nxt_pm * tstep + (size_t)nxt_k0 * kstep : cA;
        const char* nB = has_next ? (const char*)((EPI == EPI_GLU && nxt_src) ? gBt2 : gBt) + (size_t)nxt_pn * tstep + (size_t)nxt_k0 * kstep : cB;
        const int cnk = cur_nk;
        for (int t = 0; t < cnk; t += 2) {
            const bool last = (t == cnk - 2);
            const char* a1 = cA + (size_t)(t + 1) * kstep;
            const char* a2 = last ? nA : cA + (size_t)(t + 2) * kstep; const char* b2 = last ? nB : cB + (size_t)(t + 2) * kstep;
            const char* a3 = a2 + kstep; const char* b3 = b2 + kstep;
            PG8_LDB(B0, 0, 0); PG8_LDB(B1, 0, 1); PG8_SCHED; PG8_LDA(At, 0, 0); PG8_STAGE(PG8_SA(1, 1), a1 + hstep);
            PG8_WAIT_V(8); PG8_WAIT_L(0); PG8_BAR; PG8_MMA(0, 0, At, B0); PG8_MMA(0, 1, At, B1); PG8_BAR; PG8_SCHED;
            PG8_LDA(At, 0, 1); PG8_STAGE(PG8_SB(0, 0), b2); PG8_STAGE(PG8_SB(0, 1), b2 + hstep); PG8_STAGE(PG8_SA(0, 0), a2);
            PG8_WAIT_V(8); PG8_WAIT_L(0); PG8_BAR; PG8_MMA(1, 0, At, B0); PG8_MMA(1, 1, At, B1); PG8_BAR; PG8_SCHED;
            PG8_LDB(B0, 1, 0); PG8_LDB(B1, 1, 1); PG8_SCHED; PG8_LDA(At, 1, 0); PG8_STAGE(PG8_SA(0, 1), a2 + hstep);
            PG8_WAIT_V(8); PG8_WAIT_L(0); PG8_BAR; PG8_MMA(0, 0, At, B0); PG8_MMA(0, 1, At, B1); PG8_BAR; PG8_SCHED;
            PG8_LDA(At, 1, 1); PG8_STAGE(PG8_SB(1, 0), b3); PG8_STAGE(PG8_SB(1, 1), b3 + hstep); PG8_STAGE(PG8_SA(1, 0), a3);
            PG8_WAIT_V(8); PG8_WAIT_L(0); PG8_BAR; PG8_MMA(1, 0, At, B0); PG8_MMA(1, 1, At, B1); PG8_BAR; PG8_SCHED;
        }
        if (wr == 0) PG8_BAR;
        if (SPLIT && cur_slice >= 0) {
            const int ldc = (EPI == EPI_GLU && cur_src == 0) ? 2048 : DM;
            float* SL = (float*)(p.ws + (EPI == EPI_WO ? OFF_SLAB_WO : (EPI == EPI_DOWN ? OFF_SLAB_DN : (cur_src ? OFF_SLAB_ATT : OFF_SLAB_GLU)))) + (size_t)cur_slice * MS * ldc;
#pragma unroll
            for (int ai = 0; ai < 2; ++ai)
#pragma unroll
                for (int m = 0; m < 4; ++m) {
                    const int rs = (cur_pm - 64) * 256 + ai * 128 + wr * 64 + m * 16 + fr;
#pragma unroll
                    for (int bj = 0; bj < 2; ++bj)
#pragma unroll
                        for (int n = 0; n < 2; ++n) *(f32x4*)(SL + (size_t)rs * ldc + cur_pn * 256 + bj * 128 + wc * 32 + n * 16 + fq * 4) = acc[ai][bj][m][n];
                }
        } else epilogue<EPI>(p, acc, cur_pm, cur_pn, wr, wc, fr, fq);
        if (!has_next) break;
#pragma unroll
        for (int a = 0; a < 2; ++a)
#pragma unroll
            for (int b = 0; b < 2; ++b)
#pragma unroll
                for (int m = 0; m < 4; ++m)
#pragma unroll
                    for (int n = 0; n < 2; ++n) acc[a][b][m][n] = (f32x4){0.f, 0.f, 0.f, 0.f};
        cur_pm = nxt_pm; cur_pn = nxt_pn; cur_k0 = nxt_k0; cur_nk = nxt_nk; cur_slice = nxt_slice; cur_src = nxt_src; cA = nA; cB = nB; ++ui;
        if (wr == 1) PG8_BAR;
    }
    PG8_WAIT_V(0);
    PG8_BAR;
#undef PG8_SA
#undef PG8_SB
#undef PG8_STAGE
#undef PG8_LDA
#undef PG8_LDB
#undef PG8_MMA
#undef PG8_WAIT_V
#undef PG8_WAIT_L
#undef PG8_BAR
#undef PG8_SCHED
}

template <int MODE>
__device__ __forceinline__ int dest_row(int n, int HH) {
  if (MODE == 0) return n;
  const int part = n >= HH ? 1 : 0, j = n - part * HH;
  const int tj = j >> 7, jl = j & 127, bj = jl >> 6, wcj = (jl >> 4) & 3, w = jl & 15;
  return tj * 256 + bj * 128 + wcj * 32 + part * 16 + w;
}
template <int MODE>
__device__ __forceinline__ void transpose_item(const float* __restrict__ W, int K, int N, bf16_t* __restrict__ WT, int HH, float* scr, int item, int lane) {
  const int nblk = N / 32, kb = item / nblk, nb = item - kb * nblk, k0 = 64 * kb, n0 = 32 * nb;
#pragma unroll 8
  for (int i = 0; i < 32; ++i) { const int kk = 2 * i + (lane >> 5); scr[kk * 33 + (lane & 31)] = W[(size_t)(k0 + kk) * N + n0 + (lane & 31)]; }
  asm volatile("s_waitcnt lgkmcnt(0)" ::: "memory");
  const int c = lane & 7;
#pragma unroll
  for (int j = 0; j < 4; ++j) {
    const int n = (lane >> 3) + 8 * j; const float* s = scr + (8 * c) * 33 + n;
    u32x4 o; o.x = pk2(s[0], s[33]); o.y = pk2(s[66], s[99]); o.z = pk2(s[132], s[165]); o.w = pk2(s[198], s[231]);
    *(u32x4*)(WT + (size_t)dest_row<MODE>(n0 + n, HH) * K + k0 + 8 * c) = o;
  }
  asm volatile("s_waitcnt lgkmcnt(0)" ::: "memory");
}

__device__ __forceinline__ void prep_phase(const Params& p, char* lds) {
  unsigned char* ws = p.ws;
  const int tid = threadIdx.x, lane = tid & 63, wid = tid >> 6;
  const int gt = blockIdx.x * NTHR + tid, NGT = gridDim.x * NTHR;
  const int gw = blockIdx.x * NWAVE + wid, NGW = gridDim.x * NWAVE;
  {
    bf16_t* Xb = (bf16_t*)(ws + OFF_B);
    const int nchunk = MT * DM / 8, npc = MP * DM / 8;
    for (int i0 = gt; i0 < nchunk / 4; i0 += NGT) {
      f32x4 a[4], b[4];
#pragma unroll
      for (int q = 0; q < 4; ++q) {
        const int i = i0 + q * (nchunk / 4);
        const float* sp = (i < npc) ? p.in[0] + (size_t)i * 8 : p.in[1] + (size_t)(i - npc) * 8;
        a[q] = *(const f32x4*)sp; b[q] = *(const f32x4*)(sp + 4);
      }
#pragma unroll
      for (int q = 0; q < 4; ++q) {
        const int i = i0 + q * (nchunk / 4);
        u32x4 o; o.x = pk2(a[q].x, a[q].y); o.y = pk2(a[q].z, a[q].w); o.z = pk2(b[q].x, b[q].y); o.w = pk2(b[q].z, b[q].w);
        *(u32x4*)(Xb + (size_t)i * 8) = o;
      }
    }
  }
  {
    float* scr = (float*)(lds + wid * 8704);
    constexpr int I_IN = 16 * 104, I_GLU = 8 * 64, I_ATT = 8 * 32, I_O = 16 * 32, I_UP = 16 * 176, I_DN = 44 * 32;
    constexpr int NIT = I_IN + I_GLU + I_ATT + I_O + I_UP + I_DN;
    for (int it = gw; it < NIT; it += NGW) {
      int r = it;
      if (r < I_IN) { transpose_item<0>(p.in[7], 1024, DIN, (bf16_t*)(ws + OFF_WIN), 0, scr, r, lane); continue; } r -= I_IN;
      if (r < I_GLU) { transpose_item<1>(p.in[16], 512, 2048, (bf16_t*)(ws + OFF_WGLU), 1024, scr, r, lane); continue; } r -= I_GLU;
      if (r < I_ATT) { transpose_item<0>(p.in[18], 512, 1024, (bf16_t*)(ws + OFF_WATT), 0, scr, r, lane); continue; } r -= I_ATT;
      if (r < I_O) { transpose_item<0>(p.in[19], 1024, 1024, (bf16_t*)(ws + OFF_WO), 0, scr, r, lane); continue; } r -= I_O;
      if (r < I_UP) { transpose_item<1>(p.in[22], 1024, 5632, (bf16_t*)(ws + OFF_WUP), DFF, scr, r, lane); continue; } r -= I_UP;
      transpose_item<0>(p.in[25], DFF, 1024, (bf16_t*)(ws + OFF_WDN), 0, scr, r, lane);
    }
  }
  {
    bf16_t* Ks = (bf16_t*)(ws + OFF_KS); bf16_t* Vts = (bf16_t*)(ws + OFF_VTS);
    const float* ck = p.in[2]; const float* cv = p.in[3];
    for (int i = gt; i < 128 * 128 * 16; i += NGT) {
      const int c8 = i & 15, w = (i >> 4) & 127, b = i >> 11;
      const float* s = ck + ((size_t)b * 128 + w) * 128 + c8 * 8;
      const f32x4 a = *(const f32x4*)s, bq = *(const f32x4*)(s + 4);
      u32x4 o; o.x = pk2(a.x, a.y); o.y = pk2(a.z, a.w); o.z = pk2(bq.x, bq.y); o.w = pk2(bq.z, bq.w);
      *(u32x4*)(Ks + ((size_t)b * 144 + w) * 128 + c8 * 8) = o;
    }
    for (int i = gt; i < 128 * 12 * 16; i += NGT) {
      const int c8 = i & 15, r = (i >> 4) % 12, b = i / 192;
      *(u32x4*)(Ks + ((size_t)b * 144 + 132 + r) * 128 + c8 * 8) = u32x4{0u, 0u, 0u, 0u};
    }
    for (int i = gt; i < 128 * 16 * 128; i += NGT) {
      const int kvd = i & 127, w8 = (i >> 7) & 15, b = i >> 11;
      const float* s = cv + ((size_t)b * 128 + w8 * 8) * 128 + kvd;
      u32x4 o; o.x = pk2(s[0], s[128]); o.y = pk2(s[256], s[384]); o.z = pk2(s[512], s[640]); o.w = pk2(s[768], s[896]);
      *(u32x4*)(Vts + ((size_t)b * 128 + kvd) * 144 + w8 * 8) = o;
    }
    for (int i = gt; i < 128 * 128 * 3; i += NGT) {
      const int q = i % 3, r = i / 3;
      *(u32x2*)(Vts + (size_t)r * 144 + 132 + q * 4) = u32x2{0u, 0u};
    }
    for (int i = gt; i < 128 * 124 * 32; i += NGT) {
      const int c4 = i & 31, w = (i >> 5) % 124, b = i / (124 * 32);
      const size_t so = ((size_t)b * 128 + w + 4) * 128 + c4 * 4, dof = ((size_t)b * 128 + w) * 128 + c4 * 4;
      *(f32x4*)(p.out + O_KS + dof) = *(const f32x4*)(ck + so);
      *(f32x4*)(p.out + O_VS + dof) = *(const f32x4*)(cv + so);
    }
  }
  {
    float* AR = (float*)(ws + OFF_AR); float* AI = (float*)(ws + OFF_AI); bf16_t* BB = (bf16_t*)(ws + OFF_BB);
    for (int i = gt; i < 2048; i += NGT) {
      const int g = i >> 6, pp = i & 63;
      const float lr = p.in[8][i], li = p.in[9][i], dt = expf(p.in[10][g]);
      const float mag = expf(lr * dt), ang = li * dt;
      const float abr = mag * cosf(ang), abi = mag * sinf(ang);
      const float den = lr * lr + li * li, nr = abr - 1.f;
      const float cr = (nr * lr + abi * li) / den, ci = (abi * lr - nr * li) / den;
      AR[i] = abr; AI[i] = abi;
      const float* br = p.in[11] + (size_t)i * 16; const float* bi = p.in[12] + (size_t)i * 16;
      bf16_t* dre = BB + ((size_t)g * 128 + pp) * 16; bf16_t* dim_ = BB + ((size_t)g * 128 + 64 + pp) * 16;
#pragma unroll
      for (int c = 0; c < 16; ++c) {
        dre[c] = f2bf(cr * br[c] - ci * bi[c]);
        dim_[c] = f2bf(cr * bi[c] + ci * br[c]);
      }
    }
  }
}

#define CMUL_ACC(dr, di, ar_, ai_, br_, bi_) do { const float t_r = (ar_) * (br_) - (ai_) * (bi_); const float t_i = (ar_) * (bi_) + (ai_) * (br_); dr += t_r; di += t_i; } while (0)

template <int MODE>
__device__ __forceinline__ void scan_unit(const Params& p, int u, int lane, bf16_t* Hs) {
  unsigned char* ws = p.ws;
  const int pl = lane & 15, q4 = lane >> 4;
  const bf16_t* P = (const bf16_t*)(ws + OFF_P);
  const float* AR = (const float*)(ws + OFF_AR); const float* AI = (const float*)(ws + OFF_AI);
  const bf16_t* BB = (const bf16_t*)(ws + OFF_BB);
  float* E = (float*)(ws + OFF_E);
  int g, s = 0, c = 0, R0, ntile;
  if (MODE == 2) { g = u & 31; const int ti = u >> 5; R0 = MP + ti * 16; ntile = 1; s = ti; }
  else { c = u & 15; g = (u >> 4) & 31; s = u >> 9; R0 = s * 2048 + c * 128; ntile = 8; }
  float ar[4], ai[4], a4r[4], a4i[4], a8r[4], a8i[4], a128r[4], a128i[4];
#pragma unroll
  for (int q = 0; q < 4; ++q) {
    const float r1 = AR[g * 64 + q * 16 + pl], i1 = AI[g * 64 + q * 16 + pl];
    ar[q] = r1; ai[q] = i1;
    const float r2 = r1 * r1 - i1 * i1, i2 = 2.f * r1 * i1;
    const float r4 = r2 * r2 - i2 * i2, i4 = 2.f * r2 * i2;
    const float r8 = r4 * r4 - i4 * i4, i8 = 2.f * r4 * i4;
    a4r[q] = r4; a4i[q] = i4; a8r[q] = r8; a8i[q] = i8;
    const float r16 = r8 * r8 - i8 * i8, i16 = 2.f * r8 * i8;
    const float r32 = r16 * r16 - i16 * i16, i32 = 2.f * r16 * i16;
    const float r64 = r32 * r32 - i32 * i32, i64 = 2.f * r32 * i32;
    a128r[q] = r64 * r64 - i64 * i64; a128i[q] = 2.f * r64 * i64;
  }
  bf16x4 bb[8];
#pragma unroll
  for (int pt = 0; pt < 8; ++pt) bb[pt] = *(const bf16x4*)(BB + ((size_t)g * 128 + pt * 16 + pl) * 16 + q4 * 4);
  bf16x8 cm[4]; bf16x4 dmv;
  if (MODE != 0) {
#pragma unroll
    for (int ks = 0; ks < 4; ++ks) {
      const float* src = ((ks < 2) ? p.in[13] : p.in[14]) + ((size_t)g * 16 + pl) * 64 + (ks & 1) * 32 + q4 * 8;
      const float sg = (ks < 2) ? 1.f : -1.f;
      const f32x4 x0 = *(const f32x4*)src, x1 = *(const f32x4*)(src + 4);
      u32x4 o; o.x = pk2(sg * x0.x, sg * x0.y); o.y = pk2(sg * x0.z, sg * x0.w); o.z = pk2(sg * x1.x, sg * x1.y); o.w = pk2(sg * x1.z, sg * x1.w);
      cm[ks] = __builtin_bit_cast(bf16x8, o);
    }
    const float dv = p.in[15][g * 16 + pl];
    u32x2 o;
    o.x = pk2((q4 * 4 + 0 == pl) ? dv : 0.f, (q4 * 4 + 1 == pl) ? dv : 0.f);
    o.y = pk2((q4 * 4 + 2 == pl) ? dv : 0.f, (q4 * 4 + 3 == pl) ? dv : 0.f);
    dmv = __builtin_bit_cast(bf16x4, o);
  }
  float hr[4], hi[4];
#pragma unroll
  for (int q = 0; q < 4; ++q) { hr[q] = 0.f; hi[q] = 0.f; }
  if (MODE == 1) {
    const float* Eb = E + ((size_t)(s * 32 + g) * 16) * 128;
#pragma unroll
    for (int bt = 0; bt < 3; ++bt) {
      if (bt * 5 < c) {
        float er[5][4], ei[5][4];
#pragma unroll
        for (int k = 0; k < 5; ++k)
#pragma unroll
          for (int q = 0; q < 4; ++q) { er[k][q] = Eb[(bt * 5 + k) * 128 + q * 16 + pl]; ei[k][q] = Eb[(bt * 5 + k) * 128 + 64 + q * 16 + pl]; }
#pragma unroll
        for (int k = 0; k < 5; ++k) {
          const bool on = (bt * 5 + k) < c;
#pragma unroll
          for (int q = 0; q < 4; ++q) {
            const float nr_ = a128r[q] * hr[q] - a128i[q] * hi[q] + er[k][q];
            const float ni_ = a128r[q] * hi[q] + a128i[q] * hr[q] + ei[k][q];
            hr[q] = on ? nr_ : hr[q]; hi[q] = on ? ni_ : hi[q];
          }
        }
      }
    }
  }
  if (MODE == 2) {
    const int b = s * 4 + q4;
#pragma unroll
    for (int q = 0; q < 4; ++q) {
      hr[q] = p.in[4][((size_t)b * 32 + g) * 64 + q * 16 + pl];
      hi[q] = p.in[5][((size_t)b * 32 + g) * 64 + q * 16 + pl];
    }
  }
  const bf16_t* up = P + (size_t)(R0 + pl) * PW + g * 16 + q4 * 4;
  bf16x4 uf_next = *(const bf16x4*)up;
#pragma unroll 2
  for (int tile = 0; tile < ntile; ++tile) {
    const int Rt = R0 + tile * 16;
    const bf16x4 uf = uf_next;
    if (tile + 1 < ntile) uf_next = *(const bf16x4*)(up + (size_t)(tile + 1) * 16 * PW);
    f32x4 xr[4], xi[4];
    const f32x4 z4 = f32x4{0.f, 0.f, 0.f, 0.f};
#pragma unroll
    for (int q = 0; q < 4; ++q) {
      xr[q] = __builtin_amdgcn_mfma_f32_16x16x16bf16_1k(uf, bb[q], z4, 0, 0, 0);
      xi[q] = __builtin_amdgcn_mfma_f32_16x16x16bf16_1k(uf, bb[q + 4], z4, 0, 0, 0);
    }
#pragma unroll
    for (int q = 0; q < 4; ++q) {
      float s0r = xr[q].x, s0i = xi[q].x, s1r = xr[q].y, s1i = xi[q].y, s2r = xr[q].z, s2i = xi[q].z, s3r = xr[q].w, s3i = xi[q].w;
      if (MODE == 2 || q4 == 0) CMUL_ACC(s0r, s0i, ar[q], ai[q], hr[q], hi[q]);
      CMUL_ACC(s1r, s1i, ar[q], ai[q], s0r, s0i);
      CMUL_ACC(s2r, s2i, ar[q], ai[q], s1r, s1i);
      CMUL_ACC(s3r, s3i, ar[q], ai[q], s2r, s2i);
      if (MODE != 2) {
        float Ir = s3r, Ii = s3i;
        float tr = __shfl_up(Ir, 16), ti = __shfl_up(Ii, 16);
        if (q4 >= 1) CMUL_ACC(Ir, Ii, a4r[q], a4i[q], tr, ti);
        tr = __shfl_up(Ir, 32); ti = __shfl_up(Ii, 32);
        if (q4 >= 2) CMUL_ACC(Ir, Ii, a8r[q], a8i[q], tr, ti);
        float cr = __shfl_up(Ir, 16), ci = __shfl_up(Ii, 16);
        if (q4 == 0) { cr = 0.f; ci = 0.f; }
        float t1r = ar[q] * cr - ai[q] * ci, t1i = ar[q] * ci + ai[q] * cr; s0r += t1r; s0i += t1i;
        float t2r = ar[q] * t1r - ai[q] * t1i, t2i = ar[q] * t1i + ai[q] * t1r; s1r += t2r; s1i += t2i;
        float t3r = ar[q] * t2r - ai[q] * t2i, t3i = ar[q] * t2i + ai[q] * t2r; s2r += t3r; s2i += t3i;
        float t4r = ar[q] * t3r - ai[q] * t3i, t4i = ar[q] * t3i + ai[q] * t3r; s3r += t4r; s3i += t4i;
        hr[q] = __shfl(s3r, 48 + pl); hi[q] = __shfl(s3i, 48 + pl);
      } else {
        hr[q] = s3r; hi[q] = s3i;
      }
      xr[q] = f32x4{s0r, s1r, s2r, s3r}; xi[q] = f32x4{s0i, s1i, s2i, s3i};
    }
    if (MODE != 0) {
#pragma unroll
      for (int q = 0; q < 4; ++q) {
        Hs[(q4 * 4 + 0) * 136 + q * 16 + pl] = f2bf(xr[q].x); Hs[(q4 * 4 + 1) * 136 + q * 16 + pl] = f2bf(xr[q].y);
        Hs[(q4 * 4 + 2) * 136 + q * 16 + pl] = f2bf(xr[q].z); Hs[(q4 * 4 + 3) * 136 + q * 16 + pl] = f2bf(xr[q].w);
        Hs[(q4 * 4 + 0) * 136 + 64 + q * 16 + pl] = f2bf(xi[q].x); Hs[(q4 * 4 + 1) * 136 + 64 + q * 16 + pl] = f2bf(xi[q].y);
        Hs[(q4 * 4 + 2) * 136 + 64 + q * 16 + pl] = f2bf(xi[q].z); Hs[(q4 * 4 + 3) * 136 + 64 + q * 16 + pl] = f2bf(xi[q].w);
      }
      asm volatile("s_waitcnt lgkmcnt(0)" ::: "memory");
      f32x4 y = z4;
#pragma unroll
      for (int ks = 0; ks < 4; ++ks) {
        const bf16x8 hf = *(const bf16x8*)(Hs + pl * 136 + ks * 32 + q4 * 8);
        y = __builtin_amdgcn_mfma_f32_16x16x32_bf16(hf, cm[ks], y, 0, 0, 0);
      }
      y = __builtin_amdgcn_mfma_f32_16x16x16bf16_1k(uf, dmv, y, 0, 0, 0);
      asm volatile("s_waitcnt lgkmcnt(0)" ::: "memory");
      bf16_t* GY = (bf16_t*)(ws + OFF_GY);
      bf16_t* dst = GY + (size_t)(Rt + q4 * 4) * 512 + g * 16 + pl;
      dst[0] = f2bf(gelu_tanh(y.x)); dst[512] = f2bf(gelu_tanh(y.y)); dst[1024] = f2bf(gelu_tanh(y.z)); dst[1536] = f2bf(gelu_tanh(y.w));
    }
  }
  if (MODE == 0) {
    if (q4 == 0) {
      float* Eb = E + ((size_t)(s * 32 + g) * 16 + c) * 128;
#pragma unroll
      for (int q = 0; q < 4; ++q) { Eb[q * 16 + pl] = hr[q]; Eb[64 + q * 16 + pl] = hi[q]; }
    }
  } else if (MODE == 1) {
    if (c == 15 && q4 == 0) {
#pragma unroll
      for (int q = 0; q < 4; ++q) {
        p.out[O_HRP + ((size_t)s * 32 + g) * 64 + q * 16 + pl] = hr[q];
        p.out[O_HIP + ((size_t)s * 32 + g) * 64 + q * 16 + pl] = hi[q];
      }
    }
  } else {
    const int b = s * 4 + q4;
#pragma unroll
    for (int q = 0; q < 4; ++q) {
      p.out[O_HRS + ((size_t)b * 32 + g) * 64 + q * 16 + pl] = hr[q];
      p.out[O_HIS + ((size_t)b * 32 + g) * 64 + q * 16 + pl] = hi[q];
    }
  }
}

__device__ __forceinline__ void scan_end_unit(const Params& p, int u, int lane) {
  unsigned char* ws = p.ws;
  const int pl = lane & 15, q4 = lane >> 4;
  const bf16_t* P = (const bf16_t*)(ws + OFF_P);
  const float* AR = (const float*)(ws + OFF_AR); const float* AI = (const float*)(ws + OFF_AI);
  const bf16_t* BB = (const bf16_t*)(ws + OFF_BB);
  float* E = (float*)(ws + OFF_E);
  const int c = u & 15, g = (u >> 4) & 31, s = u >> 9, R0 = s * 2048 + c * 128;
  float ar[4], ai[4], wr_[4], wi_[4], a16r[4], a16i[4];
#pragma unroll
  for (int q = 0; q < 4; ++q) {
    const float r1 = AR[g * 64 + q * 16 + pl], i1 = AI[g * 64 + q * 16 + pl];
    ar[q] = r1; ai[q] = i1;
    const float r2 = r1 * r1 - i1 * i1, i2 = 2.f * r1 * i1;
    const float r4 = r2 * r2 - i2 * i2, i4 = 2.f * r2 * i2;
    const float r8 = r4 * r4 - i4 * i4, i8 = 2.f * r4 * i4;
    const float r12 = r8 * r4 - i8 * i4, i12 = r8 * i4 + i8 * r4;
    a16r[q] = r8 * r8 - i8 * i8; a16i[q] = 2.f * r8 * i8;
    wr_[q] = (q4 == 0) ? r12 : (q4 == 1) ? r8 : (q4 == 2) ? r4 : 1.f;
    wi_[q] = (q4 == 0) ? i12 : (q4 == 1) ? i8 : (q4 == 2) ? i4 : 0.f;
  }
  bf16x4 bb[8];
#pragma unroll
  for (int pt = 0; pt < 8; ++pt) bb[pt] = *(const bf16x4*)(BB + ((size_t)g * 128 + pt * 16 + pl) * 16 + q4 * 4);
  float er[4], ei[4];
#pragma unroll
  for (int q = 0; q < 4; ++q) { er[q] = 0.f; ei[q] = 0.f; }
  const bf16_t* up = P + (size_t)(R0 + pl) * PW + g * 16 + q4 * 4;
  bf16x4 uf_next = *(const bf16x4*)up;
  const f32x4 z4 = f32x4{0.f, 0.f, 0.f, 0.f};
#pragma unroll 2
  for (int tile = 0; tile < 8; ++tile) {
    const bf16x4 uf = uf_next;
    if (tile + 1 < 8) uf_next = *(const bf16x4*)(up + (size_t)(tile + 1) * 16 * PW);
#pragma unroll
    for (int q = 0; q < 4; ++q) {
      const f32x4 xr = __builtin_amdgcn_mfma_f32_16x16x16bf16_1k(uf, bb[q], z4, 0, 0, 0);
      const f32x4 xi = __builtin_amdgcn_mfma_f32_16x16x16bf16_1k(uf, bb[q + 4], z4, 0, 0, 0);
      float tr = xr.x, ti = xi.x, nr_, ni_;
      nr_ = ar[q] * tr - ai[q] * ti + xr.y; ni_ = ar[q] * ti + ai[q] * tr + xi.y; tr = nr_; ti = ni_;
      nr_ = ar[q] * tr - ai[q] * ti + xr.z; ni_ = ar[q] * ti + ai[q] * tr + xi.z; tr = nr_; ti = ni_;
      nr_ = ar[q] * tr - ai[q] * ti + xr.w; ni_ = ar[q] * ti + ai[q] * tr + xi.w; tr = nr_; ti = ni_;
      float sr = wr_[q] * tr - wi_[q] * ti, si = wr_[q] * ti + wi_[q] * tr;
      sr += __shfl_xor(sr, 16); si += __shfl_xor(si, 16);
      sr += __shfl_xor(sr, 32); si += __shfl_xor(si, 32);
      nr_ = a16r[q] * er[q] - a16i[q] * ei[q] + sr; ni_ = a16r[q] * ei[q] + a16i[q] * er[q] + si;
      er[q] = nr_; ei[q] = ni_;
    }
  }
  if (q4 == 0) {
    float* Eb = E + ((size_t)(s * 32 + g) * 16 + c) * 128;
#pragma unroll
    for (int q = 0; q < 4; ++q) { Eb[q * 16 + pl] = er[q]; Eb[64 + q * 16 + pl] = ei[q]; }
  }
}

template <bool LDSRC>
__device__ __forceinline__ void attn_core(const Params& p, const int lane, const char* kptr, const int kstride, const char* vptr, const int vstride,
                                          const int kt0, const int has_prev, const int row_q, const int h_q, const int i_q) {
  unsigned char* ws = p.ws;
  const int pl = lane & 15, q4 = lane >> 4;
  const bf16_t* P = (const bf16_t*)(ws + OFF_P);
  const float sink = p.in[17][h_q];
  const bf16_t* qp = P + (size_t)row_q * PW + 512 + h_q * 64 + q4 * 8;
  const bf16x8 qf0 = *(const bf16x8*)qp, qf1 = *(const bf16x8*)(qp + 32);
  u32x4 vfr[LDSRC ? 1 : 5][4];
  if constexpr (!LDSRC) {
#pragma unroll
    for (int pp = 0; pp < 5; ++pp) {
      int TA = kt0 + 2 * pp, TB = kt0 + ((2 * pp + 1 < 9) ? 2 * pp + 1 : 2 * pp);
      if (!has_prev) { if (TA < 8) TA = 8; if (TB < 8) TB = 8; }
#pragma unroll
      for (int dt = 0; dt < 4; ++dt) {
        const char* vp = vptr + (dt * 16 + pl) * vstride + q4 * 8;
        const u32x2 va = *(const u32x2*)(vp + TA * 32), vb = *(const u32x2*)(vp + TB * 32);
        vfr[pp][dt] = u32x4{va.x, va.y, vb.x, vb.y};
      }
    }
  }
  f32x4 sa[9];
#pragma unroll
  for (int kt = 0; kt < 9; ++kt) {
    int T = kt0 + kt; if (!has_prev && T < 8) T = 8;
    const char* kp = kptr + (T * 16 + pl) * kstride + q4 * 16;
    bf16x8 k0, k1;
    if constexpr (LDSRC) { k0 = *(const LAS bf16x8*)(const LAS char*)kp; k1 = *(const LAS bf16x8*)(const LAS char*)(kp + 64); }
    else { k0 = *(const bf16x8*)kp; k1 = *(const bf16x8*)(kp + 64); }
    f32x4 a = f32x4{0.f, 0.f, 0.f, 0.f};
    a = __builtin_amdgcn_mfma_f32_16x16x32_bf16(k0, qf0, a, 0, 0, 0);
    a = __builtin_amdgcn_mfma_f32_16x16x32_bf16(k1, qf1, a, 0, 0, 0);
    sa[kt] = a;
  }
  float mx = -INFINITY;
#pragma unroll
  for (int kt = 0; kt < 9; ++kt) {
#pragma unroll
    for (int r = 0; r < 4; ++r) {
      const int sj = (kt0 + kt) * 16 + q4 * 4 + r;
      const bool valid = (sj > i_q) && (sj <= i_q + 128) && (has_prev || sj >= 128);
      const float v = valid ? sa[kt][r] * 0.125f : -INFINITY;
      sa[kt][r] = v; mx = fmaxf(mx, v);
    }
  }
  mx = fmaxf(mx, __shfl_xor(mx, 16)); mx = fmaxf(mx, __shfl_xor(mx, 32));
  mx = fmaxf(mx, sink);
  float sum = 0.f;
#pragma unroll
  for (int kt = 0; kt < 9; ++kt) {
#pragma unroll
    for (int r = 0; r < 4; ++r) { const float e = __expf(sa[kt][r] - mx); sa[kt][r] = e; sum += e; }
  }
  sum += __shfl_xor(sum, 16); sum += __shfl_xor(sum, 32);
  const float inv = 1.f / (sum + __expf(sink - mx));
  f32x4 oa[4];
#pragma unroll
  for (int dt = 0; dt < 4; ++dt) oa[dt] = f32x4{0.f, 0.f, 0.f, 0.f};
#pragma unroll
  for (int pp = 0; pp < 5; ++pp) {
    const int kA = 2 * pp, kB = (2 * pp + 1 < 9) ? 2 * pp + 1 : 2 * pp;
    u32x4 pw;
    pw.x = pk2(sa[kA][0] * inv, sa[kA][1] * inv); pw.y = pk2(sa[kA][2] * inv, sa[kA][3] * inv);
    if (2 * pp + 1 < 9) { pw.z = pk2(sa[kB][0] * inv, sa[kB][1] * inv); pw.w = pk2(sa[kB][2] * inv, sa[kB][3] * inv); }
    else { pw.z = 0u; pw.w = 0u; }
    const bf16x8 pf = __builtin_bit_cast(bf16x8, pw);
    if constexpr (LDSRC) {
      int TA = kt0 + 2 * pp, TB = kt0 + ((2 * pp + 1 < 9) ? 2 * pp + 1 : 2 * pp);
      if (!has_prev) { if (TA < 8) TA = 8; if (TB < 8) TB = 8; }
#pragma unroll
      for (int dt = 0; dt < 4; ++dt) {
        const char* vp = vptr + (dt * 16 + pl) * vstride + q4 * 8;
        const u32x2 va = *(const LAS u32x2*)(const LAS char*)(vp + TA * 32), vb = *(const LAS u32x2*)(const LAS char*)(vp + TB * 32);
        oa[dt] = __builtin_amdgcn_mfma_f32_16x16x32_bf16(__builtin_bit_cast(bf16x8, u32x4{va.x, va.y, vb.x, vb.y}), pf, oa[dt], 0, 0, 0);
      }
    } else {
#pragma unroll
      for (int dt = 0; dt < 4; ++dt) oa[dt] = __builtin_amdgcn_mfma_f32_16x16x32_bf16(__builtin_bit_cast(bf16x8, vfr[pp][dt]), pf, oa[dt], 0, 0, 0);
    }
  }
  bf16_t* O = (bf16_t*)(ws + OFF_O);
#pragma unroll
  for (int dt = 0; dt < 4; ++dt) *(u32x2*)(O + (size_t)row_q * 512 + h_q * 64 + dt * 16 + q4 * 4) = pk4(oa[dt]);
}

__device__ __forceinline__ void attn_sample_unit(const Params& p, int us, int lane) {
  const int pl = lane & 15, kv = us & 1, b = us >> 1, tt = pl >> 2, g = pl & 3;
  const bf16_t* Ks = (const bf16_t*)(p.ws + OFF_KS); const bf16_t* Vts = (const bf16_t*)(p.ws + OFF_VTS);
  attn_core<false>(p, lane, (const char*)(Ks + (size_t)b * 144 * 128 + kv * 64), 256, (const char*)(Vts + (size_t)(b * 2 + kv) * 64 * 144), 288,
                   0, 1, MP + b * 4 + tt, kv * 4 + g, tt);
}

constexpr int ATT_KSTR = 144, ATT_VSTR = 528, ATT_VOFF = 256 * ATT_KSTR;
__device__ __forceinline__ void attn_block_unit(const Params& p, int bu, char* lds, int tid) {
  const int b = bu >> 5, kv = (bu >> 4) & 1, blk = bu & 15, lane = tid & 63, wid = tid >> 6;
  const bf16_t* Kp = (const bf16_t*)(p.ws + OFF_KP); const bf16_t* Vtp = (const bf16_t*)(p.ws + OFF_VTP);
  char* K_l = lds; char* Vt_l = lds + ATT_VOFF;
  u32x4 kr[4], vr[4];
#pragma unroll
  for (int i = 0; i < 4; ++i) {
    const int piece = tid + i * NTHR, key = piece >> 3, c = piece & 7;
    if (blk > 0 || key >= 128) kr[i] = *(const u32x4*)(Kp + ((size_t)b * 2048 + (size_t)(blk - 1) * 128 + key) * 128 + kv * 64 + c * 8);
    const int d = piece >> 5, c2 = piece & 31;
    if (blk > 0 || c2 >= 16) vr[i] = *(const u32x4*)(Vtp + ((size_t)(b * 2 + kv) * 64 + d) * 2048 + (size_t)(blk - 1) * 128 + c2 * 8);
  }
#pragma unroll
  for (int i = 0; i < 4; ++i) {
    const int piece = tid + i * NTHR, key = piece >> 3, c = piece & 7;
    if (blk > 0 || key >= 128) *(u32x4*)(K_l + key * ATT_KSTR + c * 16) = kr[i];
    const int d = piece >> 5, c2 = piece & 31;
    if (blk > 0 || c2 >= 16) *(u32x4*)(Vt_l + d * ATT_VSTR + c2 * 16) = vr[i];
  }
  __syncthreads();
  const int pl = lane & 15;
#pragma unroll 1
  for (int g = 0; g < 4; ++g) {
    asm volatile("" ::: "memory");
    attn_core<true>(p, lane, K_l, ATT_KSTR, Vt_l, ATT_VSTR, wid, blk > 0, b * 2048 + blk * 128 + wid * 16 + pl, kv * 4 + g, wid * 16 + pl);
  }
  __syncthreads();
}

template <int WHICH, int NRW>
__device__ __forceinline__ void ln_rows(const Params& p, const int row0, const int lane, const f32x4 (&gv)[4], const f32x4 (&bv)[4]) {
  bf16_t* X1b = (bf16_t*)(p.ws + OFF_X1B);
  f32x4 v[NRW][4];
#pragma unroll
  for (int h = 0; h < NRW; ++h) {
    const int row = row0 + h;
    if (row < MP) {
      const bf16_t* xr = (const bf16_t*)(p.ws + (WHICH == 1 ? OFF_PRE1 : OFF_PRE2)) + (size_t)row * DM;
#pragma unroll
      for (int j = 0; j < 4; ++j) v[h][j] = unpk4(*(const u32x2*)(xr + j * 256 + lane * 4));
    } else {
      const float* SL = (const float*)(p.ws + (WHICH == 1 ? OFF_SLAB_WO : OFF_SLAB_DN)) + (size_t)(row - MP) * DM;
      constexpr int NS = (WHICH == 1) ? 8 : 11;
#pragma unroll
      for (int j = 0; j < 4; ++j) {
        f32x4 a;
        if (WHICH == 1) a = *(const f32x4*)(p.in[1] + (size_t)(row - MP) * DM + j * 256 + lane * 4) * ALPHA_F;
        else a = unpk4(*(const u32x2*)(X1b + (size_t)row * DM + j * 256 + lane * 4)) * ALPHA_F;
#pragma unroll
        for (int q = 0; q < NS; ++q) a += *(const f32x4*)(SL + (size_t)q * MS * DM + j * 256 + lane * 4);
        v[h][j] = a;
      }
    }
  }
  float s[NRW], s2[NRW];
#pragma unroll
  for (int h = 0; h < NRW; ++h) { s[h] = 0.f;
#pragma unroll
    for (int j = 0; j < 4; ++j) s[h] += (v[h][j].x + v[h][j].y) + (v[h][j].z + v[h][j].w); }
#pragma unroll
  for (int o = 1; o < 64; o <<= 1) {
#pragma unroll
    for (int h = 0; h < NRW; ++h) s[h] += __shfl_xor(s[h], o);
  }
#pragma unroll
  for (int h = 0; h < NRW; ++h) { const float mean = s[h] * (1.f / DM); s2[h] = 0.f;
#pragma unroll
    for (int j = 0; j < 4; ++j) { v[h][j] = v[h][j] - mean; s2[h] += (v[h][j].x * v[h][j].x + v[h][j].y * v[h][j].y) + (v[h][j].z * v[h][j].z + v[h][j].w * v[h][j].w); } }
#pragma unroll
  for (int o = 1; o < 64; o <<= 1) {
#pragma unroll
    for (int h = 0; h < NRW; ++h) s2[h] += __shfl_xor(s2[h], o);
  }
#pragma unroll
  for (int h = 0; h < NRW; ++h) {
    const int row = row0 + h;
    const float rstd = rsqrtf(s2[h] * (1.f / DM) + LN_EPS_F);
#pragma unroll
    for (int j = 0; j < 4; ++j) {
      const f32x4 o = v[h][j] * rstd * gv[j] + bv[j];
      if (WHICH == 1) *(u32x2*)(X1b + (size_t)row * DM + j * 256 + lane * 4) = pk4(o);
      else *(f32x4*)(p.out + (size_t)row * DM + j * 256 + lane * 4) = o;
    }
  }
}
template <int WHICH>
__device__ __forceinline__ void ln_phase(const Params& p) {
  const int lane = threadIdx.x & 63, wid = threadIdx.x >> 6;
  const int gw = blockIdx.x * NWAVE + wid, NGW = gridDim.x * NWAVE;
  const float* gam = p.in[WHICH == 1 ? 20 : 26]; const float* bet = p.in[WHICH == 1 ? 21 : 27];
  f32x4 gv[4], bv[4];
#pragma unroll
  for (int j = 0; j < 4; ++j) { gv[j] = *(const f32x4*)(gam + j * 256 + lane * 4); bv[j] = *(const f32x4*)(bet + j * 256 + lane * 4); }
  for (int rp = gw; rp < MP / 2; rp += NGW) ln_rows<WHICH, 2>(p, rp * 2, lane, gv, bv);
  for (int row = MP + gw; row < MT; row += NGW) ln_rows<WHICH, 1>(p, row, lane, gv, bv);
}

__device__ __forceinline__ void fixup_phase(const Params& p) {
  unsigned char* ws = p.ws;
  const int gt = blockIdx.x * NTHR + threadIdx.x, NGT = gridDim.x * NTHR;
  const float* HA0 = (const float*)(ws + OFF_HA0); const float* HG0 = (const float*)(ws + OFF_HG0); const float* HA1 = (const float*)(ws + OFF_HA1);
  bf16_t* H = (bf16_t*)(ws + OFF_H);
  constexpr int NJ4 = DFF / 4;
  for (int i = gt; i < NRB * 2 * NJ4; i += NGT) {
    const int j4 = i % NJ4, rl = (i / NJ4) & 1, rb = i / (2 * NJ4);
    if ((rb & 31) == 0) continue;
    const int j0 = j4 * 4;
    const f32x4 a0 = *(const f32x4*)(HA0 + ((size_t)rb * 2 + rl) * DFF + j0);
    const f32x4 g = *(const f32x4*)(HG0 + ((size_t)rb * 2 + rl) * DFF + j0);
    const f32x4 pm1 = *(const f32x4*)(HA1 + ((size_t)(rb - 1) * 2 + 1) * DFF + j0);
    const f32x4 pm2 = *(const f32x4*)(HA1 + ((size_t)(rb - 1) * 2 + 0) * DFF + j0);
    f32x4 am1, am2;
    if (rl == 0) { am1 = pm1; am2 = pm2; }
    else { am1 = *(const f32x4*)(HA0 + ((size_t)rb * 2 + 0) * DFF + j0); am2 = pm1; }
    const f32x4 w0 = *(const f32x4*)(p.in[23] + j0), w1 = *(const f32x4*)(p.in[23] + DFF + j0), w2 = *(const f32x4*)(p.in[23] + 2 * DFF + j0);
    const f32x4 cb = *(const f32x4*)(p.in[24] + j0);
    f32x4 h;
    h.x = gelu_tanh(cb.x + w0.x * am2.x + w1.x * am1.x + w2.x * a0.x) * g.x;
    h.y = gelu_tanh(cb.y + w0.y * am2.y + w1.y * am1.y + w2.y * a0.y) * g.y;
    h.z = gelu_tanh(cb.z + w0.z * am2.z + w1.z * am1.z + w2.z * a0.z) * g.z;
    h.w = gelu_tanh(cb.w + w0.w * am2.w + w1.w * am1.w + w2.w * a0.w) * g.w;
    *(u32x2*)(H + ((size_t)rb * 64 + rl) * DFF + j0) = pk4(h);
  }
}

#define XB_TMO      128
#define XB_XCNT(j)  (256  + 64 * (j))
#define XB_XSUB(j)  (1280 + 64 * (j))
#define XB_XGEN(j)  (2304 + 64 * (j))
#define XB_TOP      3328
#define XB_TOPGEN   3392
#define XCD_BAR_WORDS 3456
#define XB_SPIN_CAP (1u << 18)
__device__ __forceinline__ unsigned xb_ld(unsigned* p)              { return __hip_atomic_load(p, __ATOMIC_RELAXED, __HIP_MEMORY_SCOPE_AGENT); }
__device__ __forceinline__ unsigned xb_add(unsigned* p, unsigned v) { return __hip_atomic_fetch_add(p, v, __ATOMIC_RELAXED, __HIP_MEMORY_SCOPE_AGENT); }
__device__ __forceinline__ unsigned xb_xcc_id() { return (unsigned)__builtin_amdgcn_s_getreg((3 << 11) | 20) & 0xFu; }
#define XB_SPIN(cond, bar) do { unsigned _sp = 0; while (cond) { __builtin_amdgcn_s_sleep(1); \
    if ((++_sp & 255u) == 0u) { if (xb_ld(&(bar)[XB_TMO])) break; if (_sp > XB_SPIN_CAP) { atomicAdd(&(bar)[XB_TMO], 1u); break; } } } } while (0)
#define XB_EXIT 64
__device__ unsigned g_xbar[XCD_BAR_WORDS + 64];
struct XcdBarrier { unsigned* bar; unsigned x; volatile LAS unsigned* st; };
__device__ __forceinline__ XcdBarrier xcd_barrier_post(unsigned* bar, volatile LAS unsigned* st) {
    XcdBarrier b; b.bar = bar; b.x = xb_xcc_id(); b.st = st;
    if (threadIdx.x == 0) (void)xb_add(&bar[XB_XCNT(b.x)], 1u);
    return b;
}
__device__ __forceinline__ void xcd_barrier_complete(unsigned* bar, unsigned x, unsigned& nloc, unsigned& nx) {
    const unsigned G = gridDim.x * gridDim.y * gridDim.z;
    unsigned sum, cnt, mine, sp = 0u;
    for (;;) {
        sum = 0u; cnt = 0u; mine = 0u;
#pragma unroll
        for (unsigned j = 0; j < 16; ++j) { const unsigned c = xb_ld(&bar[XB_XCNT(j)]); sum += c; cnt += (c > 0u) ? 1u : 0u; mine = (j == x) ? c : mine; }
        if (sum == G) break;
        __builtin_amdgcn_s_sleep(1);
        if ((++sp & 255u) == 0u) { if (xb_ld(&bar[XB_TMO])) break; if (sp > XB_SPIN_CAP) { atomicAdd(&bar[XB_TMO], 1u); break; } }
    }
    nloc = mine > 0u ? mine : 1u; nx = cnt > 0u ? cnt : 1u;
}
__device__ __forceinline__ void xcd_barrier(const XcdBarrier& b) {
    asm volatile("s_waitcnt vmcnt(0)" ::: "memory");
    __syncthreads();
    if (threadIdx.x == 0) {
        unsigned* bar = b.bar;
        __builtin_amdgcn_s_waitcnt(0);
        unsigned nloc = b.st[0], nx = b.st[1];
        if (nloc == 0u) { xcd_barrier_complete(bar, b.x, nloc, nx); b.st[0] = nloc; b.st[1] = nx; }
        const unsigned old = xb_add(&bar[XB_XSUB(b.x)], 1u);
        const unsigned gen = old / nloc;
        if (old + 1u == (gen + 1u) * nloc) {
            __builtin_amdgcn_fence(__ATOMIC_RELEASE, "agent");
            asm volatile("s_waitcnt vmcnt(0)" ::: "memory");
            const unsigned og = xb_add(&bar[XB_TOP], 1u);
            const unsigned tg = og / nx;
            if (og + 1u == (tg + 1u) * nx) xb_add(&bar[XB_TOPGEN], 1u);
            else XB_SPIN(xb_ld(&bar[XB_TOPGEN]) == tg, bar);
            __builtin_amdgcn_fence(__ATOMIC_ACQUIRE, "agent");
            xb_add(&bar[XB_XGEN(b.x)], 1u);
            asm volatile("s_waitcnt vmcnt(0)" ::: "memory");
        } else {
            XB_SPIN(xb_ld(&bar[XB_XGEN(b.x)]) == gen, bar);
            __builtin_amdgcn_fence(__ATOMIC_ACQUIRE, "agent");
            asm volatile("s_waitcnt vmcnt(0)" ::: "memory");
        }
    }
    __syncthreads();
}
#define GSYNC() xcd_barrier(xb)

__device__ __forceinline__ void sample_merge(const Params& p) {
  unsigned char* ws = p.ws;
  const bf16_t* P = (const bf16_t*)(ws + OFF_P); bf16_t* Mg = (bf16_t*)(ws + OFF_MG);
  const float* SLG = (const float*)(ws + OFF_SLAB_GLU); const float* SLA = (const float*)(ws + OFF_SLAB_ATT);
  for (int i = blockIdx.x * NTHR + threadIdx.x; i < MS * (DM / 4); i += gridDim.x * NTHR) {
    const int r = i >> 8, j = (i & 255) * 4;
    const int tj = j >> 7, jl = j & 127, va = tj * 256 + (jl >> 6) * 128 + ((jl >> 4) & 3) * 32 + (jl & 15);
    f32x4 ya = f32x4{0.f, 0.f, 0.f, 0.f}, yb = ya, at = ya;
#pragma unroll
    for (int q = 0; q < 4; ++q) {
      ya += *(const f32x4*)(SLG + ((size_t)q * MS + r) * 2048 + va);
      yb += *(const f32x4*)(SLG + ((size_t)q * MS + r) * 2048 + va + 16);
      at += *(const f32x4*)(SLA + ((size_t)q * MS + r) * DM + j);
    }
    const size_t row = (size_t)MP + r;
    const f32x4 gs = unpk4(*(const u32x2*)(P + row * PW + 1024 + j)), ga = unpk4(*(const u32x2*)(P + row * PW + 2048 + j));
    f32x4 sv;
    sv.x = gs.x * ya.x * sigmoidf_(yb.x); sv.y = gs.y * ya.y * sigmoidf_(yb.y); sv.z = gs.z * ya.z * sigmoidf_(yb.z); sv.w = gs.w * ya.w * sigmoidf_(yb.w);
    sv = unpk4(pk4(sv));
    sv.x += ga.x * at.x; sv.y += ga.y * at.y; sv.z += ga.z * at.z; sv.w += ga.w * at.w;
    *(u32x2*)(Mg + row * DM + j) = pk4(sv);
  }
}

__global__ void __launch_bounds__(512) fwd_megakernel(Params p) {
  extern __shared__ __attribute__((aligned(16))) char lds[];
  cg::grid_group grid = cg::this_grid();
  volatile LAS unsigned* xst = (volatile LAS unsigned*)(lds + GEMM_LDS);
  if (threadIdx.x == 0) { xst[0] = 0u; xst[1] = 0u; }
  __syncthreads();
  XcdBarrier xb = xcd_barrier_post(g_xbar, xst);
  if (p.ws == nullptr) grid.sync();
  unsigned char* ws = p.ws;
  LAS unsigned char* glds = (LAS unsigned char*)lds;
  const int lane = threadIdx.x & 63, wid = threadIdx.x >> 6;
  const int gw = blockIdx.x * NWAVE + wid, NGW = gridDim.x * NWAVE;

  prep_phase(p, lds);
  GSYNC();
  gemm_phase<EPI_IN>(p, (const bf16_t*)(ws + OFF_B), (const bf16_t*)(ws + OFF_WIN), 1024, DIN, glds);
  GSYNC();
  {
    for (int bu = blockIdx.x; bu < 256; bu += gridDim.x) attn_block_unit(p, bu, lds, threadIdx.x);
    bf16_t* Hs = (bf16_t*)(lds + wid * 4352);
    constexpr int N_S1 = 8 * 32 * 16, N_SS = 32 * 32, N_AT = 256;
    for (int u = gw; u < N_S1 + N_SS + N_AT; u += NGW) {
      if (u < N_S1) { if ((u & 15) != 15) scan_end_unit(p, u, lane); }
      else if (u < N_S1 + N_SS) scan_unit<2>(p, u - N_S1, lane, Hs);
      else attn_sample_unit(p, u - N_S1 - N_SS, lane);
    }
  }
  GSYNC();
  {
    bf16_t* Hs = (bf16_t*)(lds + wid * 4352);
    for (int u = gw; u < 8 * 32 * 16; u += NGW) scan_unit<1>(p, u, lane, Hs);
  }
  GSYNC();
  gemm_phase<EPI_GLU>(p, (const bf16_t*)(ws + OFF_GY), (const bf16_t*)(ws + OFF_WGLU), 512, 2048, glds, (const bf16_t*)(ws + OFF_O), (const bf16_t*)(ws + OFF_WATT));
  GSYNC();
  gemm_phase<EPI_ATT>(p, (const bf16_t*)(ws + OFF_O), (const bf16_t*)(ws + OFF_WATT), 512, 1024, glds);
  sample_merge(p);
  GSYNC();
  gemm_phase<EPI_WO>(p, (const bf16_t*)(ws + OFF_MG), (const bf16_t*)(ws + OFF_WO), 1024, 1024, glds);
  GSYNC();
  ln_phase<1>(p);
  GSYNC();
  gemm_phase<EPI_UP>(p, (const bf16_t*)(ws + OFF_X1B), (const bf16_t*)(ws + OFF_WUP), 1024, 5632, glds);
  GSYNC();
  fixup_phase(p);
  GSYNC();
  gemm_phase<EPI_DOWN>(p, (const bf16_t*)(ws + OFF_H), (const bf16_t*)(ws + OFF_WDN), DFF, 1024, glds);
  GSYNC();
  ln_phase<2>(p);
  __syncthreads();
  if (threadIdx.x == 0) {
    unsigned* bar = g_xbar;
    const unsigned old = xb_add(&bar[XB_EXIT], 1u);
    if (old == gridDim.x - 1u) {
#pragma unroll
      for (int j = 0; j < 16; ++j) {
        __hip_atomic_store(&bar[XB_XCNT(j)], 0u, __ATOMIC_RELAXED, __HIP_MEMORY_SCOPE_AGENT);
        __hip_atomic_store(&bar[XB_XSUB(j)], 0u, __ATOMIC_RELAXED, __HIP_MEMORY_SCOPE_AGENT);
        __hip_atomic_store(&bar[XB_XGEN(j)], 0u, __ATOMIC_RELAXED, __HIP_MEMORY_SCOPE_AGENT);
      }
      __hip_atomic_store(&bar[XB_TOP], 0u, __ATOMIC_RELAXED, __HIP_MEMORY_SCOPE_AGENT);
      __hip_atomic_store(&bar[XB_TOPGEN], 0u, __ATOMIC_RELAXED, __HIP_MEMORY_SCOPE_AGENT);
      __hip_atomic_store(&bar[XB_TMO], 0u, __ATOMIC_RELAXED, __HIP_MEMORY_SCOPE_AGENT);
      __hip_atomic_store(&bar[XB_EXIT], 0u, __ATOMIC_RELAXED, __HIP_MEMORY_SCOPE_AGENT);
    }
  }
}

extern "C" void kernel_launch(void* const* d_in, const int* in_sizes, int n_in, void* d_out, int out_size, void* d_ws, size_t ws_size, hipStream_t stream) {
  static int grid_blocks = 0;
  if (grid_blocks == 0) {
    if (n_in != 28 || ws_size < WS_TOTAL) { fprintf(stderr, "kernel_launch: unexpected n_in %d or ws_size %zu (< %zu)\n", n_in, ws_size, (size_t)WS_TOTAL); grid_blocks = -1; return; }
    int dev = 0, cus = 0, per_cu = 0;
    (void)hipGetDevice(&dev);
    (void)hipDeviceGetAttribute(&cus, hipDeviceAttributeMultiprocessorCount, dev);
    (void)hipFuncSetAttribute((const void*)fwd_megakernel, hipFuncAttributeMaxDynamicSharedMemorySize, LDS_BYTES);
    (void)hipOccupancyMaxActiveBlocksPerMultiprocessor(&per_cu, (const void*)fwd_megakernel, NTHR, LDS_BYTES);
    if (per_cu < 1) { fprintf(stderr, "kernel_launch: occupancy query returned %d\n", per_cu); per_cu = 1; }
    if (per_cu > 1) per_cu = 1;
    grid_blocks = cus * per_cu;
    fprintf(stderr, "kernel_launch: cus %d per_cu %d grid %d\n", cus, per_cu, grid_blocks);
  }
  if (grid_blocks < 0) return;
  Params p{};
  for (int i = 0; i < 28; ++i) p.in[i] = (const float*)d_in[i];
  p.out = (float*)d_out; p.ws = (unsigned char*)d_ws;
  void* args[] = {&p};
  hipError_t e = hipLaunchCooperativeKernel((const void*)fwd_megakernel, dim3(grid_blocks), dim3(NTHR), args, LDS_BYTES, stream);
  if (e != hipSuccess) fprintf(stderr, "cooperative launch failed: %s (grid %d)\n", hipGetErrorString(e), grid_blocks);
}
```

```cpp
#include <hip/hip_runtime.h>
#include <hip/hip_cooperative_groups.h>
#include <cstdio>
#include <cstdint>
namespace cg = cooperative_groups;

typedef unsigned short bf16_t;
typedef short bf16x8 __attribute__((ext_vector_type(8)));
typedef short bf16x4 __attribute__((ext_vector_type(4)));
typedef float f32x4 __attribute__((ext_vector_type(4)));
typedef unsigned u32x2 __attribute__((ext_vector_type(2)));
typedef unsigned u32x4 __attribute__((ext_vector_type(4)));

constexpr int MP = 16384, MS = 512, MT = MP + MS;
constexpr int DM = 1024, DIN = 3328, PW = 3072, DFF = 2816;
constexpr int NRB = MP / 64;
constexpr float ALPHA_F = 1.189207115002721f;
constexpr float LN_EPS_F = 1e-5f;

constexpr size_t O_YP = 0, O_YS = 16777216, O_KP = 17301504, O_VP = 17432576, O_KS = 17563648, O_VS = 19660800,
                 O_HRP = 21757952, O_HIP = 21774336, O_HRS = 21790720, O_HIS = 22052864, O_CP = 22315008, O_CS = 22360064;

constexpr size_t OFF_P = 0;
constexpr size_t OFF_H = 0;
constexpr size_t OFF_B = (size_t)MT * PW * 2;
constexpr size_t OFF_GY = OFF_B, OFF_O = OFF_B + (size_t)MT * 512 * 2;
constexpr size_t OFF_C = OFF_B + (size_t)MT * DM * 2;
constexpr size_t OFF_MG = OFF_C;
constexpr size_t OFF_X1B = OFF_C + (size_t)MT * DM * 2;
constexpr size_t OFF_KP = OFF_C + (size_t)MT * DM * 2;
constexpr size_t OFF_VTP = OFF_KP + (size_t)8 * 2048 * 128 * 2;
constexpr size_t OFF_KS = OFF_VTP + (size_t)8 * 2048 * 128 * 2;
constexpr size_t OFF_VTS = OFF_KS + (size_t)128 * 144 * 128 * 2;
constexpr size_t OFF_W = OFF_C + (size_t)MT * DM * 4;
constexpr size_t OFF_WIN = OFF_W;
constexpr size_t OFF_WGLU = OFF_WIN + (size_t)DIN * 1024 * 2;
constexpr size_t OFF_WATT = OFF_WGLU + (size_t)2048 * 512 * 2;
constexpr size_t OFF_WO = OFF_WATT + (size_t)1024 * 512 * 2;
constexpr size_t OFF_WUP = OFF_WO + (size_t)1024 * 1024 * 2;
constexpr size_t OFF_WDN = OFF_WUP + (size_t)5632 * 1024 * 2;
constexpr size_t OFF_SSM = OFF_WDN + (size_t)1024 * DFF * 2;
constexpr size_t OFF_AR = OFF_SSM, OFF_AI = OFF_SSM + 8192, OFF_BB = OFF_SSM + 16384;
constexpr size_t OFF_E = OFF_BB + 131072;
constexpr size_t OFF_HA0 = OFF_E + (size_t)8 * 32 * 16 * 128 * 4;
constexpr size_t OFF_HG0 = OFF_HA0 + (size_t)NRB * 2 * DFF * 4;
constexpr size_t OFF_HA1 = OFF_HG0 + (size_t)NRB * 2 * DFF * 4;
constexpr size_t WS_END = OFF_HA1 + (size_t)NRB * 2 * DFF * 4;
static_assert(OFF_VTS + (size_t)128 * 144 * 128 * 2 <= OFF_W, "KV overlay overflow");
static_assert(WS_END <= (size_t)256 * 1024 * 1024, "workspace too large");

constexpr size_t OFF_BAR = WS_END;
constexpr size_t WS_TOTAL = OFF_BAR + 16384;
static_assert(WS_TOTAL <= (size_t)256 * 1024 * 1024, "workspace too large");
constexpr size_t OFF_SLAB_WO = OFF_P;
constexpr size_t OFF_SLAB_DN = OFF_B;
static_assert((size_t)11 * MS * DM * 4 <= (size_t)MT * DM * 2, "down slabs must fit the X1b region");
constexpr size_t OFF_SLAB_GLU = OFF_KP;
constexpr size_t OFF_SLAB_ATT = OFF_KP + (size_t)4 * MS * 2048 * 4;
static_assert(OFF_SLAB_ATT + (size_t)4 * MS * DM * 4 <= OFF_W, "GLU/attn slabs must fit the dead K/V + x1 region");
constexpr size_t OFF_PRE1 = OFF_B;
constexpr size_t OFF_PRE2 = OFF_C;
constexpr int GEMM_LDS = 131072;
constexpr int LDS_BYTES = GEMM_LDS + 16;
constexpr int NTHR = 512, NWAVE = 8;

struct Params {
  const float* in[28];
  float* out;
  unsigned char* ws;
};

typedef __bf16 bf16v2_t __attribute__((ext_vector_type(2)));
typedef float f32x2 __attribute__((ext_vector_type(2)));
__device__ __forceinline__ unsigned pk2(float lo, float hi) { f32x2 v = {lo, hi}; bf16v2_t b = __builtin_convertvector(v, bf16v2_t); return __builtin_bit_cast(unsigned, b); }
__device__ __forceinline__ bf16_t f2bf(float x) { return (bf16_t)(pk2(x, 0.f) & 0xffffu); }
__device__ __forceinline__ float bf2f(unsigned v16) { return __uint_as_float(v16 << 16); }
__device__ __forceinline__ float bflo(unsigned w) { return __uint_as_float(w << 16); }
__device__ __forceinline__ float bfhi(unsigned w) { return __uint_as_float(w & 0xffff0000u); }
__device__ __forceinline__ float rcp_nr(float d) { const float r = __builtin_amdgcn_rcpf(d); return fmaf(r, fmaf(-d, r, 1.f), r); }
__device__ __forceinline__ float sigmoidf_(float x) { return rcp_nr(1.f + __expf(fminf(-x, 80.f))); }
__device__ __forceinline__ float gelu_tanh(float x) { float z = 1.5957691216057308f * (x + 0.044715f * x * x * x); return x * rcp_nr(1.f + __expf(fminf(-z, 80.f))); }
__device__ __forceinline__ float wave_sum(float v) {
#pragma unroll
  for (int o = 1; o < 64; o <<= 1) v += __shfl_xor(v, o);
  return v;
}
__device__ __forceinline__ u32x2 pk4(f32x4 v) { u32x2 r; r.x = pk2(v.x, v.y); r.y = pk2(v.z, v.w); return r; }
__device__ __forceinline__ f32x4 unpk4(u32x2 w) { f32x4 r; r.x = bflo(w.x); r.y = bfhi(w.x); r.z = bflo(w.y); r.w = bfhi(w.y); return r; }


#define LAS __attribute__((address_space(3)))
namespace pg8 {
constexpr int BM = 256, BK = 64, HALF = 128, HTB = HALF * BK * 2, NXCD = 8, WGM = 8;
__device__ __forceinline__ int lds_byte(int r, int c) { const int st = (r >> 4) * 2 + (c >> 5), rr = r & 15, cc = c & 31, ob = rr * 64 + cc * 2; return st * 1024 + (ob ^ (((ob >> 9) & 1) << 5)); }
__device__ __forceinline__ void stage_rc(int b, int& R, int& C) { const int st = b / 1024, sb = b % 1024, swz = sb ^ (((sb >> 9) & 1) << 5); R = (st >> 1) * 16 + swz / 64; C = (st & 1) * 32 + (swz % 64) / 2; }
struct Unit { int pm, pn, k0, nk, slice; };
struct StaticOrder {
    int nM, nN, nwg, G, c;
    __device__ __forceinline__ void init(int M, int N, int G_, int c_) { nM = M / BM; nN = N / BM; nwg = nM * nN; G = G_; c = c_; }
    int nsplit, nslice_items, nt, glu;
    __device__ __forceinline__ bool next(int i, int& pm, int& pn, int& k0, int& nk, int& slice, int& src) const {
        const long L = (long)i * G + c;
        pm = 0; pn = 0; k0 = 0; nk = nt; slice = -1; src = 0;
        if (L < nwg) {
            int wgid = (int)L; { const int q = nwg / NXCD, r = nwg % NXCD, xcd = wgid % NXCD, off = wgid / NXCD; wgid = (xcd < r ? xcd * (q + 1) : r * (q + 1) + (xcd - r) * q) + off; }
            const int nig = WGM * nN, gid = wgid / nig, fm = gid * WGM, gsz = (nM - fm) < WGM ? (nM - fm) : WGM;
            pm = fm + ((wgid % nig) % gsz); pn = (wgid % nig) / gsz; return true;
        }
        if (nsplit == 0) return false;
        int sidx = (int)(L - nwg);
        if (sidx >= nslice_items) return false;
        int ncol = nN;
        if (glu && sidx >= 64) { sidx -= 64; src = 1; ncol = 4; }
        const int tl = sidx / nsplit; slice = sidx - tl * nsplit; pm = 64 + tl / ncol; pn = tl % ncol; nk = nt / nsplit; k0 = slice * nk; return true;
    }
};
}

enum { EPI_IN = 0, EPI_GLU = 1, EPI_ATT = 2, EPI_WO = 3, EPI_UP = 4, EPI_DOWN = 5 };

__device__ __forceinline__ float dpp_ror1(float v) { return __int_as_float(__builtin_amdgcn_update_dpp(0, __float_as_int(v), 0x121, 0xf, 0xf, false)); }
__device__ __forceinline__ float dpp_ror2(float v) { return __int_as_float(__builtin_amdgcn_update_dpp(0, __float_as_int(v), 0x122, 0xf, 0xf, false)); }
__device__ __forceinline__ float dpp_shr1_old(float old, float v) { return __int_as_float(__builtin_amdgcn_update_dpp(__float_as_int(old), __float_as_int(v), 0x111, 0xf, 0xf, false)); }
__device__ __forceinline__ float dpp_shr2_old(float old, float v) { return __int_as_float(__builtin_amdgcn_update_dpp(__float_as_int(old), __float_as_int(v), 0x112, 0xf, 0xf, false)); }
__device__ __forceinline__ f32x4 shr1v(f32x4 o, f32x4 v) { return f32x4{dpp_shr1_old(o.x, v.x), dpp_shr1_old(o.y, v.y), dpp_shr1_old(o.z, v.z), dpp_shr1_old(o.w, v.w)}; }
__device__ __forceinline__ f32x4 shr2v(f32x4 o, f32x4 v) { return f32x4{dpp_shr2_old(o.x, v.x), dpp_shr2_old(o.y, v.y), dpp_shr2_old(o.z, v.z), dpp_shr2_old(o.w, v.w)}; }
__device__ __forceinline__ f32x4 ror1v(f32x4 v) { return f32x4{dpp_ror1(v.x), dpp_ror1(v.y), dpp_ror1(v.z), dpp_ror1(v.w)}; }
__device__ __forceinline__ f32x4 ror2v(f32x4 v) { return f32x4{dpp_ror2(v.x), dpp_ror2(v.y), dpp_ror2(v.z), dpp_ror2(v.w)}; }

template <int EPI>
__device__ __forceinline__ void epilogue(const Params& p, f32x4 (&acc)[2][2][4][2], const int pm, const int pn, const int wr, const int wc, const int fr, const int fq) {
  unsigned char* ws = p.ws;
  bf16_t* P = (bf16_t*)(ws + OFF_P);
  if constexpr (EPI == EPI_IN) {
    bf16_t* Kp = (bf16_t*)(ws + OFF_KP); bf16_t* Ks = (bf16_t*)(ws + OFF_KS);
    bf16_t* Vtp = (bf16_t*)(ws + OFF_VTP); bf16_t* Vts = (bf16_t*)(ws + OFF_VTS);
#pragma unroll
    for (int bj = 0; bj < 2; ++bj) {
      const int col0 = pn * 256 + bj * 128;
#pragma unroll
      for (int ai = 0; ai < 2; ++ai)
#pragma unroll
        for (int m = 0; m < 4; ++m) {
          const int row = pm * 256 + ai * 128 + wr * 64 + m * 16 + fr;
#pragma unroll
          for (int n = 0; n < 2; ++n) {
            const int col = col0 + wc * 32 + n * 16 + fq * 4;
            f32x4 v = acc[ai][bj][m][n];
            if (col0 < 1024) {
              *(u32x2*)(P + (size_t)row * PW + col) = pk4(v);
            } else if (col0 >= 1280) {
              v.x = sigmoidf_(v.x); v.y = sigmoidf_(v.y); v.z = sigmoidf_(v.z); v.w = sigmoidf_(v.w);
              *(u32x2*)(P + (size_t)row * PW + col - 256) = pk4(v);
            } else if (col0 == 1024) {
              const int cc = col - 1024;
              if (row < MP) {
                *(u32x2*)(Kp + (size_t)row * 128 + cc) = pk4(v);
                const int pos = row & 2047;
                if (pos >= 1920) *(f32x4*)(p.out + O_KP + ((size_t)(row >> 11) * 128 + (pos - 1920)) * 128 + cc) = v;
              } else {
                const int s = row - MP, b = s >> 2, tt = s & 3;
                *(u32x2*)(Ks + ((size_t)b * 144 + 128 + tt) * 128 + cc) = pk4(v);
                *(f32x4*)(p.out + O_KS + ((size_t)b * 128 + 124 + tt) * 128 + cc) = v;
              }
            } else {
              const int cc = col - 1152, kv = cc >> 6, d = cc & 63;
              if (row < MP) {
                const int b = row >> 11, pos = row & 2047;
                bf16_t* dst = Vtp + ((size_t)(b * 2 + kv) * 64 + d) * 2048 + pos;
                dst[0] = f2bf(v.x); dst[2048] = f2bf(v.y); dst[4096] = f2bf(v.z); dst[6144] = f2bf(v.w);
                if (pos >= 1920) *(f32x4*)(p.out + O_VP + ((size_t)b * 128 + (pos - 1920)) * 128 + cc) = v;
              } else {
                const int s = row - MP, b = s >> 2, tt = s & 3;
                bf16_t* dst = Vts + ((size_t)(b * 2 + kv) * 64 + d) * 144 + 128 + tt;
                dst[0] = f2bf(v.x); dst[144] = f2bf(v.y); dst[288] = f2bf(v.z); dst[432] = f2bf(v.w);
                *(f32x4*)(p.out + O_VS + ((size_t)b * 128 + 124 + tt) * 128 + cc) = v;
              }
            }
          }
        }
    }
  } else if constexpr (EPI == EPI_GLU) {
    bf16_t* Mg = (bf16_t*)(ws + OFF_MG);
#pragma unroll
    for (int ai = 0; ai < 2; ++ai)
#pragma unroll
      for (int m = 0; m < 4; ++m) {
        const int row = pm * 256 + ai * 128 + wr * 64 + m * 16 + fr;
#pragma unroll
        for (int bj = 0; bj < 2; ++bj) {
          const int j0 = pn * 128 + bj * 64 + wc * 16 + fq * 4;
          const f32x4 ya = acc[ai][bj][m][0], yb = acc[ai][bj][m][1];
          const f32x4 gs = unpk4(*(const u32x2*)(P + (size_t)row * PW + 1024 + j0));
          f32x4 sv;
          sv.x = gs.x * ya.x * sigmoidf_(yb.x); sv.y = gs.y * ya.y * sigmoidf_(yb.y);
          sv.z = gs.z * ya.z * sigmoidf_(yb.z); sv.w = gs.w * ya.w * sigmoidf_(yb.w);
          *(u32x2*)(Mg + (size_t)row * DM + j0) = pk4(sv);
        }
      }
  } else if constexpr (EPI == EPI_ATT) {
    bf16_t* Mg = (bf16_t*)(ws + OFF_MG);
#pragma unroll
    for (int ai = 0; ai < 2; ++ai)
#pragma unroll
      for (int m = 0; m < 4; ++m) {
        const int row = pm * 256 + ai * 128 + wr * 64 + m * 16 + fr;
#pragma unroll
        for (int bj = 0; bj < 2; ++bj)
#pragma unroll
          for (int n = 0; n < 2; ++n) {
            const int col = pn * 256 + bj * 128 + wc * 32 + n * 16 + fq * 4;
            const f32x4 ga = unpk4(*(const u32x2*)(P + (size_t)row * PW + 2048 + col));
            const f32x4 sv = unpk4(*(const u32x2*)(Mg + (size_t)row * DM + col));
            f32x4 v = acc[ai][bj][m][n];
            v.x = sv.x + ga.x * v.x; v.y = sv.y + ga.y * v.y; v.z = sv.z + ga.z * v.z; v.w = sv.w + ga.w * v.w;
            *(u32x2*)(Mg + (size_t)row * DM + col) = pk4(v);
          }
      }
  } else if constexpr (EPI == EPI_WO || EPI == EPI_DOWN) {
    const bf16_t* X1b = (const bf16_t*)(ws + OFF_X1B);
#pragma unroll
    for (int ai = 0; ai < 2; ++ai)
#pragma unroll
      for (int m = 0; m < 4; ++m) {
        const int row = pm * 256 + ai * 128 + wr * 64 + m * 16 + fr;
#pragma unroll
        for (int bj = 0; bj < 2; ++bj)
#pragma unroll
          for (int n = 0; n < 2; ++n) {
            const int col = pn * 256 + bj * 128 + wc * 32 + n * 16 + fq * 4;
            f32x4 x;
            if constexpr (EPI == EPI_WO) x = *(const f32x4*)(p.in[0] + (size_t)row * DM + col);
            else x = unpk4(*(const u32x2*)(X1b + (size_t)row * DM + col));
            f32x4 v = acc[ai][bj][m][n];
            v.x += ALPHA_F * x.x; v.y += ALPHA_F * x.y; v.z += ALPHA_F * x.z; v.w += ALPHA_F * x.w;
            *(u32x2*)((bf16_t*)(ws + (EPI == EPI_WO ? OFF_PRE1 : OFF_PRE2)) + (size_t)row * DM + col) = pk4(v);
          }
      }
  } else {
    bf16_t* H = (bf16_t*)(ws + OFF_H);
    float* HA0 = (float*)(ws + OFF_HA0); float* HG0 = (float*)(ws + OFF_HG0); float* HA1 = (float*)(ws + OFF_HA1);
    const bool prompt = (pm < MP / 256);
#pragma unroll
    for (int bj = 0; bj < 2; ++bj) {
      const int j0 = pn * 128 + bj * 64 + wc * 16 + fq * 4;
      const f32x4 w0 = *(const f32x4*)(p.in[23] + j0), w1 = *(const f32x4*)(p.in[23] + DFF + j0), w2 = *(const f32x4*)(p.in[23] + 2 * DFF + j0);
      const f32x4 cb = *(const f32x4*)(p.in[24] + j0);
#pragma unroll
      for (int ai = 0; ai < 2; ++ai) {
        const int rblk = pm * 256 + ai * 128 + wr * 64;
#pragma unroll
        for (int m = 0; m < 4; ++m) {
          const int row = rblk + m * 16 + fr;
          const f32x4 a0 = acc[ai][bj][m][0], g = acc[ai][bj][m][1];
          f32x4 am1, am2; bool defer = false;
          if (prompt) {
            f32x4 o1 = f32x4{0.f, 0.f, 0.f, 0.f}, o2 = o1;
            if (m > 0) { o1 = ror1v(acc[ai][bj][m > 0 ? m - 1 : 0][0]); o2 = ror2v(acc[ai][bj][m > 0 ? m - 1 : 0][0]); }
            am1 = shr1v(o1, a0); am2 = shr2v(o2, a0);
            if (m == 0 && fr < 2 && (row & 2047) >= 2) defer = true;
            if (m == 3 && fr >= 14) *(f32x4*)(HA1 + ((size_t)(rblk >> 6) * 2 + (fr - 14)) * DFF + j0) = a0;
            const int pos = row & 2047;
            if (pos >= 2046) *(f32x4*)(p.out + O_CP + ((size_t)(row >> 11) * 2 + (pos - 2046)) * DFF + j0) = a0;
          } else {
            const int sidx = row - MP, b = sidx >> 2, tt = sidx & 3;
            const f32x4 st0 = *(const f32x4*)(p.in[6] + ((size_t)b * 2 + 0) * DFF + j0);
            const f32x4 st1 = *(const f32x4*)(p.in[6] + ((size_t)b * 2 + 1) * DFF + j0);
            const f32x4 s1 = ror1v(a0), s2 = ror2v(a0);
            am1 = (tt >= 1) ? s1 : st1;
            am2 = (tt >= 2) ? s2 : ((tt == 1) ? st1 : st0);
            if (tt >= 2) *(f32x4*)(p.out + O_CS + ((size_t)b * 2 + (tt - 2)) * DFF + j0) = a0;
          }
          if (!defer) {
            f32x4 h;
            h.x = gelu_tanh(cb.x + w0.x * am2.x + w1.x * am1.x + w2.x * a0.x) * g.x;
            h.y = gelu_tanh(cb.y + w0.y * am2.y + w1.y * am1.y + w2.y * a0.y) * g.y;
            h.z = gelu_tanh(cb.z + w0.z * am2.z + w1.z * am1.z + w2.z * a0.z) * g.z;
            h.w = gelu_tanh(cb.w + w0.w * am2.w + w1.w * am1.w + w2.w * a0.w) * g.w;
            *(u32x2*)(H + (size_t)row * DFF + j0) = pk4(h);
          } else {
            *(f32x4*)(HA0 + ((size_t)(rblk >> 6) * 2 + fr) * DFF + j0) = a0;
            *(f32x4*)(HG0 + ((size_t)(rblk >> 6) * 2 + fr) * DFF + j0) = g;
          }
        }
      }
    }
  }
}

template <int EPI>
__device__ __forceinline__ void gemm_phase(const Params& p, const bf16_t* __restrict__ gA, const bf16_t* __restrict__ gBt, const int K, const int N, LAS unsigned char* lds,
                                           const bf16_t* __restrict__ gA2 = nullptr, const bf16_t* __restrict__ gBt2 = nullptr) {
    using namespace pg8;
    int tid_ = threadIdx.x; asm volatile("" : "+v"(tid_));
    const int tid = tid_, wid = __builtin_amdgcn_readfirstlane(tid >> 6), lane = tid & 63, wr = wid >> 2, wc = wid & 3, fr = lane & 15, fq = lane >> 4;
    const int nt = K / BK;
    constexpr bool SPLIT = (EPI == EPI_WO || EPI == EPI_DOWN || EPI == EPI_GLU);
    constexpr bool PROMPT_ONLY = SPLIT || (EPI == EPI_ATT);
    constexpr int NSPLIT = (EPI == EPI_WO) ? 8 : (EPI == EPI_DOWN ? 11 : 4);
    StaticOrder S; S.init(PROMPT_ONLY ? MP : MT, N, gridDim.x, blockIdx.x);
    const int nN_ = N / BM;
    S.nt = nt; S.nsplit = SPLIT ? NSPLIT : 0; S.glu = (EPI == EPI_GLU) ? 1 : 0;
    S.nslice_items = (EPI == EPI_GLU) ? 96 : 2 * nN_ * NSPLIT;
    unsigned voff[2];
#pragma unroll
    for (int i = 0; i < 2; ++i) { int R, C; stage_rc(tid * 16 + i * 8192, R, C); voff[i] = (unsigned)(R * K + C) * 2u; }
    const size_t kstep = (size_t)(BK * 2);
    const size_t hstep = (size_t)HALF * K * 2;
    const size_t tstep = 2 * hstep;
    const unsigned ldsw = (unsigned)wid * 1024u;
    const int aoff = lds_byte(wr * 64 + fr, fq * 8), boff = lds_byte(wc * 32 + fr, fq * 8);
#define PG8_SA(b, h) (((b) * 2 + (h)) * HTB)
#define PG8_SB(b, h) ((4 + (b) * 2 + (h)) * HTB)
#define PG8_STAGE(bufoff, gbase) do { _Pragma("unroll") for (int _i = 0; _i < 2; ++_i) \
        __builtin_amdgcn_global_load_lds((const unsigned*)((const char*)(gbase) + voff[_i]), (LAS unsigned*)(lds + (bufoff) + ldsw + _i * 8192), 16, 0, 0); } while (0)
#define PG8_LDA(dst, b, h) do { _Pragma("unroll") for (int m = 0; m < 4; ++m) _Pragma("unroll") for (int k = 0; k < 2; ++k) dst[m][k] = *(const LAS bf16x8*)(lds + PG8_SA(b, h) + aoff + m * 2048 + k * 1024); } while (0)
#define PG8_LDB(dst, b, h) do { _Pragma("unroll") for (int n = 0; n < 2; ++n) _Pragma("unroll") for (int k = 0; k < 2; ++k) dst[n][k] = *(const LAS bf16x8*)(lds + PG8_SB(b, h) + boff + n * 2048 + k * 1024); } while (0)
#define PG8_MMA(ai, bj, At, Bt) do { __builtin_amdgcn_s_setprio(1); _Pragma("unroll") for (int m = 0; m < 4; ++m) _Pragma("unroll") for (int n = 0; n < 2; ++n) _Pragma("unroll") for (int k = 0; k < 2; ++k) \
        acc[ai][bj][m][n] = __builtin_amdgcn_mfma_f32_16x16x32_bf16(Bt[n][k], At[m][k], acc[ai][bj][m][n], 0, 0, 0); __builtin_amdgcn_s_setprio(0); } while (0)
#define PG8_WAIT_V(n) asm volatile("s_waitcnt vmcnt(" #n ")" ::: "memory")
#define PG8_WAIT_L(n) asm volatile("s_waitcnt lgkmcnt(" #n ")" ::: "memory")
#define PG8_BAR __builtin_amdgcn_s_barrier()
#define PG8_SCHED __builtin_amdgcn_sched_barrier(0)
    int ui = 0, cur_pm, cur_pn, cur_k0, cur_nk, cur_slice, cur_src, nxt_pm, nxt_pn, nxt_k0, nxt_nk, nxt_slice, nxt_src;
    if (!S.next(0, cur_pm, cur_pn, cur_k0, cur_nk, cur_slice, cur_src)) return;
    f32x4 acc[2][2][4][2];
#pragma unroll
    for (int a = 0; a < 2; ++a)
#pragma unroll
        for (int b = 0; b < 2; ++b)
#pragma unroll
            for (int m = 0; m < 4; ++m)
#pragma unroll
                for (int n = 0; n < 2; ++n) acc[a][b][m][n] = (f32x4){0.f, 0.f, 0.f, 0.f};
    bf16x8 At[4][2], B0[2][2], B1[2][2];
    const char* cA = (const char*)((EPI == EPI_GLU && cur_src) ? gA2 : gA) + (size_t)cur_pm * tstep + (size_t)cur_k0 * kstep;
    const char* cB = (const char*)((EPI == EPI_GLU && cur_src) ? gBt2 : gBt) + (size_t)cur_pn * tstep + (size_t)cur_k0 * kstep;
    PG8_STAGE(PG8_SB(0, 0), cB); PG8_STAGE(PG8_SB(0, 1), cB + hstep); PG8_STAGE(PG8_SA(0, 0), cA); PG8_STAGE(PG8_SA(0, 1), cA + hstep);
    if (wr == 1) PG8_BAR;
    PG8_WAIT_V(2); PG8_BAR;
    PG8_STAGE(PG8_SB(1, 0), cB + kstep); PG8_STAGE(PG8_SA(1, 0), cA + kstep); PG8_STAGE(PG8_SB(1, 1), cB + hstep + kstep);
    PG8_WAIT_V(6); PG8_BAR;
    for (;;) {
        const bool has_next = S.next(ui + 1, nxt_pm, nxt_pn, nxt_k0, nxt_nk, nxt_slice, nxt_src);
        const char* nA = has_next ? (const char*)((EPI == EPI_GLU && nxt_src) ? gA2 : gA) + (size_t)nxt_pm * tstep + (size_t)nxt_k0 * kstep : cA;
        const char* nB = has_next ? (const char*)((EPI == EPI_GLU && nxt_src) ? gBt2 : gBt) + (size_t)nxt_pn * tstep + (size_t)nxt_k0 * kstep : cB;
        const int cnk = cur_nk;
        for (int t = 0; t < cnk; t += 2) {
            const bool last = (t == cnk - 2);
            const char* a1 = cA + (size_t)(t + 1) * kstep;
            const char* a2 = last ? nA : cA + (size_t)(t + 2) * kstep; const char* b2 = last ? nB : cB + (size_t)(t + 2) * kstep;
            const char* a3 = a2 + kstep; const char* b3 = b2 + kstep;
            PG8_LDB(B0, 0, 0); PG8_LDB(B1, 0, 1); PG8_SCHED; PG8_LDA(At, 0, 0); PG8_STAGE(PG8_SA(1, 1), a1 + hstep);
            PG8_WAIT_V(8); PG8_WAIT_L(0); PG8_BAR; PG8_MMA(0, 0, At, B0); PG8_MMA(0, 1, At, B1); PG8_BAR; PG8_SCHED;
            PG8_LDA(At, 0, 1); PG8_STAGE(PG8_SB(0, 0), b2); PG8_STAGE(PG8_SB(0, 1), b2 + hstep); PG8_STAGE(PG8_SA(0, 0), a2);
            PG8_WAIT_V(8); PG8_WAIT_L(0); PG8_BAR; PG8_MMA(1, 0, At, B0); PG8_MMA(1, 1, At, B1); PG8_BAR; PG8_SCHED;
            PG8_LDB(B0, 1, 0); PG8_LDB(B1, 1, 1); PG8_SCHED; PG8_LDA(At, 1, 0); PG8_STAGE(PG8_SA(0, 1), a2 + hstep);
            PG8_WAIT_V(8); PG8_WAIT_L(0); PG8_BAR; PG8_MMA(0, 0, At, B0); PG8_MMA(0, 1, At, B1); PG8_BAR; PG8_SCHED;
            PG8_LDA(At, 1, 1); PG8_STAGE(PG8_SB(1, 0), b3); PG8_STAGE(PG8_SB(1, 1), b3 + hstep); PG8_STAGE(PG8_SA(1, 0), a3);
            PG8_WAIT_V(8); PG8_WAIT_L(0); PG8_BAR; PG8_MMA(1, 0, At, B0); PG8_MMA(1, 1, At, B1); PG8_BAR; PG8_SCHED;
        }
        if (wr == 0) PG8_BAR;
        if (SPLIT && cur_slice >= 0) {
            const int ldc = (EPI == EPI_GLU && cur_src == 0) ? 2048 : DM;
            float* SL = (float*)(p.ws + (EPI == EPI_WO ? OFF_SLAB_WO : (EPI == EPI_DOWN ? OFF_SLAB_DN : (cur_src ? OFF_SLAB_ATT : OFF_SLAB_GLU)))) + (size_t)cur_slice * MS * ldc;
#pragma unroll
            for (int ai = 0; ai < 2; ++ai)
#pragma unroll
                for (int m = 0; m < 4; ++m) {
                    const int rs = (cur_pm - 64) * 256 + ai * 128 + wr * 64 + m * 16 + fr;
#pragma unroll
                    for (int bj = 0; bj < 2; ++bj)
#pragma unroll
                        for (int n = 0; n < 2; ++n) *(f32x4*)(SL + (size_t)rs * ldc + cur_pn * 256 + bj * 128 + wc * 32 + n * 16 + fq * 4) = acc[ai][bj][m][n];
                }
        } else epilogue<EPI>(p, acc, cur_pm, cur_pn, wr, wc, fr, fq);
        if (!has_next) break;
#pragma unroll
        for (int a = 0; a < 2; ++a)
#pragma unroll
            for (int b = 0; b < 2; ++b)
#pragma unroll
                for (int m = 0; m < 4; ++m)
#pragma unroll
                    for (int n = 0; n < 2; ++n) acc[a][b][m][n] = (f32x4){0.f, 0.f, 0.f, 0.f};
        cur_pm = nxt_pm; cur_pn = nxt_pn; cur_k0 = nxt_k0; cur_nk = nxt_nk; cur_slice = nxt_slice; cur_src = nxt_src; cA = nA; cB = nB; ++ui;
        if (wr == 1) PG8_BAR;
    }
    PG8_WAIT_V(0);
    PG8_BAR;
#undef PG8_SA
#undef PG8_SB
#undef PG8_STAGE
#undef PG8_LDA
#undef PG8_LDB
#undef PG8_MMA
#undef PG8_WAIT_V
#undef PG8_WAIT_L
#undef PG8_BAR
#undef PG8_SCHED
}

template <int MODE>
__device__ __forceinline__ int dest_row(int n, int HH) {
  if (MODE == 0) return n;
  const int part = n >= HH ? 1 : 0, j = n - part * HH;
  const int tj = j >> 7, jl = j & 127, bj = jl >> 6, wcj = (jl >> 4) & 3, w = jl & 15;
  return tj * 256 + bj * 128 + wcj * 32 + part * 16 + w;
}
template <int MODE>
__device__ __forceinline__ void transpose_item(const float* __restrict__ W, int K, int N, bf16_t* __restrict__ WT, int HH, float* scr, int item, int lane) {
  const int nblk = N / 32, kb = item / nblk, nb = item - kb * nblk, k0 = 64 * kb, n0 = 32 * nb;
#pragma unroll 8
  for (int i = 0; i < 32; ++i) { const int kk = 2 * i + (lane >> 5); scr[kk * 33 + (lane & 31)] = W[(size_t)(k0 + kk) * N + n0 + (lane & 31)]; }
  asm volatile("s_waitcnt lgkmcnt(0)" ::: "memory");
  const int c = lane & 7;
#pragma unroll
  for (int j = 0; j < 4; ++j) {
    const int n = (lane >> 3) + 8 * j; const float* s = scr + (8 * c) * 33 + n;
    u32x4 o; o.x = pk2(s[0], s[33]); o.y = pk2(s[66], s[99]); o.z = pk2(s[132], s[165]); o.w = pk2(s[198], s[231]);
    *(u32x4*)(WT + (size_t)dest_row<MODE>(n0 + n, HH) * K + k0 + 8 * c) = o;
  }
  asm volatile("s_waitcnt lgkmcnt(0)" ::: "memory");
}

__device__ __forceinline__ void prep_phase(const Params& p, char* lds) {
  unsigned char* ws = p.ws;
  const int tid = threadIdx.x, lane = tid & 63, wid = tid >> 6;
  const int gt = blockIdx.x * NTHR + tid, NGT = gridDim.x * NTHR;
  const int gw = blockIdx.x * NWAVE + wid, NGW = gridDim.x * NWAVE;
  {
    bf16_t* Xb = (bf16_t*)(ws + OFF_B);
    const int nchunk = MT * DM / 8, npc = MP * DM / 8;
    const int nmain = (nchunk / (4 * NGT)) * (4 * NGT);
    for (int i0 = gt; i0 < nmain / 4; i0 += NGT) {
      f32x4 a[4], b[4];
#pragma unroll
      for (int q = 0; q < 4; ++q) {
        const int i = i0 + q * (nmain / 4);
        const float* sp = (i < npc) ? p.in[0] + (size_t)i * 8 : p.in[1] + (size_t)(i - npc) * 8;
        a[q] = *(const f32x4*)sp; b[q] = *(const f32x4*)(sp + 4);
      }
#pragma unroll
      for (int q = 0; q < 4; ++q) {
        const int i = i0 + q * (nmain / 4);
        u32x4 o; o.x = pk2(a[q].x, a[q].y); o.y = pk2(a[q].z, a[q].w); o.z = pk2(b[q].x, b[q].y); o.w = pk2(b[q].z, b[q].w);
        *(u32x4*)(Xb + (size_t)i * 8) = o;
      }
    }
    for (int i = nmain + gt; i < nchunk; i += NGT) {
      const float* sp = (i < npc) ? p.in[0] + (size_t)i * 8 : p.in[1] + (size_t)(i - npc) * 8;
      const f32x4 a = *(const f32x4*)sp, b = *(const f32x4*)(sp + 4);
      u32x4 o; o.x = pk2(a.x, a.y); o.y = pk2(a.z, a.w); o.z = pk2(b.x, b.y); o.w = pk2(b.z, b.w);
      *(u32x4*)(Xb + (size_t)i * 8) = o;
    }
  }
  {
    float* scr = (float*)(lds + wid * 8704);
    constexpr int I_IN = 16 * 104, I_GLU = 8 * 64, I_ATT = 8 * 32, I_O = 16 * 32, I_UP = 16 * 176, I_DN = 44 * 32;
    constexpr int NIT = I_IN + I_GLU + I_ATT + I_O + I_UP + I_DN;
    for (int it = gw; it < NIT; it += NGW) {
      int r = it;
      if (r < I_IN) { transpose_item<0>(p.in[7], 1024, DIN, (bf16_t*)(ws + OFF_WIN), 0, scr, r, lane); continue; } r -= I_IN;
      if (r < I_GLU) { transpose_item<1>(p.in[16], 512, 2048, (bf16_t*)(ws + OFF_WGLU), 1024, scr, r, lane); continue; } r -= I_GLU;
      if (r < I_ATT) { transpose_item<0>(p.in[18], 512, 1024, (bf16_t*)(ws + OFF_WATT), 0, scr, r, lane); continue; } r -= I_ATT;
      if (r < I_O) { transpose_item<0>(p.in[19], 1024, 1024, (bf16_t*)(ws + OFF_WO), 0, scr, r, lane); continue; } r -= I_O;
      if (r < I_UP) { transpose_item<1>(p.in[22], 1024, 5632, (bf16_t*)(ws + OFF_WUP), DFF, scr, r, lane); continue; } r -= I_UP;
      transpose_item<0>(p.in[25], DFF, 1024, (bf16_t*)(ws + OFF_WDN), 0, scr, r, lane);
    }
  }
  {
    bf16_t* Ks = (bf16_t*)(ws + OFF_KS); bf16_t* Vts = (bf16_t*)(ws + OFF_VTS);
    const float* ck = p.in[2]; const float* cv = p.in[3];
    for (int i = gt; i < 128 * 128 * 16; i += NGT) {
      const int c8 = i & 15, w = (i >> 4) & 127, b = i >> 11;
      const float* s = ck + ((size_t)b * 128 + w) * 128 + c8 * 8;
      const f32x4 a = *(const f32x4*)s, bq = *(const f32x4*)(s + 4);
      u32x4 o; o.x = pk2(a.x, a.y); o.y = pk2(a.z, a.w); o.z = pk2(bq.x, bq.y); o.w = pk2(bq.z, bq.w);
      *(u32x4*)(Ks + ((size_t)b * 144 + w) * 128 + c8 * 8) = o;
    }
    for (int i = gt; i < 128 * 12 * 16; i += NGT) {
      const int c8 = i & 15, r = (i >> 4) % 12, b = i / 192;
      *(u32x4*)(Ks + ((size_t)b * 144 + 132 + r) * 128 + c8 * 8) = u32x4{0u, 0u, 0u, 0u};
    }
    for (int i = gt; i < 128 * 16 * 128; i += NGT) {
      const int kvd = i & 127, w8 = (i >> 7) & 15, b = i >> 11;
      const float* s = cv + ((size_t)b * 128 + w8 * 8) * 128 + kvd;
      u32x4 o; o.x = pk2(s[0], s[128]); o.y = pk2(s[256], s[384]); o.z = pk2(s[512], s[640]); o.w = pk2(s[768], s[896]);
      *(u32x4*)(Vts + ((size_t)b * 128 + kvd) * 144 + w8 * 8) = o;
    }
    for (int i = gt; i < 128 * 128 * 3; i += NGT) {
      const int q = i % 3, r = i / 3;
      *(u32x2*)(Vts + (size_t)r * 144 + 132 + q * 4) = u32x2{0u, 0u};
    }
    for (int i = gt; i < 128 * 124 * 32; i += NGT) {
      const int c4 = i & 31, w = (i >> 5) % 124, b = i / (124 * 32);
      const size_t so = ((size_t)b * 128 + w + 4) * 128 + c4 * 4, dof = ((size_t)b * 128 + w) * 128 + c4 * 4;
      *(f32x4*)(p.out + O_KS + dof) = *(const f32x4*)(ck + so);
      *(f32x4*)(p.out + O_VS + dof) = *(const f32x4*)(cv + so);
    }
  }
  {
    float* AR = (float*)(ws + OFF_AR); float* AI = (float*)(ws + OFF_AI); bf16_t* BB = (bf16_t*)(ws + OFF_BB);
    for (int i = gt; i < 2048; i += NGT) {
      const int g = i >> 6, pp = i & 63;
      const float lr = p.in[8][i], li = p.in[9][i], dt = expf(p.in[10][g]);
      const float mag = expf(lr * dt), ang = li * dt;
      const float abr = mag * cosf(ang), abi = mag * sinf(ang);
      const float den = lr * lr + li * li, nr = abr - 1.f;
      const float cr = (nr * lr + abi * li) / den, ci = (abi * lr - nr * li) / den;
      AR[i] = abr; AI[i] = abi;
      const float* br = p.in[11] + (size_t)i * 16; const float* bi = p.in[12] + (size_t)i * 16;
      bf16_t* dre = BB + ((size_t)g * 128 + pp) * 16; bf16_t* dim_ = BB + ((size_t)g * 128 + 64 + pp) * 16;
#pragma unroll
      for (int c = 0; c < 16; ++c) {
        dre[c] = f2bf(cr * br[c] - ci * bi[c]);
        dim_[c] = f2bf(cr * bi[c] + ci * br[c]);
      }
    }
  }
}

#define CMUL_ACC(dr, di, ar_, ai_, br_, bi_) do { const float t_r = (ar_) * (br_) - (ai_) * (bi_); const float t_i = (ar_) * (bi_) + (ai_) * (br_); dr += t_r; di += t_i; } while (0)

template <int MODE>
__device__ __forceinline__ void scan_unit(const Params& p, int u, int lane, bf16_t* Hs) {
  unsigned char* ws = p.ws;
  const int pl = lane & 15, q4 = lane >> 4;
  const bf16_t* P = (const bf16_t*)(ws + OFF_P);
  const float* AR = (const float*)(ws + OFF_AR); const float* AI = (const float*)(ws + OFF_AI);
  const bf16_t* BB = (const bf16_t*)(ws + OFF_BB);
  float* E = (float*)(ws + OFF_E);
  int g, s = 0, c = 0, R0, ntile;
  if (MODE == 2) { g = u & 31; const int ti = u >> 5; R0 = MP + ti * 16; ntile = 1; s = ti; }
  else { c = u & 15; g = (u >> 4) & 31; s = u >> 9; R0 = s * 2048 + c * 128; ntile = 8; }
  float ar[4], ai[4], a4r[4], a4i[4], a8r[4], a8i[4], a128r[4], a128i[4];
#pragma unroll
  for (int q = 0; q < 4; ++q) {
    const float r1 = AR[g * 64 + q * 16 + pl], i1 = AI[g * 64 + q * 16 + pl];
    ar[q] = r1; ai[q] = i1;
    const float r2 = r1 * r1 - i1 * i1, i2 = 2.f * r1 * i1;
    const float r4 = r2 * r2 - i2 * i2, i4 = 2.f * r2 * i2;
    const float r8 = r4 * r4 - i4 * i4, i8 = 2.f * r4 * i4;
    a4r[q] = r4; a4i[q] = i4; a8r[q] = r8; a8i[q] = i8;
    const float r16 = r8 * r8 - i8 * i8, i16 = 2.f * r8 * i8;
    const float r32 = r16 * r16 - i16 * i16, i32 = 2.f * r16 * i16;
    const float r64 = r32 * r32 - i32 * i32, i64 = 2.f * r32 * i32;
    a128r[q] = r64 * r64 - i64 * i64; a128i[q] = 2.f * r64 * i64;
  }
  bf16x4 bb[8];
#pragma unroll
  for (int pt = 0; pt < 8; ++pt) bb[pt] = *(const bf16x4*)(BB + ((size_t)g * 128 + pt * 16 + pl) * 16 + q4 * 4);
  bf16x8 cm[4]; bf16x4 dmv;
  if (MODE != 0) {
#pragma unroll
    for (int ks = 0; ks < 4; ++ks) {
      const float* src = ((ks < 2) ? p.in[13] : p.in[14]) + ((size_t)g * 16 + pl) * 64 + (ks & 1) * 32 + q4 * 8;
      const float sg = (ks < 2) ? 1.f : -1.f;
      const f32x4 x0 = *(const f32x4*)src, x1 = *(const f32x4*)(src + 4);
      u32x4 o; o.x = pk2(sg * x0.x, sg * x0.y); o.y = pk2(sg * x0.z, sg * x0.w); o.z = pk2(sg * x1.x, sg * x1.y); o.w = pk2(sg * x1.z, sg * x1.w);
      cm[ks] = __builtin_bit_cast(bf16x8, o);
    }
    const float dv = p.in[15][g * 16 + pl];
    u32x2 o;
    o.x = pk2((q4 * 4 + 0 == pl) ? dv : 0.f, (q4 * 4 + 1 == pl) ? dv : 0.f);
    o.y = pk2((q4 * 4 + 2 == pl) ? dv : 0.f, (q4 * 4 + 3 == pl) ? dv : 0.f);
    dmv = __builtin_bit_cast(bf16x4, o);
  }
  float hr[4], hi[4];
#pragma unroll
  for (int q = 0; q < 4; ++q) { hr[q] = 0.f; hi[q] = 0.f; }
  if (MODE == 1) {
    const float* Eb = E + ((size_t)(s * 32 + g) * 16) * 128;
#pragma unroll
    for (int bt = 0; bt < 3; ++bt) {
      if (bt * 5 < c) {
        float er[5][4], ei[5][4];
#pragma unroll
        for (int k = 0; k < 5; ++k)
#pragma unroll
          for (int q = 0; q < 4; ++q) { er[k][q] = Eb[(bt * 5 + k) * 128 + q * 16 + pl]; ei[k][q] = Eb[(bt * 5 + k) * 128 + 64 + q * 16 + pl]; }
#pragma unroll
        for (int k = 0; k < 5; ++k) {
          const bool on = (bt * 5 + k) < c;
#pragma unroll
          for (int q = 0; q < 4; ++q) {
            const float nr_ = a128r[q] * hr[q] - a128i[q] * hi[q] + er[k][q];
            const float ni_ = a128r[q] * hi[q] + a128i[q] * hr[q] + ei[k][q];
            hr[q] = on ? nr_ : hr[q]; hi[q] = on ? ni_ : hi[q];
          }
        }
      }
    }
  }
  if (MODE == 2) {
    const int b = s * 4 + q4;
#pragma unroll
    for (int q = 0; q < 4; ++q) {
      hr[q] = p.in[4][((size_t)b * 32 + g) * 64 + q * 16 + pl];
      hi[q] = p.in[5][((size_t)b * 32 + g) * 64 + q * 16 + pl];
    }
  }
  const bf16_t* up = P + (size_t)(R0 + pl) * PW + g * 16 + q4 * 4;
  bf16x4 uf_next = *(const bf16x4*)up;
#pragma unroll 2
  for (int tile = 0; tile < ntile; ++tile) {
    const int Rt = R0 + tile * 16;
    const bf16x4 uf = uf_next;
    if (tile + 1 < ntile) uf_next = *(const bf16x4*)(up + (size_t)(tile + 1) * 16 * PW);
    f32x4 xr[4], xi[4];
    const f32x4 z4 = f32x4{0.f, 0.f, 0.f, 0.f};
#pragma unroll
    for (int q = 0; q < 4; ++q) {
      xr[q] = __builtin_amdgcn_mfma_f32_16x16x16bf16_1k(uf, bb[q], z4, 0, 0, 0);
      xi[q] = __builtin_amdgcn_mfma_f32_16x16x16bf16_1k(uf, bb[q + 4], z4, 0, 0, 0);
    }
#pragma unroll
    for (int q = 0; q < 4; ++q) {
      float s0r = xr[q].x, s0i = xi[q].x, s1r = xr[q].y, s1i = xi[q].y, s2r = xr[q].z, s2i = xi[q].z, s3r = xr[q].w, s3i = xi[q].w;
      if (MODE == 2 || q4 == 0) CMUL_ACC(s0r, s0i, ar[q], ai[q], hr[q], hi[q]);
      CMUL_ACC(s1r, s1i, ar[q], ai[q], s0r, s0i);
      CMUL_ACC(s2r, s2i, ar[q], ai[q], s1r, s1i);
      CMUL_ACC(s3r, s3i, ar[q], ai[q], s2r, s2i);
      if (MODE != 2) {
        float Ir = s3r, Ii = s3i;
        float tr = __shfl_up(Ir, 16), ti = __shfl_up(Ii, 16);
        if (q4 >= 1) CMUL_ACC(Ir, Ii, a4r[q], a4i[q], tr, ti);
        tr = __shfl_up(Ir, 32); ti = __shfl_up(Ii, 32);
        if (q4 >= 2) CMUL_ACC(Ir, Ii, a8r[q], a8i[q], tr, ti);
        float cr = __shfl_up(Ir, 16), ci = __shfl_up(Ii, 16);
        if (q4 == 0) { cr = 0.f; ci = 0.f; }
        float t1r = ar[q] * cr - ai[q] * ci, t1i = ar[q] * ci + ai[q] * cr; s0r += t1r; s0i += t1i;
        float t2r = ar[q] * t1r - ai[q] * t1i, t2i = ar[q] * t1i + ai[q] * t1r; s1r += t2r; s1i += t2i;
        float t3r = ar[q] * t2r - ai[q] * t2i, t3i = ar[q] * t2i + ai[q] * t2r; s2r += t3r; s2i += t3i;
        float t4r = ar[q] * t3r - ai[q] * t3i, t4i = ar[q] * t3i + ai[q] * t3r; s3r += t4r; s3i += t4i;
        hr[q] = __shfl(s3r, 48 + pl); hi[q] = __shfl(s3i, 48 + pl);
      } else {
        hr[q] = s3r; hi[q] = s3i;
      }
      xr[q] = f32x4{s0r, s1r, s2r, s3r}; xi[q] = f32x4{s0i, s1i, s2i, s3i};
    }
    if (MODE != 0) {
#pragma unroll
      for (int q = 0; q < 4; ++q) {
        Hs[(q4 * 4 + 0) * 136 + q * 16 + pl] = f2bf(xr[q].x); Hs[(q4 * 4 + 1) * 136 + q * 16 + pl] = f2bf(xr[q].y);
        Hs[(q4 * 4 + 2) * 136 + q * 16 + pl] = f2bf(xr[q].z); Hs[(q4 * 4 + 3) * 136 + q * 16 + pl] = f2bf(xr[q].w);
        Hs[(q4 * 4 + 0) * 136 + 64 + q * 16 + pl] = f2bf(xi[q].x); Hs[(q4 * 4 + 1) * 136 + 64 + q * 16 + pl] = f2bf(xi[q].y);
        Hs[(q4 * 4 + 2) * 136 + 64 + q * 16 + pl] = f2bf(xi[q].z); Hs[(q4 * 4 + 3) * 136 + 64 + q * 16 + pl] = f2bf(xi[q].w);
      }
      asm volatile("s_waitcnt lgkmcnt(0)" ::: "memory");
      f32x4 y = z4;
#pragma unroll
      for (int ks = 0; ks < 4; ++ks) {
        const bf16x8 hf = *(const bf16x8*)(Hs + pl * 136 + ks * 32 + q4 * 8);
        y = __builtin_amdgcn_mfma_f32_16x16x32_bf16(hf, cm[ks], y, 0, 0, 0);
      }
      y = __builtin_amdgcn_mfma_f32_16x16x16bf16_1k(uf, dmv, y, 0, 0, 0);
      asm volatile("s_waitcnt lgkmcnt(0)" ::: "memory");
      bf16_t* GY = (bf16_t*)(ws + OFF_GY);
      bf16_t* dst = GY + (size_t)(Rt + q4 * 4) * 512 + g * 16 + pl;
      dst[0] = f2bf(gelu_tanh(y.x)); dst[512] = f2bf(gelu_tanh(y.y)); dst[1024] = f2bf(gelu_tanh(y.z)); dst[1536] = f2bf(gelu_tanh(y.w));
    }
  }
  if (MODE == 0) {
    if (q4 == 0) {
      float* Eb = E + ((size_t)(s * 32 + g) * 16 + c) * 128;
#pragma unroll
      for (int q = 0; q < 4; ++q) { Eb[q * 16 + pl] = hr[q]; Eb[64 + q * 16 + pl] = hi[q]; }
    }
  } else if (MODE == 1) {
    if (c == 15 && q4 == 0) {
#pragma unroll
      for (int q = 0; q < 4; ++q) {
        p.out[O_HRP + ((size_t)s * 32 + g) * 64 + q * 16 + pl] = hr[q];
        p.out[O_HIP + ((size_t)s * 32 + g) * 64 + q * 16 + pl] = hi[q];
      }
    }
  } else {
    const int b = s * 4 + q4;
#pragma unroll
    for (int q = 0; q < 4; ++q) {
      p.out[O_HRS + ((size_t)b * 32 + g) * 64 + q * 16 + pl] = hr[q];
      p.out[O_HIS + ((size_t)b * 32 + g) * 64 + q * 16 + pl] = hi[q];
    }
  }
}

__device__ __forceinline__ void scan_end_unit(const Params& p, int u, int lane) {
  unsigned char* ws = p.ws;
  const int pl = lane & 15, q4 = lane >> 4;
  const bf16_t* P = (const bf16_t*)(ws + OFF_P);
  const float* AR = (const float*)(ws + OFF_AR); const float* AI = (const float*)(ws + OFF_AI);
  const bf16_t* BB = (const bf16_t*)(ws + OFF_BB);
  float* E = (float*)(ws + OFF_E);
  const int c = u & 15, g = (u >> 4) & 31, s = u >> 9, R0 = s * 2048 + c * 128;
  float ar[4], ai[4], wr_[4], wi_[4], a16r[4], a16i[4];
#pragma unroll
  for (int q = 0; q < 4; ++q) {
    const float r1 = AR[g * 64 + q * 16 + pl], i1 = AI[g * 64 + q * 16 + pl];
    ar[q] = r1; ai[q] = i1;
    const float r2 = r1 * r1 - i1 * i1, i2 = 2.f * r1 * i1;
    const float r4 = r2 * r2 - i2 * i2, i4 = 2.f * r2 * i2;
    const float r8 = r4 * r4 - i4 * i4, i8 = 2.f * r4 * i4;
    const float r12 = r8 * r4 - i8 * i4, i12 = r8 * i4 + i8 * r4;
    a16r[q] = r8 * r8 - i8 * i8; a16i[q] = 2.f * r8 * i8;
    wr_[q] = (q4 == 0) ? r12 : (q4 == 1) ? r8 : (q4 == 2) ? r4 : 1.f;
    wi_[q] = (q4 == 0) ? i12 : (q4 == 1) ? i8 : (q4 == 2) ? i4 : 0.f;
  }
  bf16x4 bb[8];
#pragma unroll
  for (int pt = 0; pt < 8; ++pt) bb[pt] = *(const bf16x4*)(BB + ((size_t)g * 128 + pt * 16 + pl) * 16 + q4 * 4);
  float er[4], ei[4];
#pragma unroll
  for (int q = 0; q < 4; ++q) { er[q] = 0.f; ei[q] = 0.f; }
  const bf16_t* up = P + (size_t)(R0 + pl) * PW + g * 16 + q4 * 4;
  bf16x4 uf_next = *(const bf16x4*)up;
  const f32x4 z4 = f32x4{0.f, 0.f, 0.f, 0.f};
#pragma unroll 2
  for (int tile = 0; tile < 8; ++tile) {
    const bf16x4 uf = uf_next;
    if (tile + 1 < 8) uf_next = *(const bf16x4*)(up + (size_t)(tile + 1) * 16 * PW);
#pragma unroll
    for (int q = 0; q < 4; ++q) {
      const f32x4 xr = __builtin_amdgcn_mfma_f32_16x16x16bf16_1k(uf, bb[q], z4, 0, 0, 0);
      const f32x4 xi = __builtin_amdgcn_mfma_f32_16x16x16bf16_1k(uf, bb[q + 4], z4, 0, 0, 0);
      float tr = xr.x, ti = xi.x, nr_, ni_;
      nr_ = ar[q] * tr - ai[q] * ti + xr.y; ni_ = ar[q] * ti + ai[q] * tr + xi.y; tr = nr_; ti = ni_;
      nr_ = ar[q] * tr - ai[q] * ti + xr.z; ni_ = ar[q] * ti + ai[q] * tr + xi.z; tr = nr_; ti = ni_;
      nr_ = ar[q] * tr - ai[q] * ti + xr.w; ni_ = ar[q] * ti + ai[q] * tr + xi.w; tr = nr_; ti = ni_;
      float sr = wr_[q] * tr - wi_[q] * ti, si = wr_[q] * ti + wi_[q] * tr;
      sr += __shfl_xor(sr, 16); si += __shfl_xor(si, 16);
      sr += __shfl_xor(sr, 32); si += __shfl_xor(si, 32);
      nr_ = a16r[q] * er[q] - a16i[q] * ei[q] + sr; ni_ = a16r[q] * ei[q] + a16i[q] * er[q] + si;
      er[q] = nr_; ei[q] = ni_;
    }
  }
  if (q4 == 0) {
    float* Eb = E + ((size_t)(s * 32 + g) * 16 + c) * 128;
#pragma unroll
    for (int q = 0; q < 4; ++q) { Eb[q * 16 + pl] = er[q]; Eb[64 + q * 16 + pl] = ei[q]; }
  }
}

template <bool LDSRC>
__device__ __forceinline__ void attn_core(const Params& p, const int lane, const char* kptr, const int kstride, const char* vptr, const int vstride,
                                          const int kt0, const int has_prev, const int row_q, const int h_q, const int i_q) {
  unsigned char* ws = p.ws;
  const int pl = lane & 15, q4 = lane >> 4;
  const bf16_t* P = (const bf16_t*)(ws + OFF_P);
  const float sink = p.in[17][h_q];
  const bf16_t* qp = P + (size_t)row_q * PW + 512 + h_q * 64 + q4 * 8;
  const bf16x8 qf0 = *(const bf16x8*)qp, qf1 = *(const bf16x8*)(qp + 32);
  u32x4 vfr[LDSRC ? 1 : 5][4];
  if constexpr (!LDSRC) {
#pragma unroll
    for (int pp = 0; pp < 5; ++pp) {
      int TA = kt0 + 2 * pp, TB = kt0 + ((2 * pp + 1 < 9) ? 2 * pp + 1 : 2 * pp);
      if (!has_prev) { if (TA < 8) TA = 8; if (TB < 8) TB = 8; }
#pragma unroll
      for (int dt = 0; dt < 4; ++dt) {
        const char* vp = vptr + (dt * 16 + pl) * vstride + q4 * 8;
        const u32x2 va = *(const u32x2*)(vp + TA * 32), vb = *(const u32x2*)(vp + TB * 32);
        vfr[pp][dt] = u32x4{va.x, va.y, vb.x, vb.y};
      }
    }
  }
  f32x4 sa[9];
#pragma unroll
  for (int kt = 0; kt < 9; ++kt) {
    int T = kt0 + kt; if (!has_prev && T < 8) T = 8;
    const char* kp = kptr + (T * 16 + pl) * kstride + q4 * 16;
    bf16x8 k0, k1;
    if constexpr (LDSRC) { k0 = *(const LAS bf16x8*)(const LAS char*)kp; k1 = *(const LAS bf16x8*)(const LAS char*)(kp + 64); }
    else { k0 = *(const bf16x8*)kp; k1 = *(const bf16x8*)(kp + 64); }
    f32x4 a = f32x4{0.f, 0.f, 0.f, 0.f};
    a = __builtin_amdgcn_mfma_f32_16x16x32_bf16(k0, qf0, a, 0, 0, 0);
    a = __builtin_amdgcn_mfma_f32_16x16x32_bf16(k1, qf1, a, 0, 0, 0);
    sa[kt] = a;
  }
  float mx = -INFINITY;
#pragma unroll
  for (int kt = 0; kt < 9; ++kt) {
#pragma unroll
    for (int r = 0; r < 4; ++r) {
      const int sj = (kt0 + kt) * 16 + q4 * 4 + r;
      const bool valid = (sj > i_q) && (sj <= i_q + 128) && (has_prev || sj >= 128);
      const float v = valid ? sa[kt][r] * 0.125f : -INFINITY;
      sa[kt][r] = v; mx = fmaxf(mx, v);
    }
  }
  mx = fmaxf(mx, __shfl_xor(mx, 16)); mx = fmaxf(mx, __shfl_xor(mx, 32));
  mx = fmaxf(mx, sink);
  float sum = 0.f;
#pragma unroll
  for (int kt = 0; kt < 9; ++kt) {
#pragma unroll
    for (int r = 0; r < 4; ++r) { const float e = __expf(sa[kt][r] - mx); sa[kt][r] = e; sum += e; }
  }
  sum += __shfl_xor(sum, 16); sum += __shfl_xor(sum, 32);
  const float inv = 1.f / (sum + __expf(sink - mx));
  f32x4 oa[4];
#pragma unroll
  for (int dt = 0; dt < 4; ++dt) oa[dt] = f32x4{0.f, 0.f, 0.f, 0.f};
#pragma unroll
  for (int pp = 0; pp < 5; ++pp) {
    const int kA = 2 * pp, kB = (2 * pp + 1 < 9) ? 2 * pp + 1 : 2 * pp;
    u32x4 pw;
    pw.x = pk2(sa[kA][0] * inv, sa[kA][1] * inv); pw.y = pk2(sa[kA][2] * inv, sa[kA][3] * inv);
    if (2 * pp + 1 < 9) { pw.z = pk2(sa[kB][0] * inv, sa[kB][1] * inv); pw.w = pk2(sa[kB][2] * inv, sa[kB][3] * inv); }
    else { pw.z = 0u; pw.w = 0u; }
    const bf16x8 pf = __builtin_bit_cast(bf16x8, pw);
    if constexpr (LDSRC) {
      int TA = kt0 + 2 * pp, TB = kt0 + ((2 * pp + 1 < 9) ? 2 * pp + 1 : 2 * pp);
      if (!has_prev) { if (TA < 8) TA = 8; if (TB < 8) TB = 8; }
#pragma unroll
      for (int dt = 0; dt < 4; ++dt) {
        const char* vp = vptr + (dt * 16 + pl) * vstride + q4 * 8;
        const u32x2 va = *(const LAS u32x2*)(const LAS char*)(vp + TA * 32), vb = *(const LAS u32x2*)(const LAS char*)(vp + TB * 32);
        oa[dt] = __builtin_amdgcn_mfma_f32_16x16x32_bf16(__builtin_bit_cast(bf16x8, u32x4{va.x, va.y, vb.x, vb.y}), pf, oa[dt], 0, 0, 0);
      }
    } else {
#pragma unroll
      for (int dt = 0; dt < 4; ++dt) oa[dt] = __builtin_amdgcn_mfma_f32_16x16x32_bf16(__builtin_bit_cast(bf16x8, vfr[pp][dt]), pf, oa[dt], 0, 0, 0);
    }
  }
  bf16_t* O = (bf16_t*)(ws + OFF_O);
#pragma unroll
  for (int dt = 0; dt < 4; ++dt) *(u32x2*)(O + (size_t)row_q * 512 + h_q * 64 + dt * 16 + q4 * 4) = pk4(oa[dt]);
}

__device__ __forceinline__ void attn_sample_unit(const Params& p, int us, int lane) {
  const int pl = lane & 15, kv = us & 1, b = us >> 1, tt = pl >> 2, g = pl & 3;
  const bf16_t* Ks = (const bf16_t*)(p.ws + OFF_KS); const bf16_t* Vts = (const bf16_t*)(p.ws + OFF_VTS);
  attn_core<false>(p, lane, (const char*)(Ks + (size_t)b * 144 * 128 + kv * 64), 256, (const char*)(Vts + (size_t)(b * 2 + kv) * 64 * 144), 288,
                   0, 1, MP + b * 4 + tt, kv * 4 + g, tt);
}

constexpr int ATT_KSTR = 144, ATT_VSTR = 528, ATT_VOFF = 256 * ATT_KSTR;
__device__ __forceinline__ void attn_block_unit(const Params& p, int bu, char* lds, int tid) {
  const int b = bu >> 5, kv = (bu >> 4) & 1, blk = bu & 15, lane = tid & 63, wid = tid >> 6;
  const bf16_t* Kp = (const bf16_t*)(p.ws + OFF_KP); const bf16_t* Vtp = (const bf16_t*)(p.ws + OFF_VTP);
  char* K_l = lds; char* Vt_l = lds + ATT_VOFF;
  u32x4 kr[4], vr[4];
#pragma unroll
  for (int i = 0; i < 4; ++i) {
    const int piece = tid + i * NTHR, key = piece >> 3, c = piece & 7;
    if (blk > 0 || key >= 128) kr[i] = *(const u32x4*)(Kp + ((size_t)b * 2048 + (size_t)(blk - 1) * 128 + key) * 128 + kv * 64 + c * 8);
    const int d = piece >> 5, c2 = piece & 31;
    if (blk > 0 || c2 >= 16) vr[i] = *(const u32x4*)(Vtp + ((size_t)(b * 2 + kv) * 64 + d) * 2048 + (size_t)(blk - 1) * 128 + c2 * 8);
  }
#pragma unroll
  for (int i = 0; i < 4; ++i) {
    const int piece = tid + i * NTHR, key = piece >> 3, c = piece & 7;
    if (blk > 0 || key >= 128) *(u32x4*)(K_l + key * ATT_KSTR + c * 16) = kr[i];
    const int d = piece >> 5, c2 = piece & 31;
    if (blk > 0 || c2 >= 16) *(u32x4*)(Vt_l + d * ATT_VSTR + c2 * 16) = vr[i];
  }
  __syncthreads();
  const int pl = lane & 15;
#pragma unroll 1
  for (int g = 0; g < 4; ++g) {
    asm volatile("" ::: "memory");
    attn_core<true>(p, lane, K_l, ATT_KSTR, Vt_l, ATT_VSTR, wid, blk > 0, b * 2048 + blk * 128 + wid * 16 + pl, kv * 4 + g, wid * 16 + pl);
  }
  __syncthreads();
}

template <int WHICH, int NRW>
__device__ __forceinline__ void ln_rows(const Params& p, const int row0, const int lane, const f32x4 (&gv)[4], const f32x4 (&bv)[4]) {
  bf16_t* X1b = (bf16_t*)(p.ws + OFF_X1B);
  f32x4 v[NRW][4];
#pragma unroll
  for (int h = 0; h < NRW; ++h) {
    const int row = row0 + h;
    if (row < MP) {
      const bf16_t* xr = (const bf16_t*)(p.ws + (WHICH == 1 ? OFF_PRE1 : OFF_PRE2)) + (size_t)row * DM;
#pragma unroll
      for (int j = 0; j < 4; ++j) v[h][j] = unpk4(*(const u32x2*)(xr + j * 256 + lane * 4));
    } else {
      const float* SL = (const float*)(p.ws + (WHICH == 1 ? OFF_SLAB_WO : OFF_SLAB_DN)) + (size_t)(row - MP) * DM;
      constexpr int NS = (WHICH == 1) ? 8 : 11;
#pragma unroll
      for (int j = 0; j < 4; ++j) {
        f32x4 a;
        if (WHICH == 1) a = *(const f32x4*)(p.in[1] + (size_t)(row - MP) * DM + j * 256 + lane * 4) * ALPHA_F;
        else a = unpk4(*(const u32x2*)(X1b + (size_t)row * DM + j * 256 + lane * 4)) * ALPHA_F;
#pragma unroll
        for (int q = 0; q < NS; ++q) a += *(const f32x4*)(SL + (size_t)q * MS * DM + j * 256 + lane * 4);
        v[h][j] = a;
      }
    }
  }
  float s[NRW], s2[NRW];
#pragma unroll
  for (int h = 0; h < NRW; ++h) { s[h] = 0.f;
#pragma unroll
    for (int j = 0; j < 4; ++j) s[h] += (v[h][j].x + v[h][j].y) + (v[h][j].z + v[h][j].w); }
#pragma unroll
  for (int o = 1; o < 64; o <<= 1) {
#pragma unroll
    for (int h = 0; h < NRW; ++h) s[h] += __shfl_xor(s[h], o);
  }
#pragma unroll
  for (int h = 0; h < NRW; ++h) { const float mean = s[h] * (1.f / DM); s2[h] = 0.f;
#pragma unroll
    for (int j = 0; j < 4; ++j) { v[h][j] = v[h][j] - mean; s2[h] += (v[h][j].x * v[h][j].x + v[h][j].y * v[h][j].y) + (v[h][j].z * v[h][j].z + v[h][j].w * v[h][j].w); } }
#pragma unroll
  for (int o = 1; o < 64; o <<= 1) {
#pragma unroll
    for (int h = 0; h < NRW; ++h) s2[h] += __shfl_xor(s2[h], o);
  }
#pragma unroll
  for (int h = 0; h < NRW; ++h) {
    const int row = row0 + h;
    const float rstd = rsqrtf(s2[h] * (1.f / DM) + LN_EPS_F);
#pragma unroll
    for (int j = 0; j < 4; ++j) {
      const f32x4 o = v[h][j] * rstd * gv[j] + bv[j];
      if (WHICH == 1) *(u32x2*)(X1b + (size_t)row * DM + j * 256 + lane * 4) = pk4(o);
      else *(f32x4*)(p.out + (size_t)row * DM + j * 256 + lane * 4) = o;
    }
  }
}
template <int WHICH>
__device__ __forceinline__ void ln_phase(const Params& p) {
  const int lane = threadIdx.x & 63, wid = threadIdx.x >> 6;
  const int gw = blockIdx.x * NWAVE + wid, NGW = gridDim.x * NWAVE;
  const float* gam = p.in[WHICH == 1 ? 20 : 26]; const float* bet = p.in[WHICH == 1 ? 21 : 27];
  f32x4 gv[4], bv[4];
#pragma unroll
  for (int j = 0; j < 4; ++j) { gv[j] = *(const f32x4*)(gam + j * 256 + lane * 4); bv[j] = *(const f32x4*)(bet + j * 256 + lane * 4); }
  for (int rp = gw; rp < MP / 2; rp += NGW) ln_rows<WHICH, 2>(p, rp * 2, lane, gv, bv);
  for (int row = MP + gw; row < MT; row += NGW) ln_rows<WHICH, 1>(p, row, lane, gv, bv);
}

__device__ __forceinline__ void fixup_phase(const Params& p) {
  unsigned char* ws = p.ws;
  const int gt = blockIdx.x * NTHR + threadIdx.x, NGT = gridDim.x * NTHR;
  const float* HA0 = (const float*)(ws + OFF_HA0); const float* HG0 = (const float*)(ws + OFF_HG0); const float* HA1 = (const float*)(ws + OFF_HA1);
  bf16_t* H = (bf16_t*)(ws + OFF_H);
  constexpr int NJ4 = DFF / 4;
  for (int i = gt; i < NRB * 2 * NJ4; i += NGT) {
    const int j4 = i % NJ4, rl = (i / NJ4) & 1, rb = i / (2 * NJ4);
    if ((rb & 31) == 0) continue;
    const int j0 = j4 * 4;
    const f32x4 a0 = *(const f32x4*)(HA0 + ((size_t)rb * 2 + rl) * DFF + j0);
    const f32x4 g = *(const f32x4*)(HG0 + ((size_t)rb * 2 + rl) * DFF + j0);
    const f32x4 pm1 = *(const f32x4*)(HA1 + ((size_t)(rb - 1) * 2 + 1) * DFF + j0);
    const f32x4 pm2 = *(const f32x4*)(HA1 + ((size_t)(rb - 1) * 2 + 0) * DFF + j0);
    f32x4 am1, am2;
    if (rl == 0) { am1 = pm1; am2 = pm2; }
    else { am1 = *(const f32x4*)(HA0 + ((size_t)rb * 2 + 0) * DFF + j0); am2 = pm1; }
    const f32x4 w0 = *(const f32x4*)(p.in[23] + j0), w1 = *(const f32x4*)(p.in[23] + DFF + j0), w2 = *(const f32x4*)(p.in[23] + 2 * DFF + j0);
    const f32x4 cb = *(const f32x4*)(p.in[24] + j0);
    f32x4 h;
    h.x = gelu_tanh(cb.x + w0.x * am2.x + w1.x * am1.x + w2.x * a0.x) * g.x;
    h.y = gelu_tanh(cb.y + w0.y * am2.y + w1.y * am1.y + w2.y * a0.y) * g.y;
    h.z = gelu_tanh(cb.z + w0.z * am2.z + w1.z * am1.z + w2.z * a0.z) * g.z;
    h.w = gelu_tanh(cb.w + w0.w * am2.w + w1.w * am1.w + w2.w * a0.w) * g.w;
    *(u32x2*)(H + ((size_t)rb * 64 + rl) * DFF + j0) = pk4(h);
  }
}

#define XB_TMO      128
#define XB_XCNT(j)  (256  + 64 * (j))
#define XB_XSUB(j)  (1280 + 64 * (j))
#define XB_XGEN(j)  (2304 + 64 * (j))
#define XB_TOP      3328
#define XB_TOPGEN   3392
#define XCD_BAR_WORDS 3456
#define XB_SPIN_CAP (1u << 18)
__device__ __forceinline__ unsigned xb_ld(unsigned* p)              { return __hip_atomic_load(p, __ATOMIC_RELAXED, __HIP_MEMORY_SCOPE_AGENT); }
__device__ __forceinline__ unsigned xb_add(unsigned* p, unsigned v) { return __hip_atomic_fetch_add(p, v, __ATOMIC_RELAXED, __HIP_MEMORY_SCOPE_AGENT); }
__device__ __forceinline__ unsigned xb_xcc_id() { return (unsigned)__builtin_amdgcn_s_getreg((3 << 11) | 20) & 0xFu; }
#define XB_SPIN(cond, bar) do { unsigned _sp = 0; while (cond) { __builtin_amdgcn_s_sleep(1); \
    if ((++_sp & 255u) == 0u) { if (xb_ld(&(bar)[XB_TMO])) break; if (_sp > XB_SPIN_CAP) { atomicAdd(&(bar)[XB_TMO], 1u); break; } } } } while (0)
#define XB_EXIT 64
__device__ unsigned g_xbar[XCD_BAR_WORDS + 64];
struct XcdBarrier { unsigned* bar; unsigned x; volatile LAS unsigned* st; };
__device__ __forceinline__ XcdBarrier xcd_barrier_post(unsigned* bar, volatile LAS unsigned* st) {
    XcdBarrier b; b.bar = bar; b.x = xb_xcc_id(); b.st = st;
    if (threadIdx.x == 0) (void)xb_add(&bar[XB_XCNT(b.x)], 1u);
    return b;
}
__device__ __forceinline__ void xcd_barrier_complete(unsigned* bar, unsigned x, unsigned& nloc, unsigned& nx) {
    const unsigned G = gridDim.x * gridDim.y * gridDim.z;
    unsigned sum, cnt, mine, sp = 0u;
    for (;;) {
        sum = 0u; cnt = 0u; mine = 0u;
#pragma unroll
        for (unsigned j = 0; j < 16; ++j) { const unsigned c = xb_ld(&bar[XB_XCNT(j)]); sum += c; cnt += (c > 0u) ? 1u : 0u; mine = (j == x) ? c : mine; }
        if (sum == G) break;
        __builtin_amdgcn_s_sleep(1);
        if ((++sp & 255u) == 0u) { if (xb_ld(&bar[XB_TMO])) break; if (sp > XB_SPIN_CAP) { atomicAdd(&bar[XB_TMO], 1u); break; } }
    }
    nloc = mine > 0u ? mine : 1u; nx = cnt > 0u ? cnt : 1u;
}
__device__ __forceinline__ void xcd_barrier(const XcdBarrier& b) {
    asm volatile("s_waitcnt vmcnt(0)" ::: "memory");
    __syncthreads();
    if (threadIdx.x == 0) {
        unsigned* bar = b.bar;
        __builtin_amdgcn_s_waitcnt(0);
        unsigned nloc = b.st[0], nx = b.st[1];
        if (nloc == 0u) { xcd_barrier_complete(bar, b.x, nloc, nx); b.st[0] = nloc; b.st[1] = nx; }
        const unsigned old = xb_add(&bar[XB_XSUB(b.x)], 1u);
        const unsigned gen = old / nloc;
        if (old + 1u == (gen + 1u) * nloc) {
            __builtin_amdgcn_fence(__ATOMIC_RELEASE, "agent");
            asm volatile("s_waitcnt vmcnt(0)" ::: "memory");
            const unsigned og = xb_add(&bar[XB_TOP], 1u);
            const unsigned tg = og / nx;
            if (og + 1u == (tg + 1u) * nx) xb_add(&bar[XB_TOPGEN], 1u);
            else XB_SPIN(xb_ld(&bar[XB_TOPGEN]) == tg, bar);
            __builtin_amdgcn_fence(__ATOMIC_ACQUIRE, "agent");
            xb_add(&bar[XB_XGEN(b.x)], 1u);
            asm volatile("s_waitcnt vmcnt(0)" ::: "memory");
        } else {
            XB_SPIN(xb_ld(&bar[XB_XGEN(b.x)]) == gen, bar);
            __builtin_amdgcn_fence(__ATOMIC_ACQUIRE, "agent");
            asm volatile("s_waitcnt vmcnt(0)" ::: "memory");
        }
    }
    __syncthreads();
}
#define GSYNC() xcd_barrier(xb)

__device__ __forceinline__ void sample_merge(const Params& p) {
  unsigned char* ws = p.ws;
  const bf16_t* P = (const bf16_t*)(ws + OFF_P); bf16_t* Mg = (bf16_t*)(ws + OFF_MG);
  const float* SLG = (const float*)(ws + OFF_SLAB_GLU); const float* SLA = (const float*)(ws + OFF_SLAB_ATT);
  for (int i = blockIdx.x * NTHR + threadIdx.x; i < MS * (DM / 4); i += gridDim.x * NTHR) {
    const int r = i >> 8, j = (i & 255) * 4;
    const int tj = j >> 7, jl = j & 127, va = tj * 256 + (jl >> 6) * 128 + ((jl >> 4) & 3) * 32 + (jl & 15);
    f32x4 ya = f32x4{0.f, 0.f, 0.f, 0.f}, yb = ya, at = ya;
#pragma unroll
    for (int q = 0; q < 4; ++q) {
      ya += *(const f32x4*)(SLG + ((size_t)q * MS + r) * 2048 + va);
      yb += *(const f32x4*)(SLG + ((size_t)q * MS + r) * 2048 + va + 16);
      at += *(const f32x4*)(SLA + ((size_t)q * MS + r) * DM + j);
    }
    const size_t row = (size_t)MP + r;
    const f32x4 gs = unpk4(*(const u32x2*)(P + row * PW + 1024 + j)), ga = unpk4(*(const u32x2*)(P + row * PW + 2048 + j));
    f32x4 sv;
    sv.x = gs.x * ya.x * sigmoidf_(yb.x); sv.y = gs.y * ya.y * sigmoidf_(yb.y); sv.z = gs.z * ya.z * sigmoidf_(yb.z); sv.w = gs.w * ya.w * sigmoidf_(yb.w);
    sv = unpk4(pk4(sv));
    sv.x += ga.x * at.x; sv.y += ga.y * at.y; sv.z += ga.z * at.z; sv.w += ga.w * at.w;
    *(u32x2*)(Mg + row * DM + j) = pk4(sv);
  }
}

__global__ void __launch_bounds__(512) fwd_megakernel(Params p) {
  extern __shared__ __attribute__((aligned(16))) char lds[];
  cg::grid_group grid = cg::this_grid();
  volatile LAS unsigned* xst = (volatile LAS unsigned*)(lds + GEMM_LDS);
  if (threadIdx.x == 0) { xst[0] = 0u; xst[1] = 0u; }
  __syncthreads();
  XcdBarrier xb = xcd_barrier_post(g_xbar, xst);
  if (p.ws == nullptr) grid.sync();
  unsigned char* ws = p.ws;
  LAS unsigned char* glds = (LAS unsigned char*)lds;
  const int lane = threadIdx.x & 63, wid = threadIdx.x >> 6;
  const int gw = blockIdx.x * NWAVE + wid, NGW = gridDim.x * NWAVE;

  prep_phase(p, lds);
  GSYNC();
  gemm_phase<EPI_IN>(p, (const bf16_t*)(ws + OFF_B), (const bf16_t*)(ws + OFF_WIN), 1024, DIN, glds);
  GSYNC();
  {
    for (int bu = blockIdx.x; bu < 256; bu += gridDim.x) attn_block_unit(p, bu, lds, threadIdx.x);
    bf16_t* Hs = (bf16_t*)(lds + wid * 4352);
    constexpr int N_S1 = 8 * 32 * 16, N_SS = 32 * 32, N_AT = 256;
    for (int u = gw; u < N_S1; u += NGW) { if ((u & 15) != 15) scan_end_unit(p, u, lane); }
    for (int i = gw; i < 2 * N_SS; i += NGW) { if ((i & 1) == 0) scan_unit<2>(p, i >> 1, lane, Hs); }
    for (int i = gw; i < 8 * N_AT; i += NGW) { if ((i & 7) == 1) attn_sample_unit(p, i >> 3, lane); }
  }
  GSYNC();
  {
    bf16_t* Hs = (bf16_t*)(lds + wid * 4352);
    for (int u = gw; u < 8 * 32 * 16; u += NGW) scan_unit<1>(p, u, lane, Hs);
  }
  GSYNC();
  gemm_phase<EPI_GLU>(p, (const bf16_t*)(ws + OFF_GY), (const bf16_t*)(ws + OFF_WGLU), 512, 2048, glds, (const bf16_t*)(ws + OFF_O), (const bf16_t*)(ws + OFF_WATT));
  GSYNC();
  gemm_phase<EPI_ATT>(p, (const bf16_t*)(ws + OFF_O), (const bf16_t*)(ws + OFF_WATT), 512, 1024, glds);
  sample_merge(p);
  GSYNC();
  gemm_phase<EPI_WO>(p, (const bf16_t*)(ws + OFF_MG), (const bf16_t*)(ws + OFF_WO), 1024, 1024, glds);
  GSYNC();
  ln_phase<1>(p);
  GSYNC();
  gemm_phase<EPI_UP>(p, (const bf16_t*)(ws + OFF_X1B), (const bf16_t*)(ws + OFF_WUP), 1024, 5632, glds);
  GSYNC();
  fixup_phase(p);
  GSYNC();
  gemm_phase<EPI_DOWN>(p, (const bf16_t*)(ws + OFF_H), (const bf16_t*)(ws + OFF_WDN), DFF, 1024, glds);
  GSYNC();
  ln_phase<2>(p);
  __syncthreads();
  if (threadIdx.x == 0) {
    unsigned* bar = g_xbar;
    const unsigned old = xb_add(&bar[XB_EXIT], 1u);
    if (old == gridDim.x - 1u) {
#pragma unroll
      for (int j = 0; j < 16; ++j) {
        __hip_atomic_store(&bar[XB_XCNT(j)], 0u, __ATOMIC_RELAXED, __HIP_MEMORY_SCOPE_AGENT);
        __hip_atomic_store(&bar[XB_XSUB(j)], 0u, __ATOMIC_RELAXED, __HIP_MEMORY_SCOPE_AGENT);
        __hip_atomic_store(&bar[XB_XGEN(j)], 0u, __ATOMIC_RELAXED, __HIP_MEMORY_SCOPE_AGENT);
      }
      __hip_atomic_store(&bar[XB_TOP], 0u, __ATOMIC_RELAXED, __HIP_MEMORY_SCOPE_AGENT);
      __hip_atomic_store(&bar[XB_TOPGEN], 0u, __ATOMIC_RELAXED, __HIP_MEMORY_SCOPE_AGENT);
      __hip_atomic_store(&bar[XB_TMO], 0u, __ATOMIC_RELAXED, __HIP_MEMORY_SCOPE_AGENT);
      __hip_atomic_store(&bar[XB_EXIT], 0u, __ATOMIC_RELAXED, __HIP_MEMORY_SCOPE_AGENT);
    }
  }
}

extern "C" void kernel_launch(void* const* d_in, const int* in_sizes, int n_in, void* d_out, int out_size, void* d_ws, size_t ws_size, hipStream_t stream) {
  static int grid_blocks = 0;
  if (grid_blocks == 0) {
    if (n_in != 28 || ws_size < WS_TOTAL) { fprintf(stderr, "kernel_launch: unexpected n_in %d or ws_size %zu (< %zu)\n", n_in, ws_size, (size_t)WS_TOTAL); grid_blocks = -1; return; }
    int dev = 0, cus = 0, per_cu = 0;
    (void)hipGetDevice(&dev);
    (void)hipDeviceGetAttribute(&cus, hipDeviceAttributeMultiprocessorCount, dev);
    (void)hipFuncSetAttribute((const void*)fwd_megakernel, hipFuncAttributeMaxDynamicSharedMemorySize, LDS_BYTES);
    (void)hipOccupancyMaxActiveBlocksPerMultiprocessor(&per_cu, (const void*)fwd_megakernel, NTHR, LDS_BYTES);
    if (per_cu < 1) { fprintf(stderr, "kernel_launch: occupancy query returned %d\n", per_cu); per_cu = 1; }
    if (per_cu > 1) per_cu = 1;
    grid_blocks = cus * per_cu;
    fprintf(stderr, "kernel_launch: cus %d per_cu %d grid %d\n", cus, per_cu, grid_blocks);
  }
  if (grid_blocks < 0) return;
  Params p{};
  for (int i = 0; i < 28; ++i) p.in[i] = (const float*)d_in[i];
  p.out = (float*)d_out; p.ws = (unsigned char*)d_ws;
  void* args[] = {&p};
  hipError_t e = hipLaunchCooperativeKernel((const void*)fwd_megakernel, dim3(grid_blocks), dim3(NTHR), args, LDS_BYTES, stream);
  if (e != hipSuccess) fprintf(stderr, "cooperative launch failed: %s (grid %d)\n", hipGetErrorString(e), grid_blocks);
}
```

```cpp
#include <hip/hip_runtime.h>
#include <hip/hip_cooperative_groups.h>
#include <cstdio>
#include <cstdint>
namespace cg = cooperative_groups;

typedef unsigned short bf16_t;
typedef short bf16x8 __attribute__((ext_vector_type(8)));
typedef short bf16x4 __attribute__((ext_vector_type(4)));
typedef float f32x4 __attribute__((ext_vector_type(4)));
typedef unsigned u32x2 __attribute__((ext_vector_type(2)));
typedef unsigned u32x4 __attribute__((ext_vector_type(4)));

constexpr int MP = 16384, MS = 512, MT = MP + MS;
constexpr int DM = 1024, DIN = 3328, PW = 3072, DFF = 2816;
constexpr int NRB = MP / 64;
constexpr float ALPHA_F = 1.189207115002721f;
constexpr float LN_EPS_F = 1e-5f;

constexpr size_t O_YP = 0, O_YS = 16777216, O_KP = 17301504, O_VP = 17432576, O_KS = 17563648, O_VS = 19660800,
                 O_HRP = 21757952, O_HIP = 21774336, O_HRS = 21790720, O_HIS = 22052864, O_CP = 22315008, O_CS = 22360064;

constexpr size_t OFF_P = 0;
constexpr size_t OFF_H = 0;
constexpr size_t OFF_B = (size_t)MT * PW * 2;
constexpr size_t OFF_GY = OFF_B, OFF_O = OFF_B + (size_t)MT * 512 * 2;
constexpr size_t OFF_C = OFF_B + (size_t)MT * DM * 2;
constexpr size_t OFF_MG = OFF_C;
constexpr size_t OFF_X1B = OFF_C + (size_t)MT * DM * 2;
constexpr size_t OFF_KP = OFF_C + (size_t)MT * DM * 2;
constexpr size_t OFF_VTP = OFF_KP + (size_t)8 * 2048 * 128 * 2;
constexpr size_t OFF_KS = OFF_VTP + (size_t)8 * 2048 * 128 * 2;
constexpr size_t OFF_VTS = OFF_KS + (size_t)128 * 144 * 128 * 2;
constexpr size_t OFF_W = OFF_C + (size_t)MT * DM * 4;
constexpr size_t OFF_WIN = OFF_W;
constexpr size_t OFF_WGLU = OFF_WIN + (size_t)DIN * 1024 * 2;
constexpr size_t OFF_WATT = OFF_WGLU + (size_t)2048 * 512 * 2;
constexpr size_t OFF_WO = OFF_WATT + (size_t)1024 * 512 * 2;
constexpr size_t OFF_WUP = OFF_WO + (size_t)1024 * 1024 * 2;
constexpr size_t OFF_WDN = OFF_WUP + (size_t)5632 * 1024 * 2;
constexpr size_t OFF_SSM = OFF_WDN + (size_t)1024 * DFF * 2;
constexpr size_t OFF_AR = OFF_SSM, OFF_AI = OFF_SSM + 8192, OFF_BB = OFF_SSM + 16384;
constexpr size_t OFF_E = OFF_BB + 131072;
constexpr size_t OFF_HA0 = OFF_E + (size_t)8 * 32 * 16 * 128 * 4;
constexpr size_t OFF_HG0 = OFF_HA0 + (size_t)NRB * 2 * DFF * 4;
constexpr size_t OFF_HA1 = OFF_HG0 + (size_t)NRB * 2 * DFF * 4;
constexpr size_t WS_END = OFF_HA1 + (size_t)NRB * 2 * DFF * 4;
static_assert(OFF_VTS + (size_t)128 * 144 * 128 * 2 <= OFF_W, "KV overlay overflow");
static_assert(WS_END <= (size_t)256 * 1024 * 1024, "workspace too large");

constexpr size_t OFF_BAR = WS_END;
constexpr size_t WS_TOTAL = OFF_BAR + 16384;
static_assert(WS_TOTAL <= (size_t)256 * 1024 * 1024, "workspace too large");
constexpr size_t OFF_SLAB_WO = OFF_P;
constexpr size_t OFF_SLAB_DN = OFF_B;
static_assert((size_t)11 * MS * DM * 4 <= (size_t)MT * DM * 2, "down slabs must fit the X1b region");
constexpr size_t OFF_SLAB_GLU = OFF_KP;
constexpr size_t OFF_SLAB_ATT = OFF_KP + (size_t)4 * MS * 2048 * 4;
static_assert(OFF_SLAB_ATT + (size_t)4 * MS * DM * 4 <= OFF_W, "GLU/attn slabs must fit the dead K/V + x1 region");
constexpr size_t OFF_PRE1 = OFF_B;
constexpr size_t OFF_PRE2 = OFF_C;
constexpr int GEMM_LDS = 131072;
constexpr int LDS_BYTES = GEMM_LDS + 16;
constexpr int NTHR = 512, NWAVE = 8;

struct Params {
  const float* in[28];
  float* out;
  unsigned char* ws;
};

typedef __bf16 bf16v2_t __attribute__((ext_vector_type(2)));
typedef float f32x2 __attribute__((ext_vector_type(2)));
__device__ __forceinline__ unsigned pk2(float lo, float hi) { f32x2 v = {lo, hi}; bf16v2_t b = __builtin_convertvector(v, bf16v2_t); return __builtin_bit_cast(unsigned, b); }
__device__ __forceinline__ bf16_t f2bf(float x) { return (bf16_t)(pk2(x, 0.f) & 0xffffu); }
__device__ __forceinline__ float bf2f(unsigned v16) { return __uint_as_float(v16 << 16); }
__device__ __forceinline__ float bflo(unsigned w) { return __uint_as_float(w << 16); }
__device__ __forceinline__ float bfhi(unsigned w) { return __uint_as_float(w & 0xffff0000u); }
__device__ __forceinline__ float rcp_nr(float d) { const float r = __builtin_amdgcn_rcpf(d); return fmaf(r, fmaf(-d, r, 1.f), r); }
__device__ __forceinline__ float sigmoidf_(float x) { return rcp_nr(1.f + __expf(fminf(-x, 80.f))); }
__device__ __forceinline__ float gelu_tanh(float x) { float z = 1.5957691216057308f * (x + 0.044715f * x * x * x); return x * rcp_nr(1.f + __expf(fminf(-z, 80.f))); }
__device__ __forceinline__ float wave_sum(float v) {
#pragma unroll
  for (int o = 1; o < 64; o <<= 1) v += __shfl_xor(v, o);
  return v;
}
__device__ __forceinline__ u32x2 pk4(f32x4 v) { u32x2 r; r.x = pk2(v.x, v.y); r.y = pk2(v.z, v.w); return r; }
__device__ __forceinline__ f32x4 unpk4(u32x2 w) { f32x4 r; r.x = bflo(w.x); r.y = bfhi(w.x); r.z = bflo(w.y); r.w = bfhi(w.y); return r; }


#define LAS __attribute__((address_space(3)))
namespace pg8 {
constexpr int BM = 256, BK = 64, HALF = 128, HTB = HALF * BK * 2, NXCD = 8, WGM = 8;
__device__ __forceinline__ int lds_byte(int r, int c) { const int st = (r >> 4) * 2 + (c >> 5), rr = r & 15, cc = c & 31, ob = rr * 64 + cc * 2; return st * 1024 + (ob ^ (((ob >> 9) & 1) << 5)); }
__device__ __forceinline__ void stage_rc(int b, int& R, int& C) { const int st = b / 1024, sb = b % 1024, swz = sb ^ (((sb >> 9) & 1) << 5); R = (st >> 1) * 16 + swz / 64; C = (st & 1) * 32 + (swz % 64) / 2; }
struct Unit { int pm, pn, k0, nk, slice; };
struct StaticOrder {
    int nM, nN, nwg, G, c;
    __device__ __forceinline__ void init(int M, int N, int G_, int c_) { nM = M / BM; nN = N / BM; nwg = nM * nN; G = G_; c = c_; }
    int nsplit, nslice_items, nt, glu;
    __device__ __forceinline__ bool next(int i, int& pm, int& pn, int& k0, int& nk, int& slice, int& src) const {
        const long L = (long)i * G + c;
        pm = 0; pn = 0; k0 = 0; nk = nt; slice = -1; src = 0;
        if (L < nwg) {
            int wgid = (int)L; { const int q = nwg / NXCD, r = nwg % NXCD, xcd = wgid % NXCD, off = wgid / NXCD; wgid = (xcd < r ? xcd * (q + 1) : r * (q + 1) + (xcd - r) * q) + off; }
            const int nig = WGM * nN, gid = wgid / nig, fm = gid * WGM, gsz = (nM - fm) < WGM ? (nM - fm) : WGM;
            pm = fm + ((wgid % nig) % gsz); pn = (wgid % nig) / gsz; return true;
        }
        if (nsplit == 0) return false;
        int sidx = (int)(L - nwg);
        if (sidx >= nslice_items) return false;
        int ncol = nN;
        if (glu && sidx >= 64) { sidx -= 64; src = 1; ncol = 4; }
        const int tl = sidx / nsplit; slice = sidx - tl * nsplit; pm = 64 + tl / ncol; pn = tl % ncol; nk = nt / nsplit; k0 = slice * nk; return true;
    }
};
}

enum { EPI_IN = 0, EPI_GLU = 1, EPI_ATT = 2, EPI_WO = 3, EPI_UP = 4, EPI_DOWN = 5 };

__device__ __forceinline__ float dpp_ror1(float v) { return __int_as_float(__builtin_amdgcn_update_dpp(0, __float_as_int(v), 0x121, 0xf, 0xf, false)); }
__device__ __forceinline__ float dpp_ror2(float v) { return __int_as_float(__builtin_amdgcn_update_dpp(0, __float_as_int(v), 0x122, 0xf, 0xf, false)); }
__device__ __forceinline__ float dpp_shr1_old(float old, float v) { return __int_as_float(__builtin_amdgcn_update_dpp(__float_as_int(old), __float_as_int(v), 0x111, 0xf, 0xf, false)); }
__device__ __forceinline__ float dpp_shr2_old(float old, float v) { return __int_as_float(__builtin_amdgcn_update_dpp(__float_as_int(old), __float_as_int(v), 0x112, 0xf, 0xf, false)); }
__device__ __forceinline__ f32x4 shr1v(f32x4 o, f32x4 v) { return f32x4{dpp_shr1_old(o.x, v.x), dpp_shr1_old(o.y, v.y), dpp_shr1_old(o.z, v.z), dpp_shr1_old(o.w, v.w)}; }
__device__ __forceinline__ f32x4 shr2v(f32x4 o, f32x4 v) { return f32x4{dpp_shr2_old(o.x, v.x), dpp_shr2_old(o.y, v.y), dpp_shr2_old(o.z, v.z), dpp_shr2_old(o.w, v.w)}; }
__device__ __forceinline__ f32x4 ror1v(f32x4 v) { return f32x4{dpp_ror1(v.x), dpp_ror1(v.y), dpp_ror1(v.z), dpp_ror1(v.w)}; }
__device__ __forceinline__ f32x4 ror2v(f32x4 v) { return f32x4{dpp_ror2(v.x), dpp_ror2(v.y), dpp_ror2(v.z), dpp_ror2(v.w)}; }

template <int EPI>
__device__ __forceinline__ void epilogue(const Params& p, f32x4 (&acc)[2][2][4][2], const int pm, const int pn, const int wr, const int wc, const int fr, const int fq) {
  unsigned char* ws = p.ws;
  bf16_t* P = (bf16_t*)(ws + OFF_P);
  if constexpr (EPI == EPI_IN) {
    bf16_t* Kp = (bf16_t*)(ws + OFF_KP); bf16_t* Ks = (bf16_t*)(ws + OFF_KS);
    bf16_t* Vtp = (bf16_t*)(ws + OFF_VTP); bf16_t* Vts = (bf16_t*)(ws + OFF_VTS);
#pragma unroll
    for (int bj = 0; bj < 2; ++bj) {
      const int col0 = pn * 256 + bj * 128;
#pragma unroll
      for (int ai = 0; ai < 2; ++ai)
#pragma unroll
        for (int m = 0; m < 4; ++m) {
          const int row = pm * 256 + ai * 128 + wr * 64 + m * 16 + fr;
#pragma unroll
          for (int n = 0; n < 2; ++n) {
            const int col = col0 + wc * 32 + n * 16 + fq * 4;
            f32x4 v = acc[ai][bj][m][n];
            if (col0 < 1024) {
              *(u32x2*)(P + (size_t)row * PW + col) = pk4(v);
            } else if (col0 >= 1280) {
              v.x = sigmoidf_(v.x); v.y = sigmoidf_(v.y); v.z = sigmoidf_(v.z); v.w = sigmoidf_(v.w);
              *(u32x2*)(P + (size_t)row * PW + col - 256) = pk4(v);
            } else if (col0 == 1024) {
              const int cc = col - 1024;
              if (row < MP) {
                *(u32x2*)(Kp + (size_t)row * 128 + cc) = pk4(v);
                const int pos = row & 2047;
                if (pos >= 1920) *(f32x4*)(p.out + O_KP + ((size_t)(row >> 11) * 128 + (pos - 1920)) * 128 + cc) = v;
              } else {
                const int s = row - MP, b = s >> 2, tt = s & 3;
                *(u32x2*)(Ks + ((size_t)b * 144 + 128 + tt) * 128 + cc) = pk4(v);
                *(f32x4*)(p.out + O_KS + ((size_t)b * 128 + 124 + tt) * 128 + cc) = v;
              }
            } else {
              const int cc = col - 1152, kv = cc >> 6, d = cc & 63;
              if (row < MP) {
                const int b = row >> 11, pos = row & 2047;
                bf16_t* dst = Vtp + ((size_t)(b * 2 + kv) * 64 + d) * 2048 + pos;
                dst[0] = f2bf(v.x); dst[2048] = f2bf(v.y); dst[4096] = f2bf(v.z); dst[6144] = f2bf(v.w);
                if (pos >= 1920) *(f32x4*)(p.out + O_VP + ((size_t)b * 128 + (pos - 1920)) * 128 + cc) = v;
              } else {
                const int s = row - MP, b = s >> 2, tt = s & 3;
                bf16_t* dst = Vts + ((size_t)(b * 2 + kv) * 64 + d) * 144 + 128 + tt;
                dst[0] = f2bf(v.x); dst[144] = f2bf(v.y); dst[288] = f2bf(v.z); dst[432] = f2bf(v.w);
                *(f32x4*)(p.out + O_VS + ((size_t)b * 128 + 124 + tt) * 128 + cc) = v;
              }
            }
          }
        }
    }
  } else if constexpr (EPI == EPI_GLU) {
    bf16_t* Mg = (bf16_t*)(ws + OFF_MG);
#pragma unroll
    for (int ai = 0; ai < 2; ++ai)
#pragma unroll
      for (int m = 0; m < 4; ++m) {
        const int row = pm * 256 + ai * 128 + wr * 64 + m * 16 + fr;
#pragma unroll
        for (int bj = 0; bj < 2; ++bj) {
          const int j0 = pn * 128 + bj * 64 + wc * 16 + fq * 4;
          const f32x4 ya = acc[ai][bj][m][0], yb = acc[ai][bj][m][1];
          const f32x4 gs = unpk4(*(const u32x2*)(P + (size_t)row * PW + 1024 + j0));
          f32x4 sv;
          sv.x = gs.x * ya.x * sigmoidf_(yb.x); sv.y = gs.y * ya.y * sigmoidf_(yb.y);
          sv.z = gs.z * ya.z * sigmoidf_(yb.z); sv.w = gs.w * ya.w * sigmoidf_(yb.w);
          *(u32x2*)(Mg + (size_t)row * DM + j0) = pk4(sv);
        }
      }
  } else if constexpr (EPI == EPI_ATT) {
    bf16_t* Mg = (bf16_t*)(ws + OFF_MG);
#pragma unroll
    for (int ai = 0; ai < 2; ++ai)
#pragma unroll
      for (int m = 0; m < 4; ++m) {
        const int row = pm * 256 + ai * 128 + wr * 64 + m * 16 + fr;
#pragma unroll
        for (int bj = 0; bj < 2; ++bj)
#pragma unroll
          for (int n = 0; n < 2; ++n) {
            const int col = pn * 256 + bj * 128 + wc * 32 + n * 16 + fq * 4;
            const f32x4 ga = unpk4(*(const u32x2*)(P + (size_t)row * PW + 2048 + col));
            const f32x4 sv = unpk4(*(const u32x2*)(Mg + (size_t)row * DM + col));
            f32x4 v = acc[ai][bj][m][n];
            v.x = sv.x + ga.x * v.x; v.y = sv.y + ga.y * v.y; v.z = sv.z + ga.z * v.z; v.w = sv.w + ga.w * v.w;
            *(u32x2*)(Mg + (size_t)row * DM + col) = pk4(v);
          }
      }
  } else if constexpr (EPI == EPI_WO || EPI == EPI_DOWN) {
    const bf16_t* X1b = (const bf16_t*)(ws + OFF_X1B);
#pragma unroll
    for (int ai = 0; ai < 2; ++ai)
#pragma unroll
      for (int m = 0; m < 4; ++m) {
        const int row = pm * 256 + ai * 128 + wr * 64 + m * 16 + fr;
#pragma unroll
        for (int bj = 0; bj < 2; ++bj)
#pragma unroll
          for (int n = 0; n < 2; ++n) {
            const int col = pn * 256 + bj * 128 + wc * 32 + n * 16 + fq * 4;
            f32x4 x;
            if constexpr (EPI == EPI_WO) x = *(const f32x4*)(p.in[0] + (size_t)row * DM + col);
            else x = unpk4(*(const u32x2*)(X1b + (size_t)row * DM + col));
            f32x4 v = acc[ai][bj][m][n];
            v.x += ALPHA_F * x.x; v.y += ALPHA_F * x.y; v.z += ALPHA_F * x.z; v.w += ALPHA_F * x.w;
            *(u32x2*)((bf16_t*)(ws + (EPI == EPI_WO ? OFF_PRE1 : OFF_PRE2)) + (size_t)row * DM + col) = pk4(v);
          }
      }
  } else {
    bf16_t* H = (bf16_t*)(ws + OFF_H);
    float* HA0 = (float*)(ws + OFF_HA0); float* HG0 = (float*)(ws + OFF_HG0); float* HA1 = (float*)(ws + OFF_HA1);
    const bool prompt = (pm < MP / 256);
#pragma unroll
    for (int bj = 0; bj < 2; ++bj) {
      const int j0 = pn * 128 + bj * 64 + wc * 16 + fq * 4;
      const f32x4 w0 = *(const f32x4*)(p.in[23] + j0), w1 = *(const f32x4*)(p.in[23] + DFF + j0), w2 = *(const f32x4*)(p.in[23] + 2 * DFF + j0);
      const f32x4 cb = *(const f32x4*)(p.in[24] + j0);
#pragma unroll
      for (int ai = 0; ai < 2; ++ai) {
        const int rblk = pm * 256 + ai * 128 + wr * 64;
#pragma unroll
        for (int m = 0; m < 4; ++m) {
          const int row = rblk + m * 16 + fr;
          const f32x4 a0 = acc[ai][bj][m][0], g = acc[ai][bj][m][1];
          f32x4 am1, am2; bool defer = false;
          if (prompt) {
            f32x4 o1 = f32x4{0.f, 0.f, 0.f, 0.f}, o2 = o1;
            if (m > 0) { o1 = ror1v(acc[ai][bj][m > 0 ? m - 1 : 0][0]); o2 = ror2v(acc[ai][bj][m > 0 ? m - 1 : 0][0]); }
            am1 = shr1v(o1, a0); am2 = shr2v(o2, a0);
            if (m == 0 && fr < 2 && (row & 2047) >= 2) defer = true;
            if (m == 3 && fr >= 14) *(f32x4*)(HA1 + ((size_t)(rblk >> 6) * 2 + (fr - 14)) * DFF + j0) = a0;
            const int pos = row & 2047;
            if (pos >= 2046) *(f32x4*)(p.out + O_CP + ((size_t)(row >> 11) * 2 + (pos - 2046)) * DFF + j0) = a0;
          } else {
            const int sidx = row - MP, b = sidx >> 2, tt = sidx & 3;
            const f32x4 st0 = *(const f32x4*)(p.in[6] + ((size_t)b * 2 + 0) * DFF + j0);
            const f32x4 st1 = *(const f32x4*)(p.in[6] + ((size_t)b * 2 + 1) * DFF + j0);
            const f32x4 s1 = ror1v(a0), s2 = ror2v(a0);
            am1 = (tt >= 1) ? s1 : st1;
            am2 = (tt >= 2) ? s2 : ((tt == 1) ? st1 : st0);
            if (tt >= 2) *(f32x4*)(p.out + O_CS + ((size_t)b * 2 + (tt - 2)) * DFF + j0) = a0;
          }
          if (!defer) {
            f32x4 h;
            h.x = gelu_tanh(cb.x + w0.x * am2.x + w1.x * am1.x + w2.x * a0.x) * g.x;
            h.y = gelu_tanh(cb.y + w0.y * am2.y + w1.y * am1.y + w2.y * a0.y) * g.y;
            h.z = gelu_tanh(cb.z + w0.z * am2.z + w1.z * am1.z + w2.z * a0.z) * g.z;
            h.w = gelu_tanh(cb.w + w0.w * am2.w + w1.w * am1.w + w2.w * a0.w) * g.w;
            *(u32x2*)(H + (size_t)row * DFF + j0) = pk4(h);
          } else {
            *(f32x4*)(HA0 + ((size_t)(rblk >> 6) * 2 + fr) * DFF + j0) = a0;
            *(f32x4*)(HG0 + ((size_t)(rblk >> 6) * 2 + fr) * DFF + j0) = g;
          }
        }
      }
    }
  }
}

template <int EPI>
__device__ __forceinline__ void gemm_phase(const Params& p, const bf16_t* __restrict__ gA, const bf16_t* __restrict__ gBt, const int K, const int N, LAS unsigned char* lds,
                                           const bf16_t* __restrict__ gA2 = nullptr, const bf16_t* __restrict__ gBt2 = nullptr) {
    using namespace pg8;
    int tid_ = threadIdx.x; asm volatile("" : "+v"(tid_));
    const int tid = tid_, wid = __builtin_amdgcn_readfirstlane(tid >> 6), lane = tid & 63, wr = wid >> 2, wc = wid & 3, fr = lane & 15, fq = lane >> 4;
    const int nt = K / BK;
    constexpr bool SPLIT = (EPI == EPI_WO || EPI == EPI_DOWN || EPI == EPI_GLU);
    constexpr bool PROMPT_ONLY = SPLIT || (EPI == EPI_ATT);
    constexpr int NSPLIT = (EPI == EPI_WO) ? 8 : (EPI == EPI_DOWN ? 11 : 4);
    StaticOrder S; S.init(PROMPT_ONLY ? MP : MT, N, gridDim.x, blockIdx.x);
    const int nN_ = N / BM;
    S.nt = nt; S.nsplit = SPLIT ? NSPLIT : 0; S.glu = (EPI == EPI_GLU) ? 1 : 0;
    S.nslice_items = (EPI == EPI_GLU) ? 96 : 2 * nN_ * NSPLIT;
    unsigned voff[2];
#pragma unroll
    for (int i = 0; i < 2; ++i) { int R, C; stage_rc(tid * 16 + i * 8192, R, C); voff[i] = (unsigned)(R * K + C) * 2u; }
    const size_t kstep = (size_t)(BK * 2);
    const size_t hstep = (size_t)HALF * K * 2;
    const size_t tstep = 2 * hstep;
    const unsigned ldsw = (unsigned)wid * 1024u;
    const int aoff = lds_byte(wr * 64 + fr, fq * 8), boff = lds_byte(wc * 32 + fr, fq * 8);
#define PG8_SA(b, h) (((b) * 2 + (h)) * HTB)
#define PG8_SB(b, h) ((4 + (b) * 2 + (h)) * HTB)
#define PG8_STAGE(bufoff, gbase) do { _Pragma("unroll") for (int _i = 0; _i < 2; ++_i) \
        __builtin_amdgcn_global_load_lds((const unsigned*)((const char*)(gbase) + voff[_i]), (LAS unsigned*)(lds + (bufoff) + ldsw + _i * 8192), 16, 0, 0); } while (0)
#define PG8_LDA(dst, b, h) do { _Pragma("unroll") for (int m = 0; m < 4; ++m) _Pragma("unroll") for (int k = 0; k < 2; ++k) dst[m][k] = *(const LAS bf16x8*)(lds + PG8_SA(b, h) + aoff + m * 2048 + k * 1024); } while (0)
#define PG8_LDB(dst, b, h) do { _Pragma("unroll") for (int n = 0; n < 2; ++n) _Pragma("unroll") for (int k = 0; k < 2; ++k) dst[n][k] = *(const LAS bf16x8*)(lds + PG8_SB(b, h) + boff + n * 2048 + k * 1024); } while (0)
#define PG8_MMA(ai, bj, At, Bt) do { __builtin_amdgcn_s_setprio(1); _Pragma("unroll") for (int m = 0; m < 4; ++m) _Pragma("unroll") for (int n = 0; n < 2; ++n) _Pragma("unroll") for (int k = 0; k < 2; ++k) \
        acc[ai][bj][m][n] = __builtin_amdgcn_mfma_f32_16x16x32_bf16(Bt[n][k], At[m][k], acc[ai][bj][m][n], 0, 0, 0); __builtin_amdgcn_s_setprio(0); } while (0)
#define PG8_WAIT_V(n) asm volatile("s_waitcnt vmcnt(" #n ")" ::: "memory")
#define PG8_WAIT_L(n) asm volatile("s_waitcnt lgkmcnt(" #n ")" ::: "memory")
#define PG8_BAR __builtin_amdgcn_s_barrier()
#define PG8_SCHED __builtin_amdgcn_sched_barrier(0)
    int ui = 0, cur_pm, cur_pn, cur_k0, cur_nk, cur_slice, cur_src, nxt_pm, nxt_pn, nxt_k0, nxt_nk, nxt_slice, nxt_src;
    if (!S.next(0, cur_pm, cur_pn, cur_k0, cur_nk, cur_slice, cur_src)) return;
    f32x4 acc[2][2][4][2];
#pragma unroll
    for (int a = 0; a < 2; ++a)
#pragma unroll
        for (int b = 0; b < 2; ++b)
#pragma unroll
            for (int m = 0; m < 4; ++m)
#pragma unroll
                for (int n = 0; n < 2; ++n) acc[a][b][m][n] = (f32x4){0.f, 0.f, 0.f, 0.f};
    bf16x8 At[4][2], B0[2][2], B1[2][2];
    const char* cA = (const char*)((EPI == EPI_GLU && cur_src) ? gA2 : gA) + (size_t)cur_pm * tstep + (size_t)cur_k0 * kstep;
    const char* cB = (const char*)((EPI == EPI_GLU && cur_src) ? gBt2 : gBt) + (size_t)cur_pn * tstep + (size_t)cur_k0 * kstep;
    PG8_STAGE(PG8_SB(0, 0), cB); PG8_STAGE(PG8_SB(0, 1), cB + hstep); PG8_STAGE(PG8_SA(0, 0), cA); PG8_STAGE(PG8_SA(0, 1), cA + hstep);
    if (wr == 1) PG8_BAR;
    PG8_WAIT_V(2); PG8_BAR;
    PG8_STAGE(PG8_SB(1, 0), cB + kstep); PG8_STAGE(PG8_SA(1, 0), cA + kstep); PG8_STAGE(PG8_SB(1, 1), cB + hstep + kstep);
    PG8_WAIT_V(6); PG8_BAR;
    for (;;) {
        const bool has_next = S.next(ui + 1, nxt_pm, nxt_pn, nxt_k0, nxt_nk, nxt_slice, nxt_src);
        const char* nA = has_next ? (const char*)((EPI == EPI_GLU && nxt_src) ? gA2 : gA) + (size_t)nxt_pm * tstep + (size_t)nxt_k0 * kstep : cA;
        const char* nB = has_next ? (const char*)((EPI == EPI_GLU && nxt_src) ? gBt2 : gBt) + (size_t)nxt_pn * tstep + (size_t)nxt_k0 * kstep : cB;
        const int cnk = cur_nk;
        for (int t = 0; t < cnk; t += 2) {
            const bool last = (t == cnk - 2);
            const char* a1 = cA + (size_t)(t + 1) * kstep;
            const char* a2 = last ? nA : cA + (size_t)(t + 2) * kstep; const char* b2 = last ? nB : cB + (size_t)(t + 2) * kstep;
            const char* a3 = a2 + kstep; const char* b3 = b2 + kstep;
            PG8_LDB(B0, 0, 0); PG8_LDB(B1, 0, 1); PG8_SCHED; PG8_LDA(At, 0, 0); PG8_STAGE(PG8_SA(1, 1), a1 + hstep);
            PG8_WAIT_V(8); PG8_WAIT_L(0); PG8_BAR; PG8_MMA(0, 0, At, B0); PG8_MMA(0, 1, At, B1); PG8_BAR; PG8_SCHED;
            PG8_LDA(At, 0, 1); PG8_STAGE(PG8_SB(0, 0), b2); PG8_STAGE(PG8_SB(0, 1), b2 + hstep); PG8_STAGE(PG8_SA(0, 0), a2);
            PG8_WAIT_V(8); PG8_WAIT_L(0); PG8_BAR; PG8_MMA(1, 0, At, B0); PG8_MMA(1, 1, At, B1); PG8_BAR; PG8_SCHED;
            PG8_LDB(B0, 1, 0); PG8_LDB(B1, 1, 1); PG8_SCHED; PG8_LDA(At, 1, 0); PG8_STAGE(PG8_SA(0, 1), a2 + hstep);
            PG8_WAIT_V(8); PG8_WAIT_L(0); PG8_BAR; PG8_MMA(0, 0, At, B0); PG8_MMA(0, 1, At, B1); PG8_BAR; PG8_SCHED;
            PG8_LDA(At, 1, 1); PG8_STAGE(PG8_SB(1, 0), b3); PG8_STAGE(PG8_SB(1, 1), b3 + hstep); PG8_STAGE(PG8_SA(1, 0), a3);
            PG8_WAIT_V(8); PG8_WAIT_L(0); PG8_BAR; PG8_MMA(1, 0, At, B0); PG8_MMA(1, 1, At, B1); PG8_BAR; PG8_SCHED;
        }
        if (wr == 0) PG8_BAR;
        if (SPLIT && cur_slice >= 0) {
            const int ldc = (EPI == EPI_GLU && cur_src == 0) ? 2048 : DM;
            float* SL = (float*)(p.ws + (EPI == EPI_WO ? OFF_SLAB_WO : (EPI == EPI_DOWN ? OFF_SLAB_DN : (cur_src ? OFF_SLAB_ATT : OFF_SLAB_GLU)))) + (size_t)cur_slice * MS * ldc;
#pragma unroll
            for (int ai = 0; ai < 2; ++ai)
#pragma unroll
                for (int m = 0; m < 4; ++m) {
                    const int rs = (cur_pm - 64) * 256 + ai * 128 + wr * 64 + m * 16 + fr;
#pragma unroll
                    for (int bj = 0; bj < 2; ++bj)
#pragma unroll
                        for (int n = 0; n < 2; ++n) *(f32x4*)(SL + (size_t)rs * ldc + cur_pn * 256 + bj * 128 + wc * 32 + n * 16 + fq * 4) = acc[ai][bj][m][n];
                }
        } else epilogue<EPI>(p, acc, cur_pm, cur_pn, wr, wc, fr, fq);
        if (!has_next) break;
#pragma unroll
        for (int a = 0; a < 2; ++a)
#pragma unroll
            for (int b = 0; b < 2; ++b)
#pragma unroll
                for (int m = 0; m < 4; ++m)
#pragma unroll
                    for (int n = 0; n < 2; ++n) acc[a][b][m][n] = (f32x4){0.f, 0.f, 0.f, 0.f};
        cur_pm = nxt_pm; cur_pn = nxt_pn; cur_k0 = nxt_k0; cur_nk = nxt_nk; cur_slice = nxt_slice; cur_src = nxt_src; cA = nA; cB = nB; ++ui;
        if (wr == 1) PG8_BAR;
    }
    PG8_WAIT_V(0);
    PG8_BAR;
#undef PG8_SA
#undef PG8_SB
#undef PG8_STAGE
#undef PG8_LDA
#undef PG8_LDB
#undef PG8_MMA
#undef PG8_WAIT_V
#undef PG8_WAIT_L
#undef PG8_BAR
#undef PG8_SCHED
}

template <int MODE>
__device__ __forceinline__ int dest_row(int n, int HH) {
  if (MODE == 0) return n;
  const int part = n >= HH ? 1 : 0, j = n - part * HH;
  const int tj = j >> 7, jl = j & 127, bj = jl >> 6, wcj = (jl >> 4) & 3, w = jl & 15;
  return tj * 256 + bj * 128 + wcj * 32 + part * 16 + w;
}
template <int MODE>
__device__ __forceinline__ void transpose_item(const float* __restrict__ W, int K, int N, bf16_t* __restrict__ WT, int HH, float* scr, int item, int lane) {
  const int nblk = N / 32, kb = item / nblk, nb = item - kb * nblk, k0 = 32 * kb, n0 = 32 * nb;
#pragma unroll 8
  for (int i = 0; i < 16; ++i) { const int kk = 2 * i + (lane >> 5); scr[kk * 33 + (lane & 31)] = W[(size_t)(k0 + kk) * N + n0 + (lane & 31)]; }
  asm volatile("s_waitcnt lgkmcnt(0)" ::: "memory");
  const int c = lane & 3;
#pragma unroll
  for (int j = 0; j < 2; ++j) {
    const int n = (lane >> 2) + 16 * j; const float* sp = scr + (8 * c) * 33 + n;
    u32x4 o; o.x = pk2(sp[0], sp[33]); o.y = pk2(sp[66], sp[99]); o.z = pk2(sp[132], sp[165]); o.w = pk2(sp[198], sp[231]);
    *(u32x4*)(WT + (size_t)dest_row<MODE>(n0 + n, HH) * K + k0 + 8 * c) = o;
  }
  asm volatile("s_waitcnt lgkmcnt(0)" ::: "memory");
}

__device__ __forceinline__ void prep_phase(const Params& p, char* lds) {
  unsigned char* ws = p.ws;
  const int tid = threadIdx.x, lane = tid & 63, wid = tid >> 6;
  const int gt = blockIdx.x * NTHR + tid, NGT = gridDim.x * NTHR;
  const int gw = blockIdx.x * NWAVE + wid, NGW = gridDim.x * NWAVE;
  {
    bf16_t* Xb = (bf16_t*)(ws + OFF_B);
    const int nchunk = MT * DM / 8, npc = MP * DM / 8;
    const int nmain = (nchunk / (4 * NGT)) * (4 * NGT);
    for (int i0 = gt; i0 < nmain / 4; i0 += NGT) {
      f32x4 a[4], b[4];
#pragma unroll
      for (int q = 0; q < 4; ++q) {
        const int i = i0 + q * (nmain / 4);
        const float* sp = (i < npc) ? p.in[0] + (size_t)i * 8 : p.in[1] + (size_t)(i - npc) * 8;
        a[q] = *(const f32x4*)sp; b[q] = *(const f32x4*)(sp + 4);
      }
#pragma unroll
      for (int q = 0; q < 4; ++q) {
        const int i = i0 + q * (nmain / 4);
        u32x4 o; o.x = pk2(a[q].x, a[q].y); o.y = pk2(a[q].z, a[q].w); o.z = pk2(b[q].x, b[q].y); o.w = pk2(b[q].z, b[q].w);
        *(u32x4*)(Xb + (size_t)i * 8) = o;
      }
    }
    for (int i = nmain + gt; i < nchunk; i += NGT) {
      const float* sp = (i < npc) ? p.in[0] + (size_t)i * 8 : p.in[1] + (size_t)(i - npc) * 8;
      const f32x4 a = *(const f32x4*)sp, b = *(const f32x4*)(sp + 4);
      u32x4 o; o.x = pk2(a.x, a.y); o.y = pk2(a.z, a.w); o.z = pk2(b.x, b.y); o.w = pk2(b.z, b.w);
      *(u32x4*)(Xb + (size_t)i * 8) = o;
    }
  }
  {
    float* scr = (float*)(lds + wid * 8704);
    constexpr int I_IN = 32 * 104, I_GLU = 16 * 64, I_ATT = 16 * 32, I_O = 32 * 32, I_UP = 32 * 176, I_DN = 88 * 32;
    constexpr int NIT = I_IN + I_GLU + I_ATT + I_O + I_UP + I_DN;
    for (int it = gw; it < NIT; it += NGW) {
      int r = it;
      if (r < I_IN) { transpose_item<0>(p.in[7], 1024, DIN, (bf16_t*)(ws + OFF_WIN), 0, scr, r, lane); continue; } r -= I_IN;
      if (r < I_GLU) { transpose_item<1>(p.in[16], 512, 2048, (bf16_t*)(ws + OFF_WGLU), 1024, scr, r, lane); continue; } r -= I_GLU;
      if (r < I_ATT) { transpose_item<0>(p.in[18], 512, 1024, (bf16_t*)(ws + OFF_WATT), 0, scr, r, lane); continue; } r -= I_ATT;
      if (r < I_O) { transpose_item<0>(p.in[19], 1024, 1024, (bf16_t*)(ws + OFF_WO), 0, scr, r, lane); continue; } r -= I_O;
      if (r < I_UP) { transpose_item<1>(p.in[22], 1024, 5632, (bf16_t*)(ws + OFF_WUP), DFF, scr, r, lane); continue; } r -= I_UP;
      transpose_item<0>(p.in[25], DFF, 1024, (bf16_t*)(ws + OFF_WDN), 0, scr, r, lane);
    }
  }
  {
    bf16_t* Ks = (bf16_t*)(ws + OFF_KS); bf16_t* Vts = (bf16_t*)(ws + OFF_VTS);
    const float* ck = p.in[2]; const float* cv = p.in[3];
    for (int i = gt; i < 128 * 128 * 16; i += NGT) {
      const int c8 = i & 15, w = (i >> 4) & 127, b = i >> 11;
      const float* s = ck + ((size_t)b * 128 + w) * 128 + c8 * 8;
      const f32x4 a = *(const f32x4*)s, bq = *(const f32x4*)(s + 4);
      u32x4 o; o.x = pk2(a.x, a.y); o.y = pk2(a.z, a.w); o.z = pk2(bq.x, bq.y); o.w = pk2(bq.z, bq.w);
      *(u32x4*)(Ks + ((size_t)b * 144 + w) * 128 + c8 * 8) = o;
    }
    for (int i = gt; i < 128 * 12 * 16; i += NGT) {
      const int c8 = i & 15, r = (i >> 4) % 12, b = i / 192;
      *(u32x4*)(Ks + ((size_t)b * 144 + 132 + r) * 128 + c8 * 8) = u32x4{0u, 0u, 0u, 0u};
    }
    for (int i = gt; i < 128 * 16 * 128; i += NGT) {
      const int kvd = i & 127, w8 = (i >> 7) & 15, b = i >> 11;
      const float* s = cv + ((size_t)b * 128 + w8 * 8) * 128 + kvd;
      u32x4 o; o.x = pk2(s[0], s[128]); o.y = pk2(s[256], s[384]); o.z = pk2(s[512], s[640]); o.w = pk2(s[768], s[896]);
      *(u32x4*)(Vts + ((size_t)b * 128 + kvd) * 144 + w8 * 8) = o;
    }
    for (int i = gt; i < 128 * 128 * 3; i += NGT) {
      const int q = i % 3, r = i / 3;
      *(u32x2*)(Vts + (size_t)r * 144 + 132 + q * 4) = u32x2{0u, 0u};
    }
    for (int i = gt; i < 128 * 124 * 32; i += NGT) {
      const int c4 = i & 31, w = (i >> 5) % 124, b = i / (124 * 32);
      const size_t so = ((size_t)b * 128 + w + 4) * 128 + c4 * 4, dof = ((size_t)b * 128 + w) * 128 + c4 * 4;
      *(f32x4*)(p.out + O_KS + dof) = *(const f32x4*)(ck + so);
      *(f32x4*)(p.out + O_VS + dof) = *(const f32x4*)(cv + so);
    }
  }
  {
    float* AR = (float*)(ws + OFF_AR); float* AI = (float*)(ws + OFF_AI); bf16_t* BB = (bf16_t*)(ws + OFF_BB);
    for (int i = gt; i < 2048; i += NGT) {
      const int g = i >> 6, pp = i & 63;
      const float lr = p.in[8][i], li = p.in[9][i], dt = expf(p.in[10][g]);
      const float mag = expf(lr * dt), ang = li * dt;
      const float abr = mag * cosf(ang), abi = mag * sinf(ang);
      const float den = lr * lr + li * li, nr = abr - 1.f;
      const float cr = (nr * lr + abi * li) / den, ci = (abi * lr - nr * li) / den;
      AR[i] = abr; AI[i] = abi;
      const float* br = p.in[11] + (size_t)i * 16; const float* bi = p.in[12] + (size_t)i * 16;
      bf16_t* dre = BB + ((size_t)g * 128 + pp) * 16; bf16_t* dim_ = BB + ((size_t)g * 128 + 64 + pp) * 16;
#pragma unroll
      for (int c = 0; c < 16; ++c) {
        dre[c] = f2bf(cr * br[c] - ci * bi[c]);
        dim_[c] = f2bf(cr * bi[c] + ci * br[c]);
      }
    }
  }
}

#define CMUL_ACC(dr, di, ar_, ai_, br_, bi_) do { const float t_r = (ar_) * (br_) - (ai_) * (bi_); const float t_i = (ar_) * (bi_) + (ai_) * (br_); dr += t_r; di += t_i; } while (0)

template <int MODE>
__device__ __forceinline__ void scan_unit(const Params& p, int u, int lane, bf16_t* Hs) {
  unsigned char* ws = p.ws;
  const int pl = lane & 15, q4 = lane >> 4;
  const bf16_t* P = (const bf16_t*)(ws + OFF_P);
  const float* AR = (const float*)(ws + OFF_AR); const float* AI = (const float*)(ws + OFF_AI);
  const bf16_t* BB = (const bf16_t*)(ws + OFF_BB);
  float* E = (float*)(ws + OFF_E);
  int g, s = 0, c = 0, R0, ntile;
  if (MODE == 2) { g = u & 31; const int ti = u >> 5; R0 = MP + ti * 16; ntile = 1; s = ti; }
  else { c = u & 15; g = (u >> 4) & 31; s = u >> 9; R0 = s * 2048 + c * 128; ntile = 8; }
  float ar[4], ai[4], a4r[4], a4i[4], a8r[4], a8i[4], a128r[4], a128i[4];
#pragma unroll
  for (int q = 0; q < 4; ++q) {
    const float r1 = AR[g * 64 + q * 16 + pl], i1 = AI[g * 64 + q * 16 + pl];
    ar[q] = r1; ai[q] = i1;
    const float r2 = r1 * r1 - i1 * i1, i2 = 2.f * r1 * i1;
    const float r4 = r2 * r2 - i2 * i2, i4 = 2.f * r2 * i2;
    const float r8 = r4 * r4 - i4 * i4, i8 = 2.f * r4 * i4;
    a4r[q] = r4; a4i[q] = i4; a8r[q] = r8; a8i[q] = i8;
    const float r16 = r8 * r8 - i8 * i8, i16 = 2.f * r8 * i8;
    const float r32 = r16 * r16 - i16 * i16, i32 = 2.f * r16 * i16;
    const float r64 = r32 * r32 - i32 * i32, i64 = 2.f * r32 * i32;
    a128r[q] = r64 * r64 - i64 * i64; a128i[q] = 2.f * r64 * i64;
  }
  bf16x4 bb[8];
#pragma unroll
  for (int pt = 0; pt < 8; ++pt) bb[pt] = *(const bf16x4*)(BB + ((size_t)g * 128 + pt * 16 + pl) * 16 + q4 * 4);
  bf16x8 cm[4]; bf16x4 dmv;
  if (MODE != 0) {
#pragma unroll
    for (int ks = 0; ks < 4; ++ks) {
      const float* src = ((ks < 2) ? p.in[13] : p.in[14]) + ((size_t)g * 16 + pl) * 64 + (ks & 1) * 32 + q4 * 8;
      const float sg = (ks < 2) ? 1.f : -1.f;
      const f32x4 x0 = *(const f32x4*)src, x1 = *(const f32x4*)(src + 4);
      u32x4 o; o.x = pk2(sg * x0.x, sg * x0.y); o.y = pk2(sg * x0.z, sg * x0.w); o.z = pk2(sg * x1.x, sg * x1.y); o.w = pk2(sg * x1.z, sg * x1.w);
      cm[ks] = __builtin_bit_cast(bf16x8, o);
    }
    const float dv = p.in[15][g * 16 + pl];
    u32x2 o;
    o.x = pk2((q4 * 4 + 0 == pl) ? dv : 0.f, (q4 * 4 + 1 == pl) ? dv : 0.f);
    o.y = pk2((q4 * 4 + 2 == pl) ? dv : 0.f, (q4 * 4 + 3 == pl) ? dv : 0.f);
    dmv = __builtin_bit_cast(bf16x4, o);
  }
  float hr[4], hi[4];
#pragma unroll
  for (int q = 0; q < 4; ++q) { hr[q] = 0.f; hi[q] = 0.f; }
  if (MODE == 1) {
    const float* Eb = E + ((size_t)(s * 32 + g) * 16) * 128;
#pragma unroll
    for (int bt = 0; bt < 3; ++bt) {
      if (bt * 5 < c) {
        float er[5][4], ei[5][4];
#pragma unroll
        for (int k = 0; k < 5; ++k)
#pragma unroll
          for (int q = 0; q < 4; ++q) { er[k][q] = Eb[(bt * 5 + k) * 128 + q * 16 + pl]; ei[k][q] = Eb[(bt * 5 + k) * 128 + 64 + q * 16 + pl]; }
#pragma unroll
        for (int k = 0; k < 5; ++k) {
          const bool on = (bt * 5 + k) < c;
#pragma unroll
          for (int q = 0; q < 4; ++q) {
            const float nr_ = a128r[q] * hr[q] - a128i[q] * hi[q] + er[k][q];
            const float ni_ = a128r[q] * hi[q] + a128i[q] * hr[q] + ei[k][q];
            hr[q] = on ? nr_ : hr[q]; hi[q] = on ? ni_ : hi[q];
          }
        }
      }
    }
  }
  if (MODE == 2) {
    const int b = s * 4 + q4;
#pragma unroll
    for (int q = 0; q < 4; ++q) {
      hr[q] = p.in[4][((size_t)b * 32 + g) * 64 + q * 16 + pl];
      hi[q] = p.in[5][((size_t)b * 32 + g) * 64 + q * 16 + pl];
    }
  }
  const bf16_t* up = P + (size_t)(R0 + pl) * PW + g * 16 + q4 * 4;
  bf16x4 uf_next = *(const bf16x4*)up;
#pragma unroll 2
  for (int tile = 0; tile < ntile; ++tile) {
    const int Rt = R0 + tile * 16;
    const bf16x4 uf = uf_next;
    if (tile + 1 < ntile) uf_next = *(const bf16x4*)(up + (size_t)(tile + 1) * 16 * PW);
    f32x4 xr[4], xi[4];
    const f32x4 z4 = f32x4{0.f, 0.f, 0.f, 0.f};
#pragma unroll
    for (int q = 0; q < 4; ++q) {
      xr[q] = __builtin_amdgcn_mfma_f32_16x16x16bf16_1k(uf, bb[q], z4, 0, 0, 0);
      xi[q] = __builtin_amdgcn_mfma_f32_16x16x16bf16_1k(uf, bb[q + 4], z4, 0, 0, 0);
    }
#pragma unroll
    for (int q = 0; q < 4; ++q) {
      float s0r = xr[q].x, s0i = xi[q].x, s1r = xr[q].y, s1i = xi[q].y, s2r = xr[q].z, s2i = xi[q].z, s3r = xr[q].w, s3i = xi[q].w;
      if (MODE == 2 || q4 == 0) CMUL_ACC(s0r, s0i, ar[q], ai[q], hr[q], hi[q]);
      CMUL_ACC(s1r, s1i, ar[q], ai[q], s0r, s0i);
      CMUL_ACC(s2r, s2i, ar[q], ai[q], s1r, s1i);
      CMUL_ACC(s3r, s3i, ar[q], ai[q], s2r, s2i);
      if (MODE != 2) {
        float Ir = s3r, Ii = s3i;
        float tr = __shfl_up(Ir, 16), ti = __shfl_up(Ii, 16);
        if (q4 >= 1) CMUL_ACC(Ir, Ii, a4r[q], a4i[q], tr, ti);
        tr = __shfl_up(Ir, 32); ti = __shfl_up(Ii, 32);
        if (q4 >= 2) CMUL_ACC(Ir, Ii, a8r[q], a8i[q], tr, ti);
        float cr = __shfl_up(Ir, 16), ci = __shfl_up(Ii, 16);
        if (q4 == 0) { cr = 0.f; ci = 0.f; }
        float t1r = ar[q] * cr - ai[q] * ci, t1i = ar[q] * ci + ai[q] * cr; s0r += t1r; s0i += t1i;
        float t2r = ar[q] * t1r - ai[q] * t1i, t2i = ar[q] * t1i + ai[q] * t1r; s1r += t2r; s1i += t2i;
        float t3r = ar[q] * t2r - ai[q] * t2i, t3i = ar[q] * t2i + ai[q] * t2r; s2r += t3r; s2i += t3i;
        float t4r = ar[q] * t3r - ai[q] * t3i, t4i = ar[q] * t3i + ai[q] * t3r; s3r += t4r; s3i += t4i;
        hr[q] = __shfl(s3r, 48 + pl); hi[q] = __shfl(s3i, 48 + pl);
      } else {
        hr[q] = s3r; hi[q] = s3i;
      }
      xr[q] = f32x4{s0r, s1r, s2r, s3r}; xi[q] = f32x4{s0i, s1i, s2i, s3i};
    }
    if (MODE != 0) {
#pragma unroll
      for (int q = 0; q < 4; ++q) {
        Hs[(q4 * 4 + 0) * 136 + q * 16 + pl] = f2bf(xr[q].x); Hs[(q4 * 4 + 1) * 136 + q * 16 + pl] = f2bf(xr[q].y);
        Hs[(q4 * 4 + 2) * 136 + q * 16 + pl] = f2bf(xr[q].z); Hs[(q4 * 4 + 3) * 136 + q * 16 + pl] = f2bf(xr[q].w);
        Hs[(q4 * 4 + 0) * 136 + 64 + q * 16 + pl] = f2bf(xi[q].x); Hs[(q4 * 4 + 1) * 136 + 64 + q * 16 + pl] = f2bf(xi[q].y);
        Hs[(q4 * 4 + 2) * 136 + 64 + q * 16 + pl] = f2bf(xi[q].z); Hs[(q4 * 4 + 3) * 136 + 64 + q * 16 + pl] = f2bf(xi[q].w);
      }
      asm volatile("s_waitcnt lgkmcnt(0)" ::: "memory");
      f32x4 y = z4;
#pragma unroll
      for (int ks = 0; ks < 4; ++ks) {
        const bf16x8 hf = *(const bf16x8*)(Hs + pl * 136 + ks * 32 + q4 * 8);
        y = __builtin_amdgcn_mfma_f32_16x16x32_bf16(hf, cm[ks], y, 0, 0, 0);
      }
      y = __builtin_amdgcn_mfma_f32_16x16x16bf16_1k(uf, dmv, y, 0, 0, 0);
      asm volatile("s_waitcnt lgkmcnt(0)" ::: "memory");
      bf16_t* GY = (bf16_t*)(ws + OFF_GY);
      bf16_t* dst = GY + (size_t)(Rt + q4 * 4) * 512 + g * 16 + pl;
      dst[0] = f2bf(gelu_tanh(y.x)); dst[512] = f2bf(gelu_tanh(y.y)); dst[1024] = f2bf(gelu_tanh(y.z)); dst[1536] = f2bf(gelu_tanh(y.w));
    }
  }
  if (MODE == 0) {
    if (q4 == 0) {
      float* Eb = E + ((size_t)(s * 32 + g) * 16 + c) * 128;
#pragma unroll
      for (int q = 0; q < 4; ++q) { Eb[q * 16 + pl] = hr[q]; Eb[64 + q * 16 + pl] = hi[q]; }
    }
  } else if (MODE == 1) {
    if (c == 15 && q4 == 0) {
#pragma unroll
      for (int q = 0; q < 4; ++q) {
        p.out[O_HRP + ((size_t)s * 32 + g) * 64 + q * 16 + pl] = hr[q];
        p.out[O_HIP + ((size_t)s * 32 + g) * 64 + q * 16 + pl] = hi[q];
      }
    }
  } else {
    const int b = s * 4 + q4;
#pragma unroll
    for (int q = 0; q < 4; ++q) {
      p.out[O_HRS + ((size_t)b * 32 + g) * 64 + q * 16 + pl] = hr[q];
      p.out[O_HIS + ((size_t)b * 32 + g) * 64 + q * 16 + pl] = hi[q];
    }
  }
}

__device__ __forceinline__ void scan_end_unit(const Params& p, int u, int lane) {
  unsigned char* ws = p.ws;
  const int pl = lane & 15, q4 = lane >> 4;
  const bf16_t* P = (const bf16_t*)(ws + OFF_P);
  const float* AR = (const float*)(ws + OFF_AR); const float* AI = (const float*)(ws + OFF_AI);
  const bf16_t* BB = (const bf16_t*)(ws + OFF_BB);
  float* E = (float*)(ws + OFF_E);
  const int c = u & 15, g = (u >> 4) & 31, s = u >> 9, R0 = s * 2048 + c * 128;
  float ar[4], ai[4], wr_[4], wi_[4], a16r[4], a16i[4];
#pragma unroll
  for (int q = 0; q < 4; ++q) {
    const float r1 = AR[g * 64 + q * 16 + pl], i1 = AI[g * 64 + q * 16 + pl];
    ar[q] = r1; ai[q] = i1;
    const float r2 = r1 * r1 - i1 * i1, i2 = 2.f * r1 * i1;
    const float r4 = r2 * r2 - i2 * i2, i4 = 2.f * r2 * i2;
    const float r8 = r4 * r4 - i4 * i4, i8 = 2.f * r4 * i4;
    const float r12 = r8 * r4 - i8 * i4, i12 = r8 * i4 + i8 * r4;
    a16r[q] = r8 * r8 - i8 * i8; a16i[q] = 2.f * r8 * i8;
    wr_[q] = (q4 == 0) ? r12 : (q4 == 1) ? r8 : (q4 == 2) ? r4 : 1.f;
    wi_[q] = (q4 == 0) ? i12 : (q4 == 1) ? i8 : (q4 == 2) ? i4 : 0.f;
  }
  bf16x4 bb[8];
#pragma unroll
  for (int pt = 0; pt < 8; ++pt) bb[pt] = *(const bf16x4*)(BB + ((size_t)g * 128 + pt * 16 + pl) * 16 + q4 * 4);
  float er[4], ei[4];
#pragma unroll
  for (int q = 0; q < 4; ++q) { er[q] = 0.f; ei[q] = 0.f; }
  const bf16_t* up = P + (size_t)(R0 + pl) * PW + g * 16 + q4 * 4;
  bf16x4 uf_next = *(const bf16x4*)up;
  const f32x4 z4 = f32x4{0.f, 0.f, 0.f, 0.f};
#pragma unroll 2
  for (int tile = 0; tile < 8; ++tile) {
    const bf16x4 uf = uf_next;
    if (tile + 1 < 8) uf_next = *(const bf16x4*)(up + (size_t)(tile + 1) * 16 * PW);
#pragma unroll
    for (int q = 0; q < 4; ++q) {
      const f32x4 xr = __builtin_amdgcn_mfma_f32_16x16x16bf16_1k(uf, bb[q], z4, 0, 0, 0);
      const f32x4 xi = __builtin_amdgcn_mfma_f32_16x16x16bf16_1k(uf, bb[q + 4], z4, 0, 0, 0);
      float tr = xr.x, ti = xi.x, nr_, ni_;
      nr_ = ar[q] * tr - ai[q] * ti + xr.y; ni_ = ar[q] * ti + ai[q] * tr + xi.y; tr = nr_; ti = ni_;
      nr_ = ar[q] * tr - ai[q] * ti + xr.z; ni_ = ar[q] * ti + ai[q] * tr + xi.z; tr = nr_; ti = ni_;
      nr_ = ar[q] * tr - ai[q] * ti + xr.w; ni_ = ar[q] * ti + ai[q] * tr + xi.w; tr = nr_; ti = ni_;
      float sr = wr_[q] * tr - wi_[q] * ti, si = wr_[q] * ti + wi_[q] * tr;
      sr += __shfl_xor(sr, 16); si += __shfl_xor(si, 16);
      sr += __shfl_xor(sr, 32); si += __shfl_xor(si, 32);
      nr_ = a16r[q] * er[q] - a16i[q] * ei[q] + sr; ni_ = a16r[q] * ei[q] + a16i[q] * er[q] + si;
      er[q] = nr_; ei[q] = ni_;
    }
  }
  if (q4 == 0) {
    float* Eb = E + ((size_t)(s * 32 + g) * 16 + c) * 128;
#pragma unroll
    for (int q = 0; q < 4; ++q) { Eb[q * 16 + pl] = er[q]; Eb[64 + q * 16 + pl] = ei[q]; }
  }
}

template <bool LDSRC>
__device__ __forceinline__ void attn_core(const Params& p, const int lane, const char* kptr, const int kstride, const char* vptr, const int vstride,
                                          const int kt0, const int has_prev, const int row_q, const int h_q, const int i_q) {
  unsigned char* ws = p.ws;
  const int pl = lane & 15, q4 = lane >> 4;
  const bf16_t* P = (const bf16_t*)(ws + OFF_P);
  const float sink = p.in[17][h_q];
  const bf16_t* qp = P + (size_t)row_q * PW + 512 + h_q * 64 + q4 * 8;
  const bf16x8 qf0 = *(const bf16x8*)qp, qf1 = *(const bf16x8*)(qp + 32);
  u32x4 vfr[LDSRC ? 1 : 5][4];
  if constexpr (!LDSRC) {
#pragma unroll
    for (int pp = 0; pp < 5; ++pp) {
      int TA = kt0 + 2 * pp, TB = kt0 + ((2 * pp + 1 < 9) ? 2 * pp + 1 : 2 * pp);
      if (!has_prev) { if (TA < 8) TA = 8; if (TB < 8) TB = 8; }
#pragma unroll
      for (int dt = 0; dt < 4; ++dt) {
        const char* vp = vptr + (dt * 16 + pl) * vstride + q4 * 8;
        const u32x2 va = *(const u32x2*)(vp + TA * 32), vb = *(const u32x2*)(vp + TB * 32);
        vfr[pp][dt] = u32x4{va.x, va.y, vb.x, vb.y};
      }
    }
  }
  f32x4 sa[9];
#pragma unroll
  for (int kt = 0; kt < 9; ++kt) {
    int T = kt0 + kt; if (!has_prev && T < 8) T = 8;
    const char* kp = kptr + (T * 16 + pl) * kstride + q4 * 16;
    bf16x8 k0, k1;
    if constexpr (LDSRC) { k0 = *(const LAS bf16x8*)(const LAS char*)kp; k1 = *(const LAS bf16x8*)(const LAS char*)(kp + 64); }
    else { k0 = *(const bf16x8*)kp; k1 = *(const bf16x8*)(kp + 64); }
    f32x4 a = f32x4{0.f, 0.f, 0.f, 0.f};
    a = __builtin_amdgcn_mfma_f32_16x16x32_bf16(k0, qf0, a, 0, 0, 0);
    a = __builtin_amdgcn_mfma_f32_16x16x32_bf16(k1, qf1, a, 0, 0, 0);
    sa[kt] = a;
  }
  const int lo = has_prev ? (i_q + 1) : ((i_q + 1) > 128 ? (i_q + 1) : 128);
  const unsigned span = (unsigned)(i_q + 128 - lo);
  const int dbase = q4 * 4 - lo;
  float mx = -INFINITY;
#pragma unroll
  for (int kt = 0; kt < 9; ++kt) {
#pragma unroll
    for (int r = 0; r < 4; ++r) {
      const int d = (kt0 + kt) * 16 + r + dbase;
      const float v = ((unsigned)d <= span) ? sa[kt][r] : -INFINITY;
      sa[kt][r] = v; mx = fmaxf(mx, v);
    }
  }
  mx = fmaxf(mx, __shfl_xor(mx, 16)); mx = fmaxf(mx, __shfl_xor(mx, 32));
  const float mfin = fmaxf(mx * 0.125f, sink);
  const float cl = 0.125f * 1.4426950408889634f, ml = mfin * 1.4426950408889634f;
  float sum = 0.f;
#pragma unroll
  for (int kt = 0; kt < 9; ++kt) {
#pragma unroll
    for (int r = 0; r < 4; ++r) { const float e = __builtin_amdgcn_exp2f(fmaf(sa[kt][r], cl, -ml)); sa[kt][r] = e; sum += e; }
  }
  sum += __shfl_xor(sum, 16); sum += __shfl_xor(sum, 32);
  const float inv = 1.f / (sum + __builtin_amdgcn_exp2f((sink - mfin) * 1.4426950408889634f));
  f32x4 oa[4];
#pragma unroll
  for (int dt = 0; dt < 4; ++dt) oa[dt] = f32x4{0.f, 0.f, 0.f, 0.f};
#pragma unroll
  for (int pp = 0; pp < 5; ++pp) {
    const int kA = 2 * pp, kB = (2 * pp + 1 < 9) ? 2 * pp + 1 : 2 * pp;
    u32x4 pw;
    pw.x = pk2(sa[kA][0] * inv, sa[kA][1] * inv); pw.y = pk2(sa[kA][2] * inv, sa[kA][3] * inv);
    if (2 * pp + 1 < 9) { pw.z = pk2(sa[kB][0] * inv, sa[kB][1] * inv); pw.w = pk2(sa[kB][2] * inv, sa[kB][3] * inv); }
    else { pw.z = 0u; pw.w = 0u; }
    const bf16x8 pf = __builtin_bit_cast(bf16x8, pw);
    if constexpr (LDSRC) {
      int TA = kt0 + 2 * pp, TB = kt0 + ((2 * pp + 1 < 9) ? 2 * pp + 1 : 2 * pp);
      if (!has_prev) { if (TA < 8) TA = 8; if (TB < 8) TB = 8; }
#pragma unroll
      for (int dt = 0; dt < 4; ++dt) {
        const char* vp = vptr + (dt * 16 + pl) * vstride + q4 * 8;
        const u32x2 va = *(const LAS u32x2*)(const LAS char*)(vp + TA * 32), vb = *(const LAS u32x2*)(const LAS char*)(vp + TB * 32);
        oa[dt] = __builtin_amdgcn_mfma_f32_16x16x32_bf16(__builtin_bit_cast(bf16x8, u32x4{va.x, va.y, vb.x, vb.y}), pf, oa[dt], 0, 0, 0);
      }
    } else {
#pragma unroll
      for (int dt = 0; dt < 4; ++dt) oa[dt] = __builtin_amdgcn_mfma_f32_16x16x32_bf16(__builtin_bit_cast(bf16x8, vfr[pp][dt]), pf, oa[dt], 0, 0, 0);
    }
  }
  bf16_t* O = (bf16_t*)(ws + OFF_O);
#pragma unroll
  for (int dt = 0; dt < 4; ++dt) *(u32x2*)(O + (size_t)row_q * 512 + h_q * 64 + dt * 16 + q4 * 4) = pk4(oa[dt]);
}

__device__ __forceinline__ void attn_sample_unit(const Params& p, int us, int lane) {
  const int pl = lane & 15, kv = us & 1, b = us >> 1, tt = pl >> 2, g = pl & 3;
  const bf16_t* Ks = (const bf16_t*)(p.ws + OFF_KS); const bf16_t* Vts = (const bf16_t*)(p.ws + OFF_VTS);
  attn_core<false>(p, lane, (const char*)(Ks + (size_t)b * 144 * 128 + kv * 64), 256, (const char*)(Vts + (size_t)(b * 2 + kv) * 64 * 144), 288,
                   0, 1, MP + b * 4 + tt, kv * 4 + g, tt);
}

constexpr int ATT_KSTR = 144, ATT_VSTR = 528, ATT_VOFF = 256 * ATT_KSTR;
__device__ __forceinline__ void attn_block_unit(const Params& p, int bu, char* lds, int tid) {
  const int b = bu >> 5, kv = (bu >> 4) & 1, blk = bu & 15, lane = tid & 63, wid = tid >> 6;
  const bf16_t* Kp = (const bf16_t*)(p.ws + OFF_KP); const bf16_t* Vtp = (const bf16_t*)(p.ws + OFF_VTP);
  char* K_l = lds; char* Vt_l = lds + ATT_VOFF;
  u32x4 kr[4], vr[4];
#pragma unroll
  for (int i = 0; i < 4; ++i) {
    const int piece = tid + i * NTHR, key = piece >> 3, c = piece & 7;
    if (blk > 0 || key >= 128) kr[i] = *(const u32x4*)(Kp + ((size_t)b * 2048 + (size_t)(blk - 1) * 128 + key) * 128 + kv * 64 + c * 8);
    const int d = piece >> 5, c2 = piece & 31;
    if (blk > 0 || c2 >= 16) vr[i] = *(const u32x4*)(Vtp + ((size_t)(b * 2 + kv) * 64 + d) * 2048 + (size_t)(blk - 1) * 128 + c2 * 8);
  }
#pragma unroll
  for (int i = 0; i < 4; ++i) {
    const int piece = tid + i * NTHR, key = piece >> 3, c = piece & 7;
    if (blk > 0 || key >= 128) *(u32x4*)(K_l + key * ATT_KSTR + c * 16) = kr[i];
    const int d = piece >> 5, c2 = piece & 31;
    if (blk > 0 || c2 >= 16) *(u32x4*)(Vt_l + d * ATT_VSTR + c2 * 16) = vr[i];
  }
  __syncthreads();
  const int pl = lane & 15;
#pragma unroll 1
  for (int g = 0; g < 4; ++g) {
    asm volatile("" ::: "memory");
    attn_core<true>(p, lane, K_l, ATT_KSTR, Vt_l, ATT_VSTR, wid, blk > 0, b * 2048 + blk * 128 + wid * 16 + pl, kv * 4 + g, wid * 16 + pl);
  }
  __syncthreads();
}

template <int WHICH, int NRW>
__device__ __forceinline__ void ln_rows(const Params& p, const int row0, const int lane, const f32x4 (&gv)[4], const f32x4 (&bv)[4]) {
  bf16_t* X1b = (bf16_t*)(p.ws + OFF_X1B);
  f32x4 v[NRW][4];
#pragma unroll
  for (int h = 0; h < NRW; ++h) {
    const int row = row0 + h;
    if (row < MP) {
      const bf16_t* xr = (const bf16_t*)(p.ws + (WHICH == 1 ? OFF_PRE1 : OFF_PRE2)) + (size_t)row * DM;
#pragma unroll
      for (int j = 0; j < 4; ++j) v[h][j] = unpk4(*(const u32x2*)(xr + j * 256 + lane * 4));
    } else {
      const float* SL = (const float*)(p.ws + (WHICH == 1 ? OFF_SLAB_WO : OFF_SLAB_DN)) + (size_t)(row - MP) * DM;
      constexpr int NS = (WHICH == 1) ? 8 : 11;
#pragma unroll
      for (int j = 0; j < 4; ++j) {
        f32x4 a;
        if (WHICH == 1) a = *(const f32x4*)(p.in[1] + (size_t)(row - MP) * DM + j * 256 + lane * 4) * ALPHA_F;
        else a = unpk4(*(const u32x2*)(X1b + (size_t)row * DM + j * 256 + lane * 4)) * ALPHA_F;
#pragma unroll
        for (int q = 0; q < NS; ++q) a += *(const f32x4*)(SL + (size_t)q * MS * DM + j * 256 + lane * 4);
        v[h][j] = a;
      }
    }
  }
  float s[NRW], s2[NRW];
#pragma unroll
  for (int h = 0; h < NRW; ++h) { s[h] = 0.f;
#pragma unroll
    for (int j = 0; j < 4; ++j) s[h] += (v[h][j].x + v[h][j].y) + (v[h][j].z + v[h][j].w); }
#pragma unroll
  for (int o = 1; o < 64; o <<= 1) {
#pragma unroll
    for (int h = 0; h < NRW; ++h) s[h] += __shfl_xor(s[h], o);
  }
#pragma unroll
  for (int h = 0; h < NRW; ++h) { const float mean = s[h] * (1.f / DM); s2[h] = 0.f;
#pragma unroll
    for (int j = 0; j < 4; ++j) { v[h][j] = v[h][j] - mean; s2[h] += (v[h][j].x * v[h][j].x + v[h][j].y * v[h][j].y) + (v[h][j].z * v[h][j].z + v[h][j].w * v[h][j].w); } }
#pragma unroll
  for (int o = 1; o < 64; o <<= 1) {
#pragma unroll
    for (int h = 0; h < NRW; ++h) s2[h] += __shfl_xor(s2[h], o);
  }
#pragma unroll
  for (int h = 0; h < NRW; ++h) {
    const int row = row0 + h;
    const float rstd = rsqrtf(s2[h] * (1.f / DM) + LN_EPS_F);
#pragma unroll
    for (int j = 0; j < 4; ++j) {
      const f32x4 o = v[h][j] * rstd * gv[j] + bv[j];
      if (WHICH == 1) *(u32x2*)(X1b + (size_t)row * DM + j * 256 + lane * 4) = pk4(o);
      else *(f32x4*)(p.out + (size_t)row * DM + j * 256 + lane * 4) = o;
    }
  }
}
template <int WHICH>
__device__ __forceinline__ void ln_phase(const Params& p) {
  const int lane = threadIdx.x & 63, wid = threadIdx.x >> 6;
  const int gw = blockIdx.x * NWAVE + wid, NGW = gridDim.x * NWAVE;
  const float* gam = p.in[WHICH == 1 ? 20 : 26]; const float* bet = p.in[WHICH == 1 ? 21 : 27];
  f32x4 gv[4], bv[4];
#pragma unroll
  for (int j = 0; j < 4; ++j) { gv[j] = *(const f32x4*)(gam + j * 256 + lane * 4); bv[j] = *(const f32x4*)(bet + j * 256 + lane * 4); }
  for (int rp = gw; rp < MP / 2; rp += NGW) ln_rows<WHICH, 2>(p, rp * 2, lane, gv, bv);
  for (int row = MP + gw; row < MT; row += NGW) ln_rows<WHICH, 1>(p, row, lane, gv, bv);
}

__device__ __forceinline__ void fixup_phase(const Params& p) {
  unsigned char* ws = p.ws;
  const int gt = blockIdx.x * NTHR + threadIdx.x, NGT = gridDim.x * NTHR;
  const float* HA0 = (const float*)(ws + OFF_HA0); const float* HG0 = (const float*)(ws + OFF_HG0); const float* HA1 = (const float*)(ws + OFF_HA1);
  bf16_t* H = (bf16_t*)(ws + OFF_H);
  constexpr int NJ4 = DFF / 4;
  for (int i = gt; i < NRB * 2 * NJ4; i += NGT) {
    const int j4 = i % NJ4, rl = (i / NJ4) & 1, rb = i / (2 * NJ4);
    if ((rb & 31) == 0) continue;
    const int j0 = j4 * 4;
    const f32x4 a0 = *(const f32x4*)(HA0 + ((size_t)rb * 2 + rl) * DFF + j0);
    const f32x4 g = *(const f32x4*)(HG0 + ((size_t)rb * 2 + rl) * DFF + j0);
    const f32x4 pm1 = *(const f32x4*)(HA1 + ((size_t)(rb - 1) * 2 + 1) * DFF + j0);
    const f32x4 pm2 = *(const f32x4*)(HA1 + ((size_t)(rb - 1) * 2 + 0) * DFF + j0);
    f32x4 am1, am2;
    if (rl == 0) { am1 = pm1; am2 = pm2; }
    else { am1 = *(const f32x4*)(HA0 + ((size_t)rb * 2 + 0) * DFF + j0); am2 = pm1; }
    const f32x4 w0 = *(const f32x4*)(p.in[23] + j0), w1 = *(const f32x4*)(p.in[23] + DFF + j0), w2 = *(const f32x4*)(p.in[23] + 2 * DFF + j0);
    const f32x4 cb = *(const f32x4*)(p.in[24] + j0);
    f32x4 h;
    h.x = gelu_tanh(cb.x + w0.x * am2.x + w1.x * am1.x + w2.x * a0.x) * g.x;
    h.y = gelu_tanh(cb.y + w0.y * am2.y + w1.y * am1.y + w2.y * a0.y) * g.y;
    h.z = gelu_tanh(cb.z + w0.z * am2.z + w1.z * am1.z + w2.z * a0.z) * g.z;
    h.w = gelu_tanh(cb.w + w0.w * am2.w + w1.w * am1.w + w2.w * a0.w) * g.w;
    *(u32x2*)(H + ((size_t)rb * 64 + rl) * DFF + j0) = pk4(h);
  }
}

#define XB_TMO      128
#define XB_XCNT(j)  (256  + 64 * (j))
#define XB_XSUB(j)  (1280 + 64 * (j))
#define XB_XGEN(j)  (2304 + 64 * (j))
#define XB_TOP      3328
#define XB_TOPGEN   3392
#define XCD_BAR_WORDS 3456
#define XB_SPIN_CAP (1u << 18)
__device__ __forceinline__ unsigned xb_ld(unsigned* p)              { return __hip_atomic_load(p, __ATOMIC_RELAXED, __HIP_MEMORY_SCOPE_AGENT); }
__device__ __forceinline__ unsigned xb_add(unsigned* p, unsigned v) { return __hip_atomic_fetch_add(p, v, __ATOMIC_RELAXED, __HIP_MEMORY_SCOPE_AGENT); }
__device__ __forceinline__ unsigned xb_xcc_id() { return (unsigned)__builtin_amdgcn_s_getreg((3 << 11) | 20) & 0xFu; }
#define XB_SPIN(cond, bar) do { unsigned _sp = 0; while (cond) { __builtin_amdgcn_s_sleep(1); \
    if ((++_sp & 255u) == 0u) { if (xb_ld(&(bar)[XB_TMO])) break; if (_sp > XB_SPIN_CAP) { atomicAdd(&(bar)[XB_TMO], 1u); break; } } } } while (0)
#define XB_EXIT 64
__device__ unsigned g_xbar[XCD_BAR_WORDS + 64];
struct XcdBarrier { unsigned* bar; unsigned x; volatile LAS unsigned* st; };
__device__ __forceinline__ XcdBarrier xcd_barrier_post(unsigned* bar, volatile LAS unsigned* st) {
    XcdBarrier b; b.bar = bar; b.x = xb_xcc_id(); b.st = st;
    if (threadIdx.x == 0) (void)xb_add(&bar[XB_XCNT(b.x)], 1u);
    return b;
}
__device__ __forceinline__ void xcd_barrier_complete(unsigned* bar, unsigned x, unsigned& nloc, unsigned& nx) {
    const unsigned G = gridDim.x * gridDim.y * gridDim.z;
    unsigned sum, cnt, mine, sp = 0u;
    for (;;) {
        sum = 0u; cnt = 0u; mine = 0u;
#pragma unroll
        for (unsigned j = 0; j < 16; ++j) { const unsigned c = xb_ld(&bar[XB_XCNT(j)]); sum += c; cnt += (c > 0u) ? 1u : 0u; mine = (j == x) ? c : mine; }
        if (sum == G) break;
        __builtin_amdgcn_s_sleep(1);
        if ((++sp & 255u) == 0u) { if (xb_ld(&bar[XB_TMO])) break; if (sp > XB_SPIN_CAP) { atomicAdd(&bar[XB_TMO], 1u); break; } }
    }
    nloc = mine > 0u ? mine : 1u; nx = cnt > 0u ? cnt : 1u;
}
__device__ __forceinline__ void xcd_barrier(const XcdBarrier& b) {
    asm volatile("s_waitcnt vmcnt(0)" ::: "memory");
    __syncthreads();
    if (threadIdx.x == 0) {
        unsigned* bar = b.bar;
        __builtin_amdgcn_s_waitcnt(0);
        unsigned nloc = b.st[0], nx = b.st[1];
        if (nloc == 0u) { xcd_barrier_complete(bar, b.x, nloc, nx); b.st[0] = nloc; b.st[1] = nx; }
        const unsigned old = xb_add(&bar[XB_XSUB(b.x)], 1u);
        const unsigned gen = old / nloc;
        if (old + 1u == (gen + 1u) * nloc) {
            __builtin_amdgcn_fence(__ATOMIC_RELEASE, "agent");
            asm volatile("s_waitcnt vmcnt(0)" ::: "memory");
            const unsigned og = xb_add(&bar[XB_TOP], 1u);
            const unsigned tg = og / nx;
            if (og + 1u == (tg + 1u) * nx) xb_add(&bar[XB_TOPGEN], 1u);
            else XB_SPIN(xb_ld(&bar[XB_TOPGEN]) == tg, bar);
            __builtin_amdgcn_fence(__ATOMIC_ACQUIRE, "agent");
            xb_add(&bar[XB_XGEN(b.x)], 1u);
            asm volatile("s_waitcnt vmcnt(0)" ::: "memory");
        } else {
            XB_SPIN(xb_ld(&bar[XB_XGEN(b.x)]) == gen, bar);
            __builtin_amdgcn_fence(__ATOMIC_ACQUIRE, "agent");
            asm volatile("s_waitcnt vmcnt(0)" ::: "memory");
        }
    }
    __syncthreads();
}
#define GSYNC() xcd_barrier(xb)

__device__ __forceinline__ void sample_merge(const Params& p) {
  unsigned char* ws = p.ws;
  const bf16_t* P = (const bf16_t*)(ws + OFF_P); bf16_t* Mg = (bf16_t*)(ws + OFF_MG);
  const float* SLG = (const float*)(ws + OFF_SLAB_GLU); const float* SLA = (const float*)(ws + OFF_SLAB_ATT);
  for (int i = blockIdx.x * NTHR + threadIdx.x; i < MS * (DM / 4); i += gridDim.x * NTHR) {
    const int r = i >> 8, j = (i & 255) * 4;
    const int tj = j >> 7, jl = j & 127, va = tj * 256 + (jl >> 6) * 128 + ((jl >> 4) & 3) * 32 + (jl & 15);
    f32x4 ya = f32x4{0.f, 0.f, 0.f, 0.f}, yb = ya, at = ya;
#pragma unroll
    for (int q = 0; q < 4; ++q) {
      ya += *(const f32x4*)(SLG + ((size_t)q * MS + r) * 2048 + va);
      yb += *(const f32x4*)(SLG + ((size_t)q * MS + r) * 2048 + va + 16);
      at += *(const f32x4*)(SLA + ((size_t)q * MS + r) * DM + j);
    }
    const size_t row = (size_t)MP + r;
    const f32x4 gs = unpk4(*(const u32x2*)(P + row * PW + 1024 + j)), ga = unpk4(*(const u32x2*)(P + row * PW + 2048 + j));
    f32x4 sv;
    sv.x = gs.x * ya.x * sigmoidf_(yb.x); sv.y = gs.y * ya.y * sigmoidf_(yb.y); sv.z = gs.z * ya.z * sigmoidf_(yb.z); sv.w = gs.w * ya.w * sigmoidf_(yb.w);
    sv = unpk4(pk4(sv));
    sv.x += ga.x * at.x; sv.y += ga.y * at.y; sv.z += ga.z * at.z; sv.w += ga.w * at.w;
    *(u32x2*)(Mg + row * DM + j) = pk4(sv);
  }
}

__global__ void __launch_bounds__(512) fwd_megakernel(Params p) {
  extern __shared__ __attribute__((aligned(16))) char lds[];
  cg::grid_group grid = cg::this_grid();
  volatile LAS unsigned* xst = (volatile LAS unsigned*)(lds + GEMM_LDS);
  if (threadIdx.x == 0) { xst[0] = 0u; xst[1] = 0u; }
  __syncthreads();
  XcdBarrier xb = xcd_barrier_post(g_xbar, xst);
  if (p.ws == nullptr) grid.sync();
  unsigned char* ws = p.ws;
  LAS unsigned char* glds = (LAS unsigned char*)lds;
  const int lane = threadIdx.x & 63, wid = threadIdx.x >> 6;
  const int gw = blockIdx.x * NWAVE + wid, NGW = gridDim.x * NWAVE;

  prep_phase(p, lds);
  GSYNC();
  gemm_phase<EPI_IN>(p, (const bf16_t*)(ws + OFF_B), (const bf16_t*)(ws + OFF_WIN), 1024, DIN, glds);
  GSYNC();
  {
    for (int bu = blockIdx.x; bu < 256; bu += gridDim.x) attn_block_unit(p, bu, lds, threadIdx.x);
    bf16_t* Hs = (bf16_t*)(lds + wid * 4352);
    constexpr int N_S1 = 8 * 32 * 16, N_SS = 32 * 32, N_AT = 256;
    for (int u = gw; u < N_S1; u += NGW) { if ((u & 15) != 15) scan_end_unit(p, u, lane); }
    for (int i = gw; i < 2 * N_SS; i += NGW) { if ((i & 1) == 0) scan_unit<2>(p, i >> 1, lane, Hs); }
    for (int i = gw; i < 8 * N_AT; i += NGW) { if ((i & 7) == 1) attn_sample_unit(p, i >> 3, lane); }
  }
  GSYNC();
  {
    bf16_t* Hs = (bf16_t*)(lds + wid * 4352);
    for (int u = gw; u < 8 * 32 * 16; u += NGW) scan_unit<1>(p, u, lane, Hs);
  }
  GSYNC();
  gemm_phase<EPI_GLU>(p, (const bf16_t*)(ws + OFF_GY), (const bf16_t*)(ws + OFF_WGLU), 512, 2048, glds, (const bf16_t*)(ws + OFF_O), (const bf16_t*)(ws + OFF_WATT));
  GSYNC();
  gemm_phase<EPI_ATT>(p, (const bf16_t*)(ws + OFF_O), (const bf16_t*)(ws + OFF_WATT), 512, 1024, glds);
  sample_merge(p);
  GSYNC();
  gemm_phase<EPI_WO>(p, (const bf16_t*)(ws + OFF_MG), (const bf16_t*)(ws + OFF_WO), 1024, 1024, glds);
  GSYNC();
  ln_phase<1>(p);
  GSYNC();
  gemm_phase<EPI_UP>(p, (const bf16_t*)(ws + OFF_X1B), (const bf16_t*)(ws + OFF_WUP), 1024, 5632, glds);
  GSYNC();
  fixup_phase(p);
  GSYNC();
  gemm_phase<EPI_DOWN>(p, (const bf16_t*)(ws + OFF_H), (const bf16_t*)(ws + OFF_WDN), DFF, 1024, glds);
  GSYNC();
  ln_phase<2>(p);
  __syncthreads();
  if (threadIdx.x == 0) {
    unsigned* bar = g_xbar;
    const unsigned old = xb_add(&bar[XB_EXIT], 1u);
    if (old == gridDim.x - 1u) {
#pragma unroll
      for (int j = 0; j < 16; ++j) {
        __hip_atomic_store(&bar[XB_XCNT(j)], 0u, __ATOMIC_RELAXED, __HIP_MEMORY_SCOPE_AGENT);
        __hip_atomic_store(&bar[XB_XSUB(j)], 0u, __ATOMIC_RELAXED, __HIP_MEMORY_SCOPE_AGENT);
        __hip_atomic_store(&bar[XB_XGEN(j)], 0u, __ATOMIC_RELAXED, __HIP_MEMORY_SCOPE_AGENT);
      }
      __hip_atomic_store(&bar[XB_TOP], 0u, __ATOMIC_RELAXED, __HIP_MEMORY_SCOPE_AGENT);
      __hip_atomic_store(&bar[XB_TOPGEN], 0u, __ATOMIC_RELAXED, __HIP_MEMORY_SCOPE_AGENT);
      __hip_atomic_store(&bar[XB_TMO], 0u, __ATOMIC_RELAXED, __HIP_MEMORY_SCOPE_AGENT);
      __hip_atomic_store(&bar[XB_EXIT], 0u, __ATOMIC_RELAXED, __HIP_MEMORY_SCOPE_AGENT);
    }
  }
}

extern "C" void kernel_launch(void* const* d_in, const int* in_sizes, int n_in, void* d_out, int out_size, void* d_ws, size_t ws_size, hipStream_t stream) {
  static int grid_blocks = 0;
  if (grid_blocks == 0) {
    if (n_in != 28 || ws_size < WS_TOTAL) { fprintf(stderr, "kernel_launch: unexpected n_in %d or ws_size %zu (< %zu)\n", n_in, ws_size, (size_t)WS_TOTAL); grid_blocks = -1; return; }
    int dev = 0, cus = 0, per_cu = 0;
    (void)hipGetDevice(&dev);
    (void)hipDeviceGetAttribute(&cus, hipDeviceAttributeMultiprocessorCount, dev);
    (void)hipFuncSetAttribute((const void*)fwd_megakernel, hipFuncAttributeMaxDynamicSharedMemorySize, LDS_BYTES);
    (void)hipOccupancyMaxActiveBlocksPerMultiprocessor(&per_cu, (const void*)fwd_megakernel, NTHR, LDS_BYTES);
    if (per_cu < 1) { fprintf(stderr, "kernel_launch: occupancy query returned %d\n", per_cu); per_cu = 1; }
    if (per_cu > 1) per_cu = 1;
    grid_blocks = cus * per_cu;
    fprintf(stderr, "kernel_launch: cus %d per_cu %d grid %d\n", cus, per_cu, grid_blocks);
  }
  if (grid_blocks < 0) return;
  Params p{};
  for (int i = 0; i < 28; ++i) p.in[i] = (const float*)d_in[i];
  p.out = (float*)d_out; p.ws = (unsigned char*)d_ws;
  void* args[] = {&p};
  hipError_t e = hipLaunchCooperativeKernel((const void*)fwd_megakernel, dim3(grid_blocks), dim3(NTHR), args, LDS_BYTES, stream);
  if (e != hipSuccess) fprintf(stderr, "cooperative launch failed: %s (grid %d)\n", hipGetErrorString(e), grid_blocks);
}
```

```cpp
#include <hip/hip_runtime.h>
#include <hip/hip_cooperative_groups.h>
#include <cstdio>
#include <cstdint>
namespace cg = cooperative_groups;

typedef unsigned short bf16_t;
typedef short bf16x8 __attribute__((ext_vector_type(8)));
typedef short bf16x4 __attribute__((ext_vector_type(4)));
typedef float f32x4 __attribute__((ext_vector_type(4)));
typedef unsigned u32x2 __attribute__((ext_vector_type(2)));
typedef unsigned u32x4 __attribute__((ext_vector_type(4)));

constexpr int MP = 16384, MS = 512, MT = MP + MS;
constexpr int DM = 1024, DIN = 3328, PW = 3072, DFF = 2816;
constexpr int NRB = MP / 64;
constexpr float ALPHA_F = 1.189207115002721f;
constexpr float LN_EPS_F = 1e-5f;

constexpr size_t O_YP = 0, O_YS = 16777216, O_KP = 17301504, O_VP = 17432576, O_KS = 17563648, O_VS = 19660800,
                 O_HRP = 21757952, O_HIP = 21774336, O_HRS = 21790720, O_HIS = 22052864, O_CP = 22315008, O_CS = 22360064;

constexpr size_t OFF_P = 0;
constexpr size_t OFF_H = 0;
constexpr size_t OFF_B = (size_t)MT * PW * 2;
constexpr size_t OFF_GY = OFF_B, OFF_O = OFF_B + (size_t)MT * 512 * 2;
constexpr size_t OFF_C = OFF_B + (size_t)MT * DM * 2;
constexpr size_t OFF_MG = OFF_C;
constexpr size_t OFF_X1B = OFF_C + (size_t)MT * DM * 2;
constexpr size_t OFF_KP = OFF_C + (size_t)MT * DM * 2;
constexpr size_t OFF_VTP = OFF_KP + (size_t)8 * 2048 * 128 * 2;
constexpr size_t OFF_KS = OFF_VTP + (size_t)8 * 2048 * 128 * 2;
constexpr size_t OFF_VTS = OFF_KS + (size_t)128 * 144 * 128 * 2;
constexpr size_t OFF_W = OFF_C + (size_t)MT * DM * 4;
constexpr size_t OFF_WIN = OFF_W;
constexpr size_t OFF_WGLU = OFF_WIN + (size_t)DIN * 1024 * 2;
constexpr size_t OFF_WATT = OFF_WGLU + (size_t)2048 * 512 * 2;
constexpr size_t OFF_WO = OFF_WATT + (size_t)1024 * 512 * 2;
constexpr size_t OFF_WUP = OFF_WO + (size_t)1024 * 1024 * 2;
constexpr size_t OFF_WDN = OFF_WUP + (size_t)5632 * 1024 * 2;
constexpr size_t OFF_SSM = OFF_WDN + (size_t)1024 * DFF * 2;
constexpr size_t OFF_AR = OFF_SSM, OFF_AI = OFF_SSM + 8192, OFF_BB = OFF_SSM + 16384;
constexpr size_t OFF_E = OFF_BB + 131072;
constexpr size_t OFF_HA0 = OFF_E + (size_t)8 * 32 * 16 * 128 * 4;
constexpr size_t OFF_HG0 = OFF_HA0 + (size_t)NRB * 2 * DFF * 4;
constexpr size_t OFF_HA1 = OFF_HG0 + (size_t)NRB * 2 * DFF * 4;
constexpr size_t WS_END = OFF_HA1 + (size_t)NRB * 2 * DFF * 4;
static_assert(OFF_VTS + (size_t)128 * 144 * 128 * 2 <= OFF_W, "KV overlay overflow");
static_assert(WS_END <= (size_t)256 * 1024 * 1024, "workspace too large");

constexpr size_t OFF_BAR = WS_END;
constexpr size_t WS_TOTAL = OFF_BAR + 16384;
static_assert(WS_TOTAL <= (size_t)256 * 1024 * 1024, "workspace too large");
constexpr size_t OFF_SLAB_WO = OFF_P;
constexpr size_t OFF_SLAB_DN = OFF_B;
static_assert((size_t)11 * MS * DM * 4 <= (size_t)MT * DM * 2, "down slabs must fit the X1b region");
constexpr size_t OFF_SLAB_GLU = OFF_KP;
constexpr size_t OFF_SLAB_ATT = OFF_KP + (size_t)4 * MS * 2048 * 4;
static_assert(OFF_SLAB_ATT + (size_t)4 * MS * DM * 4 <= OFF_W, "GLU/attn slabs must fit the dead K/V + x1 region");
constexpr size_t OFF_PRE1 = OFF_B;
constexpr size_t OFF_PRE2 = OFF_C;
constexpr int GEMM_LDS = 131072;
constexpr int LDS_BYTES = GEMM_LDS + 16;
constexpr int NTHR = 512, NWAVE = 8;

struct Params {
  const float* in[28];
  float* out;
  unsigned char* ws;
};

typedef __bf16 bf16v2_t __attribute__((ext_vector_type(2)));
typedef float f32x2 __attribute__((ext_vector_type(2)));
__device__ __forceinline__ unsigned pk2(float lo, float hi) { f32x2 v = {lo, hi}; bf16v2_t b = __builtin_convertvector(v, bf16v2_t); return __builtin_bit_cast(unsigned, b); }
__device__ __forceinline__ bf16_t f2bf(float x) { return (bf16_t)(pk2(x, 0.f) & 0xffffu); }
__device__ __forceinline__ float bf2f(unsigned v16) { return __uint_as_float(v16 << 16); }
__device__ __forceinline__ float bflo(unsigned w) { return __uint_as_float(w << 16); }
__device__ __forceinline__ float bfhi(unsigned w) { return __uint_as_float(w & 0xffff0000u); }
__device__ __forceinline__ float rcp_nr(float d) { const float r = __builtin_amdgcn_rcpf(d); return fmaf(r, fmaf(-d, r, 1.f), r); }
__device__ __forceinline__ float sigmoidf_(float x) { return rcp_nr(1.f + __expf(fminf(-x, 80.f))); }
__device__ __forceinline__ float gelu_tanh(float x) { float z = 1.5957691216057308f * (x + 0.044715f * x * x * x); return x * rcp_nr(1.f + __expf(fminf(-z, 80.f))); }
__device__ __forceinline__ float wave_sum(float v) {
#pragma unroll
  for (int o = 1; o < 64; o <<= 1) v += __shfl_xor(v, o);
  return v;
}
__device__ __forceinline__ u32x2 pk4(f32x4 v) { u32x2 r; r.x = pk2(v.x, v.y); r.y = pk2(v.z, v.w); return r; }
__device__ __forceinline__ f32x4 unpk4(u32x2 w) { f32x4 r; r.x = bflo(w.x); r.y = bfhi(w.x); r.z = bflo(w.y); r.w = bfhi(w.y); return r; }


#define LAS __attribute__((address_space(3)))
namespace pg8 {
constexpr int BM = 256, BK = 64, HALF = 128, HTB = HALF * BK * 2, NXCD = 8, WGM = 8;
__device__ __forceinline__ int lds_byte(int r, int c) { const int st = (r >> 4) * 2 + (c >> 5), rr = r & 15, cc = c & 31, ob = rr * 64 + cc * 2; return st * 1024 + (ob ^ (((ob >> 9) & 1) << 5)); }
__device__ __forceinline__ void stage_rc(int b, int& R, int& C) { const int st = b / 1024, sb = b % 1024, swz = sb ^ (((sb >> 9) & 1) << 5); R = (st >> 1) * 16 + swz / 64; C = (st & 1) * 32 + (swz % 64) / 2; }
struct Unit { int pm, pn, k0, nk, slice; };
struct StaticOrder {
    int nM, nN, nwg, G, c;
    __device__ __forceinline__ void init(int M, int N, int G_, int c_) { nM = M / BM; nN = N / BM; nwg = nM * nN; G = G_; c = c_; }
    int nsplit, nslice_items, nt, glu;
    __device__ __forceinline__ bool next(int i, int& pm, int& pn, int& k0, int& nk, int& slice, int& src) const {
        const long L = (long)i * G + c;
        pm = 0; pn = 0; k0 = 0; nk = nt; slice = -1; src = 0;
        if (L < nwg) {
            int wgid = (int)L; { const int q = nwg / NXCD, r = nwg % NXCD, xcd = wgid % NXCD, off = wgid / NXCD; wgid = (xcd < r ? xcd * (q + 1) : r * (q + 1) + (xcd - r) * q) + off; }
            const int nig = WGM * nN, gid = wgid / nig, fm = gid * WGM, gsz = (nM - fm) < WGM ? (nM - fm) : WGM;
            pm = fm + ((wgid % nig) % gsz); pn = (wgid % nig) / gsz; return true;
        }
        if (nsplit == 0) return false;
        int sidx = (int)(L - nwg);
        if (sidx >= nslice_items) return false;
        int ncol = nN;
        if (glu && sidx >= 64) { sidx -= 64; src = 1; ncol = 4; }
        const int tl = sidx / nsplit; slice = sidx - tl * nsplit; pm = 64 + tl / ncol; pn = tl % ncol; nk = nt / nsplit; k0 = slice * nk; return true;
    }
};
}

enum { EPI_IN = 0, EPI_GLU = 1, EPI_ATT = 2, EPI_WO = 3, EPI_UP = 4, EPI_DOWN = 5 };

__device__ __forceinline__ float dpp_ror1(float v) { return __int_as_float(__builtin_amdgcn_update_dpp(0, __float_as_int(v), 0x121, 0xf, 0xf, false)); }
__device__ __forceinline__ float dpp_ror2(float v) { return __int_as_float(__builtin_amdgcn_update_dpp(0, __float_as_int(v), 0x122, 0xf, 0xf, false)); }
__device__ __forceinline__ float dpp_shr1_old(float old, float v) { return __int_as_float(__builtin_amdgcn_update_dpp(__float_as_int(old), __float_as_int(v), 0x111, 0xf, 0xf, false)); }
__device__ __forceinline__ float dpp_shr2_old(float old, float v) { return __int_as_float(__builtin_amdgcn_update_dpp(__float_as_int(old), __float_as_int(v), 0x112, 0xf, 0xf, false)); }
__device__ __forceinline__ f32x4 shr1v(f32x4 o, f32x4 v) { return f32x4{dpp_shr1_old(o.x, v.x), dpp_shr1_old(o.y, v.y), dpp_shr1_old(o.z, v.z), dpp_shr1_old(o.w, v.w)}; }
__device__ __forceinline__ f32x4 shr2v(f32x4 o, f32x4 v) { return f32x4{dpp_shr2_old(o.x, v.x), dpp_shr2_old(o.y, v.y), dpp_shr2_old(o.z, v.z), dpp_shr2_old(o.w, v.w)}; }
__device__ __forceinline__ f32x4 ror1v(f32x4 v) { return f32x4{dpp_ror1(v.x), dpp_ror1(v.y), dpp_ror1(v.z), dpp_ror1(v.w)}; }
__device__ __forceinline__ f32x4 ror2v(f32x4 v) { return f32x4{dpp_ror2(v.x), dpp_ror2(v.y), dpp_ror2(v.z), dpp_ror2(v.w)}; }

template <int EPI>
__device__ __forceinline__ void epilogue(const Params& p, f32x4 (&acc)[2][2][4][2], const int pm, const int pn, const int wr, const int wc, const int fr, const int fq) {
  unsigned char* ws = p.ws;
  bf16_t* P = (bf16_t*)(ws + OFF_P);
  if constexpr (EPI == EPI_IN) {
    bf16_t* Kp = (bf16_t*)(ws + OFF_KP); bf16_t* Ks = (bf16_t*)(ws + OFF_KS);
    bf16_t* Vtp = (bf16_t*)(ws + OFF_VTP); bf16_t* Vts = (bf16_t*)(ws + OFF_VTS);
#pragma unroll
    for (int bj = 0; bj < 2; ++bj) {
      const int col0 = pn * 256 + bj * 128;
#pragma unroll
      for (int ai = 0; ai < 2; ++ai)
#pragma unroll
        for (int m = 0; m < 4; ++m) {
          const int row = pm * 256 + ai * 128 + wr * 64 + m * 16 + fr;
#pragma unroll
          for (int n = 0; n < 2; ++n) {
            const int col = col0 + wc * 32 + n * 16 + fq * 4;
            f32x4 v = acc[ai][bj][m][n];
            if (col0 < 1024) {
              *(u32x2*)(P + (size_t)row * PW + col) = pk4(v);
            } else if (col0 >= 1280) {
              v.x = sigmoidf_(v.x); v.y = sigmoidf_(v.y); v.z = sigmoidf_(v.z); v.w = sigmoidf_(v.w);
              *(u32x2*)(P + (size_t)row * PW + col - 256) = pk4(v);
            } else if (col0 == 1024) {
              const int cc = col - 1024;
              if (row < MP) {
                *(u32x2*)(Kp + (size_t)row * 128 + cc) = pk4(v);
                const int pos = row & 2047;
                if (pos >= 1920) *(f32x4*)(p.out + O_KP + ((size_t)(row >> 11) * 128 + (pos - 1920)) * 128 + cc) = v;
              } else {
                const int s = row - MP, b = s >> 2, tt = s & 3;
                *(u32x2*)(Ks + ((size_t)b * 144 + 128 + tt) * 128 + cc) = pk4(v);
                *(f32x4*)(p.out + O_KS + ((size_t)b * 128 + 124 + tt) * 128 + cc) = v;
              }
            } else {
              const int cc = col - 1152, kv = cc >> 6, d = cc & 63;
              if (row < MP) {
                const int b = row >> 11, pos = row & 2047;
                bf16_t* dst = Vtp + ((size_t)(b * 2 + kv) * 64 + d) * 2048 + pos;
                dst[0] = f2bf(v.x); dst[2048] = f2bf(v.y); dst[4096] = f2bf(v.z); dst[6144] = f2bf(v.w);
                if (pos >= 1920) *(f32x4*)(p.out + O_VP + ((size_t)b * 128 + (pos - 1920)) * 128 + cc) = v;
              } else {
                const int s = row - MP, b = s >> 2, tt = s & 3;
                bf16_t* dst = Vts + ((size_t)(b * 2 + kv) * 64 + d) * 144 + 128 + tt;
                dst[0] = f2bf(v.x); dst[144] = f2bf(v.y); dst[288] = f2bf(v.z); dst[432] = f2bf(v.w);
                *(f32x4*)(p.out + O_VS + ((size_t)b * 128 + 124 + tt) * 128 + cc) = v;
              }
            }
          }
        }
    }
  } else if constexpr (EPI == EPI_GLU) {
    bf16_t* Mg = (bf16_t*)(ws + OFF_MG);
#pragma unroll
    for (int ai = 0; ai < 2; ++ai)
#pragma unroll
      for (int m = 0; m < 4; ++m) {
        const int row = pm * 256 + ai * 128 + wr * 64 + m * 16 + fr;
#pragma unroll
        for (int bj = 0; bj < 2; ++bj) {
          const int j0 = pn * 128 + bj * 64 + wc * 16 + fq * 4;
          const f32x4 ya = acc[ai][bj][m][0], yb = acc[ai][bj][m][1];
          const f32x4 gs = unpk4(*(const u32x2*)(P + (size_t)row * PW + 1024 + j0));
          f32x4 sv;
          sv.x = gs.x * ya.x * sigmoidf_(yb.x); sv.y = gs.y * ya.y * sigmoidf_(yb.y);
          sv.z = gs.z * ya.z * sigmoidf_(yb.z); sv.w = gs.w * ya.w * sigmoidf_(yb.w);
          *(u32x2*)(Mg + (size_t)row * DM + j0) = pk4(sv);
        }
      }
  } else if constexpr (EPI == EPI_ATT) {
    bf16_t* Mg = (bf16_t*)(ws + OFF_MG);
#pragma unroll
    for (int ai = 0; ai < 2; ++ai)
#pragma unroll
      for (int m = 0; m < 4; ++m) {
        const int row = pm * 256 + ai * 128 + wr * 64 + m * 16 + fr;
#pragma unroll
        for (int bj = 0; bj < 2; ++bj)
#pragma unroll
          for (int n = 0; n < 2; ++n) {
            const int col = pn * 256 + bj * 128 + wc * 32 + n * 16 + fq * 4;
            const f32x4 ga = unpk4(*(const u32x2*)(P + (size_t)row * PW + 2048 + col));
            const f32x4 sv = unpk4(*(const u32x2*)(Mg + (size_t)row * DM + col));
            f32x4 v = acc[ai][bj][m][n];
            v.x = sv.x + ga.x * v.x; v.y = sv.y + ga.y * v.y; v.z = sv.z + ga.z * v.z; v.w = sv.w + ga.w * v.w;
            *(u32x2*)(Mg + (size_t)row * DM + col) = pk4(v);
          }
      }
  } else if constexpr (EPI == EPI_WO || EPI == EPI_DOWN) {
    const bf16_t* X1b = (const bf16_t*)(ws + OFF_X1B);
#pragma unroll
    for (int ai = 0; ai < 2; ++ai)
#pragma unroll
      for (int m = 0; m < 4; ++m) {
        const int row = pm * 256 + ai * 128 + wr * 64 + m * 16 + fr;
#pragma unroll
        for (int bj = 0; bj < 2; ++bj)
#pragma unroll
          for (int n = 0; n < 2; ++n) {
            const int col = pn * 256 + bj * 128 + wc * 32 + n * 16 + fq * 4;
            f32x4 x;
            if constexpr (EPI == EPI_WO) x = *(const f32x4*)(p.in[0] + (size_t)row * DM + col);
            else x = unpk4(*(const u32x2*)(X1b + (size_t)row * DM + col));
            f32x4 v = acc[ai][bj][m][n];
            v.x += ALPHA_F * x.x; v.y += ALPHA_F * x.y; v.z += ALPHA_F * x.z; v.w += ALPHA_F * x.w;
            *(u32x2*)((bf16_t*)(ws + (EPI == EPI_WO ? OFF_PRE1 : OFF_PRE2)) + (size_t)row * DM + col) = pk4(v);
          }
      }
  } else {
    bf16_t* H = (bf16_t*)(ws + OFF_H);
    float* HA0 = (float*)(ws + OFF_HA0); float* HG0 = (float*)(ws + OFF_HG0); float* HA1 = (float*)(ws + OFF_HA1);
    const bool prompt = (pm < MP / 256);
#pragma unroll
    for (int bj = 0; bj < 2; ++bj) {
      const int j0 = pn * 128 + bj * 64 + wc * 16 + fq * 4;
      const f32x4 w0 = *(const f32x4*)(p.in[23] + j0), w1 = *(const f32x4*)(p.in[23] + DFF + j0), w2 = *(const f32x4*)(p.in[23] + 2 * DFF + j0);
      const f32x4 cb = *(const f32x4*)(p.in[24] + j0);
#pragma unroll
      for (int ai = 0; ai < 2; ++ai) {
        const int rblk = pm * 256 + ai * 128 + wr * 64;
#pragma unroll
        for (int m = 0; m < 4; ++m) {
          const int row = rblk + m * 16 + fr;
          const f32x4 a0 = acc[ai][bj][m][0], g = acc[ai][bj][m][1];
          f32x4 am1, am2; bool defer = false;
          if (prompt) {
            f32x4 o1 = f32x4{0.f, 0.f, 0.f, 0.f}, o2 = o1;
            if (m > 0) { o1 = ror1v(acc[ai][bj][m > 0 ? m - 1 : 0][0]); o2 = ror2v(acc[ai][bj][m > 0 ? m - 1 : 0][0]); }
            am1 = shr1v(o1, a0); am2 = shr2v(o2, a0);
            if (m == 0 && fr < 2 && (row & 2047) >= 2) defer = true;
            if (m == 3 && fr >= 14) *(f32x4*)(HA1 + ((size_t)(rblk >> 6) * 2 + (fr - 14)) * DFF + j0) = a0;
            const int pos = row & 2047;
            if (pos >= 2046) *(f32x4*)(p.out + O_CP + ((size_t)(row >> 11) * 2 + (pos - 2046)) * DFF + j0) = a0;
          } else {
            const int sidx = row - MP, b = sidx >> 2, tt = sidx & 3;
            const f32x4 st0 = *(const f32x4*)(p.in[6] + ((size_t)b * 2 + 0) * DFF + j0);
            const f32x4 st1 = *(const f32x4*)(p.in[6] + ((size_t)b * 2 + 1) * DFF + j0);
            const f32x4 s1 = ror1v(a0), s2 = ror2v(a0);
            am1 = (tt >= 1) ? s1 : st1;
            am2 = (tt >= 2) ? s2 : ((tt == 1) ? st1 : st0);
            if (tt >= 2) *(f32x4*)(p.out + O_CS + ((size_t)b * 2 + (tt - 2)) * DFF + j0) = a0;
          }
          if (!defer) {
            f32x4 h;
            h.x = gelu_tanh(cb.x + w0.x * am2.x + w1.x * am1.x + w2.x * a0.x) * g.x;
            h.y = gelu_tanh(cb.y + w0.y * am2.y + w1.y * am1.y + w2.y * a0.y) * g.y;
            h.z = gelu_tanh(cb.z + w0.z * am2.z + w1.z * am1.z + w2.z * a0.z) * g.z;
            h.w = gelu_tanh(cb.w + w0.w * am2.w + w1.w * am1.w + w2.w * a0.w) * g.w;
            *(u32x2*)(H + (size_t)row * DFF + j0) = pk4(h);
          } else {
            *(f32x4*)(HA0 + ((size_t)(rblk >> 6) * 2 + fr) * DFF + j0) = a0;
            *(f32x4*)(HG0 + ((size_t)(rblk >> 6) * 2 + fr) * DFF + j0) = g;
          }
        }
      }
    }
  }
}

template <int EPI>
__device__ __forceinline__ void gemm_phase(const Params& p, const bf16_t* __restrict__ gA, const bf16_t* __restrict__ gBt, const int K, const int N, LAS unsigned char* lds,
                                           const bf16_t* __restrict__ gA2 = nullptr, const bf16_t* __restrict__ gBt2 = nullptr) {
    using namespace pg8;
    int tid_ = threadIdx.x; asm volatile("" : "+v"(tid_));
    const int tid = tid_, wid = __builtin_amdgcn_readfirstlane(tid >> 6), lane = tid & 63, wr = wid >> 2, wc = wid & 3, fr = lane & 15, fq = lane >> 4;
    const int nt = K / BK;
    constexpr bool SPLIT = (EPI == EPI_WO || EPI == EPI_DOWN || EPI == EPI_GLU);
    constexpr bool PROMPT_ONLY = SPLIT || (EPI == EPI_ATT);
    constexpr int NSPLIT = (EPI == EPI_WO) ? 8 : (EPI == EPI_DOWN ? 11 : 4);
    StaticOrder S; S.init(PROMPT_ONLY ? MP : MT, N, gridDim.x, blockIdx.x);
    const int nN_ = N / BM;
    S.nt = nt; S.nsplit = SPLIT ? NSPLIT : 0; S.glu = (EPI == EPI_GLU) ? 1 : 0;
    S.nslice_items = (EPI == EPI_GLU) ? 96 : 2 * nN_ * NSPLIT;
    unsigned voff[2];
#pragma unroll
    for (int i = 0; i < 2; ++i) { int R, C; stage_rc(tid * 16 + i * 8192, R, C); voff[i] = (unsigned)(R * K + C) * 2u; }
    const size_t kstep = (size_t)(BK * 2);
    const size_t hstep = (size_t)HALF * K * 2;
    const size_t tstep = 2 * hstep;
    const unsigned ldsw = (unsigned)wid * 1024u;
    const int aoff = lds_byte(wr * 64 + fr, fq * 8), boff = lds_byte(wc * 32 + fr, fq * 8);
#define PG8_SA(b, h) (((b) * 2 + (h)) * HTB)
#define PG8_SB(b, h) ((4 + (b) * 2 + (h)) * HTB)
#define PG8_STAGE(bufoff, gbase) do { _Pragma("unroll") for (int _i = 0; _i < 2; ++_i) \
        __builtin_amdgcn_global_load_lds((const unsigned*)((const char*)(gbase) + voff[_i]), (LAS unsigned*)(lds + (bufoff) + ldsw + _i * 8192), 16, 0, 0); } while (0)
#define PG8_LDA(dst, b, h) do { _Pragma("unroll") for (int m = 0; m < 4; ++m) _Pragma("unroll") for (int k = 0; k < 2; ++k) dst[m][k] = *(const LAS bf16x8*)(lds + PG8_SA(b, h) + aoff + m * 2048 + k * 1024); } while (0)
#define PG8_LDB(dst, b, h) do { _Pragma("unroll") for (int n = 0; n < 2; ++n) _Pragma("unroll") for (int k = 0; k < 2; ++k) dst[n][k] = *(const LAS bf16x8*)(lds + PG8_SB(b, h) + boff + n * 2048 + k * 1024); } while (0)
#define PG8_MMA(ai, bj, At, Bt) do { __builtin_amdgcn_s_setprio(1); _Pragma("unroll") for (int m = 0; m < 4; ++m) _Pragma("unroll") for (int n = 0; n < 2; ++n) _Pragma("unroll") for (int k = 0; k < 2; ++k) \
        acc[ai][bj][m][n] = __builtin_amdgcn_mfma_f32_16x16x32_bf16(Bt[n][k], At[m][k], acc[ai][bj][m][n], 0, 0, 0); __builtin_amdgcn_s_setprio(0); } while (0)
#define PG8_WAIT_V(n) asm volatile("s_waitcnt vmcnt(" #n ")" ::: "memory")
#define PG8_WAIT_L(n) asm volatile("s_waitcnt lgkmcnt(" #n ")" ::: "memory")
#define PG8_BAR __builtin_amdgcn_s_barrier()
#define PG8_SCHED __builtin_amdgcn_sched_barrier(0)
    int ui = 0, cur_pm, cur_pn, cur_k0, cur_nk, cur_slice, cur_src, nxt_pm, nxt_pn, nxt_k0, nxt_nk, nxt_slice, nxt_src;
    if (!S.next(0, cur_pm, cur_pn, cur_k0, cur_nk, cur_slice, cur_src)) return;
    f32x4 acc[2][2][4][2];
#pragma unroll
    for (int a = 0; a < 2; ++a)
#pragma unroll
        for (int b = 0; b < 2; ++b)
#pragma unroll
            for (int m = 0; m < 4; ++m)
#pragma unroll
                for (int n = 0; n < 2; ++n) acc[a][b][m][n] = (f32x4){0.f, 0.f, 0.f, 0.f};
    bf16x8 At[4][2], B0[2][2], B1[2][2];
    const char* cA = (const char*)((EPI == EPI_GLU && cur_src) ? gA2 : gA) + (size_t)cur_pm * tstep + (size_t)cur_k0 * kstep;
    const char* cB = (const char*)((EPI == EPI_GLU && cur_src) ? gBt2 : gBt) + (size_t)cur_pn * tstep + (size_t)cur_k0 * kstep;
    PG8_STAGE(PG8_SB(0, 0), cB); PG8_STAGE(PG8_SB(0, 1), cB + hstep); PG8_STAGE(PG8_SA(0, 0), cA); PG8_STAGE(PG8_SA(0, 1), cA + hstep);
    if (wr == 1) PG8_BAR;
    PG8_WAIT_V(2); PG8_BAR;
    PG8_STAGE(PG8_SB(1, 0), cB + kstep); PG8_STAGE(PG8_SA(1, 0), cA + kstep); PG8_STAGE(PG8_SB(1, 1), cB + hstep + kstep);
    PG8_WAIT_V(6); PG8_BAR;
    for (;;) {
        const bool has_next = S.next(ui + 1, nxt_pm, nxt_pn, nxt_k0, nxt_nk, nxt_slice, nxt_src);
        const char* nA = has_next ? (const char*)((EPI == EPI_GLU && nxt_src) ? gA2 : gA) + (size_t)nxt_pm * tstep + (size_t)nxt_k0 * kstep : cA;
        const char* nB = has_next ? (const char*)((EPI == EPI_GLU && nxt_src) ? gBt2 : gBt) + (size_t)nxt_pn * tstep + (size_t)nxt_k0 * kstep : cB;
        const int cnk = cur_nk;
        for (int t = 0; t < cnk; t += 2) {
            const bool last = (t == cnk - 2);
            const char* a1 = cA + (size_t)(t + 1) * kstep;
            const char* a2 = last ? nA : cA + (size_t)(t + 2) * kstep; const char* b2 = last ? nB : cB + (size_t)(t + 2) * kstep;
            const char* a3 = a2 + kstep; const char* b3 = b2 + kstep;
            PG8_LDB(B0, 0, 0); PG8_LDB(B1, 0, 1); PG8_SCHED; PG8_LDA(At, 0, 0); PG8_STAGE(PG8_SA(1, 1), a1 + hstep);
            PG8_WAIT_V(8); PG8_WAIT_L(0); PG8_BAR; PG8_MMA(0, 0, At, B0); PG8_MMA(0, 1, At, B1); PG8_BAR; PG8_SCHED;
            PG8_LDA(At, 0, 1); PG8_STAGE(PG8_SB(0, 0), b2); PG8_STAGE(PG8_SB(0, 1), b2 + hstep); PG8_STAGE(PG8_SA(0, 0), a2);
            PG8_WAIT_V(8); PG8_WAIT_L(0); PG8_BAR; PG8_MMA(1, 0, At, B0); PG8_MMA(1, 1, At, B1); PG8_BAR; PG8_SCHED;
            PG8_LDB(B0, 1, 0); PG8_LDB(B1, 1, 1); PG8_SCHED; PG8_LDA(At, 1, 0); PG8_STAGE(PG8_SA(0, 1), a2 + hstep);
            PG8_WAIT_V(8); PG8_WAIT_L(0); PG8_BAR; PG8_MMA(0, 0, At, B0); PG8_MMA(0, 1, At, B1); PG8_BAR; PG8_SCHED;
            PG8_LDA(At, 1, 1); PG8_STAGE(PG8_SB(1, 0), b3); PG8_STAGE(PG8_SB(1, 1), b3 + hstep); PG8_STAGE(PG8_SA(1, 0), a3);
            PG8_WAIT_V(8); PG8_WAIT_L(0); PG8_BAR; PG8_MMA(1, 0, At, B0); PG8_MMA(1, 1, At, B1); PG8_BAR; PG8_SCHED;
        }
        if (wr == 0) PG8_BAR;
        if (SPLIT && cur_slice >= 0) {
            const int ldc = (EPI == EPI_GLU && cur_src == 0) ? 2048 : DM;
            float* SL = (float*)(p.ws + (EPI == EPI_WO ? OFF_SLAB_WO : (EPI == EPI_DOWN ? OFF_SLAB_DN : (cur_src ? OFF_SLAB_ATT : OFF_SLAB_GLU)))) + (size_t)cur_slice * MS * ldc;
#pragma unroll
            for (int ai = 0; ai < 2; ++ai)
#pragma unroll
                for (int m = 0; m < 4; ++m) {
                    const int rs = (cur_pm - 64) * 256 + ai * 128 + wr * 64 + m * 16 + fr;
#pragma unroll
                    for (int bj = 0; bj < 2; ++bj)
#pragma unroll
                        for (int n = 0; n < 2; ++n) *(f32x4*)(SL + (size_t)rs * ldc + cur_pn * 256 + bj * 128 + wc * 32 + n * 16 + fq * 4) = acc[ai][bj][m][n];
                }
        } else epilogue<EPI>(p, acc, cur_pm, cur_pn, wr, wc, fr, fq);
        if (!has_next) break;
#pragma unroll
        for (int a = 0; a < 2; ++a)
#pragma unroll
            for (int b = 0; b < 2; ++b)
#pragma unroll
                for (int m = 0; m < 4; ++m)
#pragma unroll
                    for (int n = 0; n < 2; ++n) acc[a][b][m][n] = (f32x4){0.f, 0.f, 0.f, 0.f};
        cur_pm = nxt_pm; cur_pn = nxt_pn; cur_k0 = nxt_k0; cur_nk = nxt_nk; cur_slice = nxt_slice; cur_src = nxt_src; cA = nA; cB = nB; ++ui;
        if (wr == 1) PG8_BAR;
    }
    PG8_WAIT_V(0);
    PG8_BAR;
#undef PG8_SA
#undef PG8_SB
#undef PG8_STAGE
#undef PG8_LDA
#undef PG8_LDB
#undef PG8_MMA
#undef PG8_WAIT_V
#undef PG8_WAIT_L
#undef PG8_BAR
#undef PG8_SCHED
}

template <int MODE>
__device__ __forceinline__ int dest_row(int n, int HH) {
  if (MODE == 0) return n;
  const int part = n >= HH ? 1 : 0, j = n - part * HH;
  const int tj = j >> 7, jl = j & 127, bj = jl >> 6, wcj = (jl >> 4) & 3, w = jl & 15;
  return tj * 256 + bj * 128 + wcj * 32 + part * 16 + w;
}
template <int MODE>
__device__ __forceinline__ void transpose_item(const float* __restrict__ W, int K, int N, bf16_t* __restrict__ WT, int HH, float* scr, int item, int lane) {
  const int nblk = N / 32, kb = item / nblk, nb = item - kb * nblk, k0 = 32 * kb, n0 = 32 * nb;
#pragma unroll 8
  for (int i = 0; i < 16; ++i) { const int kk = 2 * i + (lane >> 5); scr[kk * 33 + (lane & 31)] = W[(size_t)(k0 + kk) * N + n0 + (lane & 31)]; }
  asm volatile("s_waitcnt lgkmcnt(0)" ::: "memory");
  const int c = lane & 3;
#pragma unroll
  for (int j = 0; j < 2; ++j) {
    const int n = (lane >> 2) + 16 * j; const float* sp = scr + (8 * c) * 33 + n;
    u32x4 o; o.x = pk2(sp[0], sp[33]); o.y = pk2(sp[66], sp[99]); o.z = pk2(sp[132], sp[165]); o.w = pk2(sp[198], sp[231]);
    *(u32x4*)(WT + (size_t)dest_row<MODE>(n0 + n, HH) * K + k0 + 8 * c) = o;
  }
  asm volatile("s_waitcnt lgkmcnt(0)" ::: "memory");
}

__device__ __forceinline__ void prep_phase(const Params& p, char* lds) {
  unsigned char* ws = p.ws;
  const int tid = threadIdx.x, lane = tid & 63, wid = tid >> 6;
  const int gt = blockIdx.x * NTHR + tid, NGT = gridDim.x * NTHR;
  const int gw = blockIdx.x * NWAVE + wid, NGW = gridDim.x * NWAVE;
  {
    bf16_t* Xb = (bf16_t*)(ws + OFF_B);
    const int nchunk = MT * DM / 8, npc = MP * DM / 8;
    const int nmain = (nchunk / (4 * NGT)) * (4 * NGT);
    for (int i0 = gt; i0 < nmain / 4; i0 += NGT) {
      f32x4 a[4], b[4];
#pragma unroll
      for (int q = 0; q < 4; ++q) {
        const int i = i0 + q * (nmain / 4);
        const float* sp = (i < npc) ? p.in[0] + (size_t)i * 8 : p.in[1] + (size_t)(i - npc) * 8;
        a[q] = *(const f32x4*)sp; b[q] = *(const f32x4*)(sp + 4);
      }
#pragma unroll
      for (int q = 0; q < 4; ++q) {
        const int i = i0 + q * (nmain / 4);
        u32x4 o; o.x = pk2(a[q].x, a[q].y); o.y = pk2(a[q].z, a[q].w); o.z = pk2(b[q].x, b[q].y); o.w = pk2(b[q].z, b[q].w);
        *(u32x4*)(Xb + (size_t)i * 8) = o;
      }
    }
    for (int i = nmain + gt; i < nchunk; i += NGT) {
      const float* sp = (i < npc) ? p.in[0] + (size_t)i * 8 : p.in[1] + (size_t)(i - npc) * 8;
      const f32x4 a = *(const f32x4*)sp, b = *(const f32x4*)(sp + 4);
      u32x4 o; o.x = pk2(a.x, a.y); o.y = pk2(a.z, a.w); o.z = pk2(b.x, b.y); o.w = pk2(b.z, b.w);
      *(u32x4*)(Xb + (size_t)i * 8) = o;
    }
  }
  {
    float* scr = (float*)(lds + wid * 8704);
    constexpr int I_IN = 32 * 104, I_GLU = 16 * 64, I_ATT = 16 * 32, I_O = 32 * 32, I_UP = 32 * 176, I_DN = 88 * 32;
    constexpr int NIT = I_IN + I_GLU + I_ATT + I_O + I_UP + I_DN;
    for (int it = gw; it < NIT; it += NGW) {
      int r = it;
      if (r < I_IN) { transpose_item<0>(p.in[7], 1024, DIN, (bf16_t*)(ws + OFF_WIN), 0, scr, r, lane); continue; } r -= I_IN;
      if (r < I_GLU) { transpose_item<1>(p.in[16], 512, 2048, (bf16_t*)(ws + OFF_WGLU), 1024, scr, r, lane); continue; } r -= I_GLU;
      if (r < I_ATT) { transpose_item<0>(p.in[18], 512, 1024, (bf16_t*)(ws + OFF_WATT), 0, scr, r, lane); continue; } r -= I_ATT;
      if (r < I_O) { transpose_item<0>(p.in[19], 1024, 1024, (bf16_t*)(ws + OFF_WO), 0, scr, r, lane); continue; } r -= I_O;
      if (r < I_UP) { transpose_item<1>(p.in[22], 1024, 5632, (bf16_t*)(ws + OFF_WUP), DFF, scr, r, lane); continue; } r -= I_UP;
      transpose_item<0>(p.in[25], DFF, 1024, (bf16_t*)(ws + OFF_WDN), 0, scr, r, lane);
    }
  }
  {
    bf16_t* Ks = (bf16_t*)(ws + OFF_KS); bf16_t* Vts = (bf16_t*)(ws + OFF_VTS);
    const float* ck = p.in[2]; const float* cv = p.in[3];
    for (int i = gt; i < 128 * 128 * 16; i += NGT) {
      const int c8 = i & 15, w = (i >> 4) & 127, b = i >> 11;
      const float* s = ck + ((size_t)b * 128 + w) * 128 + c8 * 8;
      const f32x4 a = *(const f32x4*)s, bq = *(const f32x4*)(s + 4);
      u32x4 o; o.x = pk2(a.x, a.y); o.y = pk2(a.z, a.w); o.z = pk2(bq.x, bq.y); o.w = pk2(bq.z, bq.w);
      *(u32x4*)(Ks + ((size_t)b * 144 + w) * 128 + c8 * 8) = o;
    }
    for (int i = gt; i < 128 * 12 * 16; i += NGT) {
      const int c8 = i & 15, r = (i >> 4) % 12, b = i / 192;
      *(u32x4*)(Ks + ((size_t)b * 144 + 132 + r) * 128 + c8 * 8) = u32x4{0u, 0u, 0u, 0u};
    }
    for (int i = gt; i < 128 * 16 * 128; i += NGT) {
      const int kvd = i & 127, w8 = (i >> 7) & 15, b = i >> 11;
      const float* s = cv + ((size_t)b * 128 + w8 * 8) * 128 + kvd;
      u32x4 o; o.x = pk2(s[0], s[128]); o.y = pk2(s[256], s[384]); o.z = pk2(s[512], s[640]); o.w = pk2(s[768], s[896]);
      *(u32x4*)(Vts + ((size_t)b * 128 + kvd) * 144 + w8 * 8) = o;
    }
    for (int i = gt; i < 128 * 128 * 3; i += NGT) {
      const int q = i % 3, r = i / 3;
      *(u32x2*)(Vts + (size_t)r * 144 + 132 + q * 4) = u32x2{0u, 0u};
    }
    for (int i = gt; i < 128 * 124 * 32; i += NGT) {
      const int c4 = i & 31, w = (i >> 5) % 124, b = i / (124 * 32);
      const size_t so = ((size_t)b * 128 + w + 4) * 128 + c4 * 4, dof = ((size_t)b * 128 + w) * 128 + c4 * 4;
      *(f32x4*)(p.out + O_KS + dof) = *(const f32x4*)(ck + so);
      *(f32x4*)(p.out + O_VS + dof) = *(const f32x4*)(cv + so);
    }
  }
  {
    float* AR = (float*)(ws + OFF_AR); float* AI = (float*)(ws + OFF_AI); bf16_t* BB = (bf16_t*)(ws + OFF_BB);
    for (int i = gt; i < 2048; i += NGT) {
      const int g = i >> 6, pp = i & 63;
      const float lr = p.in[8][i], li = p.in[9][i], dt = expf(p.in[10][g]);
      const float mag = expf(lr * dt), ang = li * dt;
      const float abr = mag * cosf(ang), abi = mag * sinf(ang);
      const float den = lr * lr + li * li, nr = abr - 1.f;
      const float cr = (nr * lr + abi * li) / den, ci = (abi * lr - nr * li) / den;
      AR[i] = abr; AI[i] = abi;
      const float* br = p.in[11] + (size_t)i * 16; const float* bi = p.in[12] + (size_t)i * 16;
      bf16_t* dre = BB + ((size_t)g * 128 + pp) * 16; bf16_t* dim_ = BB + ((size_t)g * 128 + 64 + pp) * 16;
#pragma unroll
      for (int c = 0; c < 16; ++c) {
        dre[c] = f2bf(cr * br[c] - ci * bi[c]);
        dim_[c] = f2bf(cr * bi[c] + ci * br[c]);
      }
    }
  }
}

#define CMUL_ACC(dr, di, ar_, ai_, br_, bi_) do { const float t_r = (ar_) * (br_) - (ai_) * (bi_); const float t_i = (ar_) * (bi_) + (ai_) * (br_); dr += t_r; di += t_i; } while (0)

template <int MODE>
__device__ __forceinline__ void scan_unit(const Params& p, int u, int lane, bf16_t* Hs) {
  unsigned char* ws = p.ws;
  const int pl = lane & 15, q4 = lane >> 4;
  const bf16_t* P = (const bf16_t*)(ws + OFF_P);
  const float* AR = (const float*)(ws + OFF_AR); const float* AI = (const float*)(ws + OFF_AI);
  const bf16_t* BB = (const bf16_t*)(ws + OFF_BB);
  float* E = (float*)(ws + OFF_E);
  int g, s = 0, c = 0, R0, ntile;
  if (MODE == 2) { g = u & 31; const int ti = u >> 5; R0 = MP + ti * 16; ntile = 1; s = ti; }
  else { c = u & 15; g = (u >> 4) & 31; s = u >> 9; R0 = s * 2048 + c * 128; ntile = 8; }
  float ar[4], ai[4], a4r[4], a4i[4], a8r[4], a8i[4], a128r[4], a128i[4];
#pragma unroll
  for (int q = 0; q < 4; ++q) {
    const float r1 = AR[g * 64 + q * 16 + pl], i1 = AI[g * 64 + q * 16 + pl];
    ar[q] = r1; ai[q] = i1;
    const float r2 = r1 * r1 - i1 * i1, i2 = 2.f * r1 * i1;
    const float r4 = r2 * r2 - i2 * i2, i4 = 2.f * r2 * i2;
    const float r8 = r4 * r4 - i4 * i4, i8 = 2.f * r4 * i4;
    a4r[q] = r4; a4i[q] = i4; a8r[q] = r8; a8i[q] = i8;
    const float r16 = r8 * r8 - i8 * i8, i16 = 2.f * r8 * i8;
    const float r32 = r16 * r16 - i16 * i16, i32 = 2.f * r16 * i16;
    const float r64 = r32 * r32 - i32 * i32, i64 = 2.f * r32 * i32;
    a128r[q] = r64 * r64 - i64 * i64; a128i[q] = 2.f * r64 * i64;
  }
  bf16x4 bb[8];
#pragma unroll
  for (int pt = 0; pt < 8; ++pt) bb[pt] = *(const bf16x4*)(BB + ((size_t)g * 128 + pt * 16 + pl) * 16 + q4 * 4);
  bf16x8 cm[4]; bf16x4 dmv;
  if (MODE != 0) {
#pragma unroll
    for (int ks = 0; ks < 4; ++ks) {
      const float* src = ((ks < 2) ? p.in[13] : p.in[14]) + ((size_t)g * 16 + pl) * 64 + (ks & 1) * 32 + q4 * 8;
      const float sg = (ks < 2) ? 1.f : -1.f;
      const f32x4 x0 = *(const f32x4*)src, x1 = *(const f32x4*)(src + 4);
      u32x4 o; o.x = pk2(sg * x0.x, sg * x0.y); o.y = pk2(sg * x0.z, sg * x0.w); o.z = pk2(sg * x1.x, sg * x1.y); o.w = pk2(sg * x1.z, sg * x1.w);
      cm[ks] = __builtin_bit_cast(bf16x8, o);
    }
    const float dv = p.in[15][g * 16 + pl];
    u32x2 o;
    o.x = pk2((q4 * 4 + 0 == pl) ? dv : 0.f, (q4 * 4 + 1 == pl) ? dv : 0.f);
    o.y = pk2((q4 * 4 + 2 == pl) ? dv : 0.f, (q4 * 4 + 3 == pl) ? dv : 0.f);
    dmv = __builtin_bit_cast(bf16x4, o);
  }
  float hr[4], hi[4];
#pragma unroll
  for (int q = 0; q < 4; ++q) { hr[q] = 0.f; hi[q] = 0.f; }
  if (MODE == 1) {
    const float* Eb = E + ((size_t)(s * 32 + g) * 16) * 128;
#pragma unroll
    for (int bt = 0; bt < 3; ++bt) {
      if (bt * 5 < c) {
        float er[5][4], ei[5][4];
#pragma unroll
        for (int k = 0; k < 5; ++k)
#pragma unroll
          for (int q = 0; q < 4; ++q) { er[k][q] = Eb[(bt * 5 + k) * 128 + q * 16 + pl]; ei[k][q] = Eb[(bt * 5 + k) * 128 + 64 + q * 16 + pl]; }
#pragma unroll
        for (int k = 0; k < 5; ++k) {
          const bool on = (bt * 5 + k) < c;
#pragma unroll
          for (int q = 0; q < 4; ++q) {
            const float nr_ = a128r[q] * hr[q] - a128i[q] * hi[q] + er[k][q];
            const float ni_ = a128r[q] * hi[q] + a128i[q] * hr[q] + ei[k][q];
            hr[q] = on ? nr_ : hr[q]; hi[q] = on ? ni_ : hi[q];
          }
        }
      }
    }
  }
  if (MODE == 2) {
    const int b = s * 4 + q4;
#pragma unroll
    for (int q = 0; q < 4; ++q) {
      hr[q] = p.in[4][((size_t)b * 32 + g) * 64 + q * 16 + pl];
      hi[q] = p.in[5][((size_t)b * 32 + g) * 64 + q * 16 + pl];
    }
  }
  const bf16_t* up = P + (size_t)(R0 + pl) * PW + g * 16 + q4 * 4;
  bf16x4 uf_next = *(const bf16x4*)up;
#pragma unroll 2
  for (int tile = 0; tile < ntile; ++tile) {
    const int Rt = R0 + tile * 16;
    const bf16x4 uf = uf_next;
    if (tile + 1 < ntile) uf_next = *(const bf16x4*)(up + (size_t)(tile + 1) * 16 * PW);
    f32x4 xr[4], xi[4];
    const f32x4 z4 = f32x4{0.f, 0.f, 0.f, 0.f};
#pragma unroll
    for (int q = 0; q < 4; ++q) {
      xr[q] = __builtin_amdgcn_mfma_f32_16x16x16bf16_1k(uf, bb[q], z4, 0, 0, 0);
      xi[q] = __builtin_amdgcn_mfma_f32_16x16x16bf16_1k(uf, bb[q + 4], z4, 0, 0, 0);
    }
#pragma unroll
    for (int q = 0; q < 4; ++q) {
      float s0r = xr[q].x, s0i = xi[q].x, s1r = xr[q].y, s1i = xi[q].y, s2r = xr[q].z, s2i = xi[q].z, s3r = xr[q].w, s3i = xi[q].w;
      if (MODE == 2 || q4 == 0) CMUL_ACC(s0r, s0i, ar[q], ai[q], hr[q], hi[q]);
      CMUL_ACC(s1r, s1i, ar[q], ai[q], s0r, s0i);
      CMUL_ACC(s2r, s2i, ar[q], ai[q], s1r, s1i);
      CMUL_ACC(s3r, s3i, ar[q], ai[q], s2r, s2i);
      if (MODE != 2) {
        float Ir = s3r, Ii = s3i;
        float tr = __shfl_up(Ir, 16), ti = __shfl_up(Ii, 16);
        if (q4 >= 1) CMUL_ACC(Ir, Ii, a4r[q], a4i[q], tr, ti);
        tr = __shfl_up(Ir, 32); ti = __shfl_up(Ii, 32);
        if (q4 >= 2) CMUL_ACC(Ir, Ii, a8r[q], a8i[q], tr, ti);
        float cr = __shfl_up(Ir, 16), ci = __shfl_up(Ii, 16);
        if (q4 == 0) { cr = 0.f; ci = 0.f; }
        float t1r = ar[q] * cr - ai[q] * ci, t1i = ar[q] * ci + ai[q] * cr; s0r += t1r; s0i += t1i;
        float t2r = ar[q] * t1r - ai[q] * t1i, t2i = ar[q] * t1i + ai[q] * t1r; s1r += t2r; s1i += t2i;
        float t3r = ar[q] * t2r - ai[q] * t2i, t3i = ar[q] * t2i + ai[q] * t2r; s2r += t3r; s2i += t3i;
        float t4r = ar[q] * t3r - ai[q] * t3i, t4i = ar[q] * t3i + ai[q] * t3r; s3r += t4r; s3i += t4i;
        hr[q] = __shfl(s3r, 48 + pl); hi[q] = __shfl(s3i, 48 + pl);
      } else {
        hr[q] = s3r; hi[q] = s3i;
      }
      xr[q] = f32x4{s0r, s1r, s2r, s3r}; xi[q] = f32x4{s0i, s1i, s2i, s3i};
    }
    if (MODE != 0) {
#pragma unroll
      for (int q = 0; q < 4; ++q) {
        Hs[(q4 * 4 + 0) * 136 + q * 16 + pl] = f2bf(xr[q].x); Hs[(q4 * 4 + 1) * 136 + q * 16 + pl] = f2bf(xr[q].y);
        Hs[(q4 * 4 + 2) * 136 + q * 16 + pl] = f2bf(xr[q].z); Hs[(q4 * 4 + 3) * 136 + q * 16 + pl] = f2bf(xr[q].w);
        Hs[(q4 * 4 + 0) * 136 + 64 + q * 16 + pl] = f2bf(xi[q].x); Hs[(q4 * 4 + 1) * 136 + 64 + q * 16 + pl] = f2bf(xi[q].y);
        Hs[(q4 * 4 + 2) * 136 + 64 + q * 16 + pl] = f2bf(xi[q].z); Hs[(q4 * 4 + 3) * 136 + 64 + q * 16 + pl] = f2bf(xi[q].w);
      }
      asm volatile("s_waitcnt lgkmcnt(0)" ::: "memory");
      f32x4 y = z4;
#pragma unroll
      for (int ks = 0; ks < 4; ++ks) {
        const bf16x8 hf = *(const bf16x8*)(Hs + pl * 136 + ks * 32 + q4 * 8);
        y = __builtin_amdgcn_mfma_f32_16x16x32_bf16(hf, cm[ks], y, 0, 0, 0);
      }
      y = __builtin_amdgcn_mfma_f32_16x16x16bf16_1k(uf, dmv, y, 0, 0, 0);
      asm volatile("s_waitcnt lgkmcnt(0)" ::: "memory");
      bf16_t* GY = (bf16_t*)(ws + OFF_GY);
      bf16_t* dst = GY + (size_t)(Rt + q4 * 4) * 512 + g * 16 + pl;
      dst[0] = f2bf(gelu_tanh(y.x)); dst[512] = f2bf(gelu_tanh(y.y)); dst[1024] = f2bf(gelu_tanh(y.z)); dst[1536] = f2bf(gelu_tanh(y.w));
    }
  }
  if (MODE == 0) {
    if (q4 == 0) {
      float* Eb = E + ((size_t)(s * 32 + g) * 16 + c) * 128;
#pragma unroll
      for (int q = 0; q < 4; ++q) { Eb[q * 16 + pl] = hr[q]; Eb[64 + q * 16 + pl] = hi[q]; }
    }
  } else if (MODE == 1) {
    if (c == 15 && q4 == 0) {
#pragma unroll
      for (int q = 0; q < 4; ++q) {
        p.out[O_HRP + ((size_t)s * 32 + g) * 64 + q * 16 + pl] = hr[q];
        p.out[O_HIP + ((size_t)s * 32 + g) * 64 + q * 16 + pl] = hi[q];
      }
    }
  } else {
    const int b = s * 4 + q4;
#pragma unroll
    for (int q = 0; q < 4; ++q) {
      p.out[O_HRS + ((size_t)b * 32 + g) * 64 + q * 16 + pl] = hr[q];
      p.out[O_HIS + ((size_t)b * 32 + g) * 64 + q * 16 + pl] = hi[q];
    }
  }
}

__device__ __forceinline__ void scan_end_unit(const Params& p, int u, int lane) {
  unsigned char* ws = p.ws;
  const int pl = lane & 15, q4 = lane >> 4;
  const bf16_t* P = (const bf16_t*)(ws + OFF_P);
  const float* AR = (const float*)(ws + OFF_AR); const float* AI = (const float*)(ws + OFF_AI);
  const bf16_t* BB = (const bf16_t*)(ws + OFF_BB);
  float* E = (float*)(ws + OFF_E);
  const int c = u & 15, g = (u >> 4) & 31, s = u >> 9, R0 = s * 2048 + c * 128;
  float ar[4], ai[4], wr_[4], wi_[4], a16r[4], a16i[4];
#pragma unroll
  for (int q = 0; q < 4; ++q) {
    const float r1 = AR[g * 64 + q * 16 + pl], i1 = AI[g * 64 + q * 16 + pl];
    ar[q] = r1; ai[q] = i1;
    const float r2 = r1 * r1 - i1 * i1, i2 = 2.f * r1 * i1;
    const float r4 = r2 * r2 - i2 * i2, i4 = 2.f * r2 * i2;
    const float r8 = r4 * r4 - i4 * i4, i8 = 2.f * r4 * i4;
    const float r12 = r8 * r4 - i8 * i4, i12 = r8 * i4 + i8 * r4;
    a16r[q] = r8 * r8 - i8 * i8; a16i[q] = 2.f * r8 * i8;
    wr_[q] = (q4 == 0) ? r12 : (q4 == 1) ? r8 : (q4 == 2) ? r4 : 1.f;
    wi_[q] = (q4 == 0) ? i12 : (q4 == 1) ? i8 : (q4 == 2) ? i4 : 0.f;
  }
  bf16x4 bb[8];
#pragma unroll
  for (int pt = 0; pt < 8; ++pt) bb[pt] = *(const bf16x4*)(BB + ((size_t)g * 128 + pt * 16 + pl) * 16 + q4 * 4);
  float er[4], ei[4];
#pragma unroll
  for (int q = 0; q < 4; ++q) { er[q] = 0.f; ei[q] = 0.f; }
  const bf16_t* up = P + (size_t)(R0 + pl) * PW + g * 16 + q4 * 4;
  bf16x4 uf_next = *(const bf16x4*)up;
  const f32x4 z4 = f32x4{0.f, 0.f, 0.f, 0.f};
#pragma unroll 2
  for (int tile = 0; tile < 8; ++tile) {
    const bf16x4 uf = uf_next;
    if (tile + 1 < 8) uf_next = *(const bf16x4*)(up + (size_t)(tile + 1) * 16 * PW);
#pragma unroll
    for (int q = 0; q < 4; ++q) {
      const f32x4 xr = __builtin_amdgcn_mfma_f32_16x16x16bf16_1k(uf, bb[q], z4, 0, 0, 0);
      const f32x4 xi = __builtin_amdgcn_mfma_f32_16x16x16bf16_1k(uf, bb[q + 4], z4, 0, 0, 0);
      float tr = xr.x, ti = xi.x, nr_, ni_;
      nr_ = ar[q] * tr - ai[q] * ti + xr.y; ni_ = ar[q] * ti + ai[q] * tr + xi.y; tr = nr_; ti = ni_;
      nr_ = ar[q] * tr - ai[q] * ti + xr.z; ni_ = ar[q] * ti + ai[q] * tr + xi.z; tr = nr_; ti = ni_;
      nr_ = ar[q] * tr - ai[q] * ti + xr.w; ni_ = ar[q] * ti + ai[q] * tr + xi.w; tr = nr_; ti = ni_;
      float sr = wr_[q] * tr - wi_[q] * ti, si = wr_[q] * ti + wi_[q] * tr;
      sr += __shfl_xor(sr, 16); si += __shfl_xor(si, 16);
      sr += __shfl_xor(sr, 32); si += __shfl_xor(si, 32);
      nr_ = a16r[q] * er[q] - a16i[q] * ei[q] + sr; ni_ = a16r[q] * ei[q] + a16i[q] * er[q] + si;
      er[q] = nr_; ei[q] = ni_;
    }
  }
  if (q4 == 0) {
    float* Eb = E + ((size_t)(s * 32 + g) * 16 + c) * 128;
#pragma unroll
    for (int q = 0; q < 4; ++q) { Eb[q * 16 + pl] = er[q]; Eb[64 + q * 16 + pl] = ei[q]; }
  }
}

template <bool LDSRC>
__device__ __forceinline__ void attn_core(const Params& p, const int lane, const char* kptr, const int kstride, const char* vptr, const int vstride,
                                          const int kt0, const int has_prev, const int row_q, const int h_q, const int i_q) {
  unsigned char* ws = p.ws;
  const int pl = lane & 15, q4 = lane >> 4;
  const bf16_t* P = (const bf16_t*)(ws + OFF_P);
  const float sink = p.in[17][h_q];
  const bf16_t* qp = P + (size_t)row_q * PW + 512 + h_q * 64 + q4 * 8;
  const bf16x8 qf0 = *(const bf16x8*)qp, qf1 = *(const bf16x8*)(qp + 32);
  u32x4 vfr[LDSRC ? 1 : 5][4];
  if constexpr (!LDSRC) {
#pragma unroll
    for (int pp = 0; pp < 5; ++pp) {
      int TA = kt0 + 2 * pp, TB = kt0 + ((2 * pp + 1 < 9) ? 2 * pp + 1 : 2 * pp);
      if (!has_prev) { if (TA < 8) TA = 8; if (TB < 8) TB = 8; }
#pragma unroll
      for (int dt = 0; dt < 4; ++dt) {
        const char* vp = vptr + (dt * 16 + pl) * vstride + q4 * 8;
        const u32x2 va = *(const u32x2*)(vp + TA * 32), vb = *(const u32x2*)(vp + TB * 32);
        vfr[pp][dt] = u32x4{va.x, va.y, vb.x, vb.y};
      }
    }
  }
  f32x4 sa[9];
#pragma unroll
  for (int kt = 0; kt < 9; ++kt) {
    int T = kt0 + kt; if (!has_prev && T < 8) T = 8;
    const char* kp = kptr + (T * 16 + pl) * kstride + q4 * 16;
    bf16x8 k0, k1;
    if constexpr (LDSRC) { k0 = *(const LAS bf16x8*)(const LAS char*)kp; k1 = *(const LAS bf16x8*)(const LAS char*)(kp + 64); }
    else { k0 = *(const bf16x8*)kp; k1 = *(const bf16x8*)(kp + 64); }
    f32x4 a = f32x4{0.f, 0.f, 0.f, 0.f};
    a = __builtin_amdgcn_mfma_f32_16x16x32_bf16(k0, qf0, a, 0, 0, 0);
    a = __builtin_amdgcn_mfma_f32_16x16x32_bf16(k1, qf1, a, 0, 0, 0);
    sa[kt] = a;
  }
  const int lo = has_prev ? (i_q + 1) : ((i_q + 1) > 128 ? (i_q + 1) : 128);
  const unsigned span = (unsigned)(i_q + 128 - lo);
  const int dbase = q4 * 4 - lo;
  float mx = -INFINITY;
#pragma unroll
  for (int kt = 0; kt < 9; ++kt) {
#pragma unroll
    for (int r = 0; r < 4; ++r) {
      const int d = (kt0 + kt) * 16 + r + dbase;
      const float v = ((unsigned)d <= span) ? sa[kt][r] : -INFINITY;
      sa[kt][r] = v; mx = fmaxf(mx, v);
    }
  }
  mx = fmaxf(mx, __shfl_xor(mx, 16)); mx = fmaxf(mx, __shfl_xor(mx, 32));
  const float mfin = fmaxf(mx * 0.125f, sink);
  const float cl = 0.125f * 1.4426950408889634f, ml = mfin * 1.4426950408889634f;
  float sum = 0.f;
#pragma unroll
  for (int kt = 0; kt < 9; ++kt) {
#pragma unroll
    for (int r = 0; r < 4; ++r) { const float e = __builtin_amdgcn_exp2f(fmaf(sa[kt][r], cl, -ml)); sa[kt][r] = e; sum += e; }
  }
  sum += __shfl_xor(sum, 16); sum += __shfl_xor(sum, 32);
  const float inv = 1.f / (sum + __builtin_amdgcn_exp2f((sink - mfin) * 1.4426950408889634f));
  f32x4 oa[4];
#pragma unroll
  for (int dt = 0; dt < 4; ++dt) oa[dt] = f32x4{0.f, 0.f, 0.f, 0.f};
#pragma unroll
  for (int pp = 0; pp < 5; ++pp) {
    const int kA = 2 * pp, kB = (2 * pp + 1 < 9) ? 2 * pp + 1 : 2 * pp;
    u32x4 pw;
    pw.x = pk2(sa[kA][0] * inv, sa[kA][1] * inv); pw.y = pk2(sa[kA][2] * inv, sa[kA][3] * inv);
    if (2 * pp + 1 < 9) { pw.z = pk2(sa[kB][0] * inv, sa[kB][1] * inv); pw.w = pk2(sa[kB][2] * inv, sa[kB][3] * inv); }
    else { pw.z = 0u; pw.w = 0u; }
    const bf16x8 pf = __builtin_bit_cast(bf16x8, pw);
    if constexpr (LDSRC) {
      int TA = kt0 + 2 * pp, TB = kt0 + ((2 * pp + 1 < 9) ? 2 * pp + 1 : 2 * pp);
      if (!has_prev) { if (TA < 8) TA = 8; if (TB < 8) TB = 8; }
#pragma unroll
      for (int dt = 0; dt < 4; ++dt) {
        const char* vp = vptr + (dt * 16 + pl) * vstride + q4 * 8;
        const u32x2 va = *(const LAS u32x2*)(const LAS char*)(vp + TA * 32), vb = *(const LAS u32x2*)(const LAS char*)(vp + TB * 32);
        oa[dt] = __builtin_amdgcn_mfma_f32_16x16x32_bf16(__builtin_bit_cast(bf16x8, u32x4{va.x, va.y, vb.x, vb.y}), pf, oa[dt], 0, 0, 0);
      }
    } else {
#pragma unroll
      for (int dt = 0; dt < 4; ++dt) oa[dt] = __builtin_amdgcn_mfma_f32_16x16x32_bf16(__builtin_bit_cast(bf16x8, vfr[pp][dt]), pf, oa[dt], 0, 0, 0);
    }
  }
  bf16_t* O = (bf16_t*)(ws + OFF_O);
#pragma unroll
  for (int dt = 0; dt < 4; ++dt) *(u32x2*)(O + (size_t)row_q * 512 + h_q * 64 + dt * 16 + q4 * 4) = pk4(oa[dt]);
}

__device__ __forceinline__ void attn_sample_unit(const Params& p, int us, int lane) {
  const int pl = lane & 15, kv = us & 1, b = us >> 1, tt = pl >> 2, g = pl & 3;
  const bf16_t* Ks = (const bf16_t*)(p.ws + OFF_KS); const bf16_t* Vts = (const bf16_t*)(p.ws + OFF_VTS);
  attn_core<false>(p, lane, (const char*)(Ks + (size_t)b * 144 * 128 + kv * 64), 256, (const char*)(Vts + (size_t)(b * 2 + kv) * 64 * 144), 288,
                   0, 1, MP + b * 4 + tt, kv * 4 + g, tt);
}

constexpr int ATT_KSTR = 144, ATT_VSTR = 528, ATT_VOFF = 256 * ATT_KSTR;
__device__ __forceinline__ void attn_block_unit(const Params& p, int bu, char* lds, int tid) {
  const int b = bu >> 5, kv = (bu >> 4) & 1, blk = bu & 15, lane = tid & 63, wid = tid >> 6;
  const bf16_t* Kp = (const bf16_t*)(p.ws + OFF_KP); const bf16_t* Vtp = (const bf16_t*)(p.ws + OFF_VTP);
  char* K_l = lds; char* Vt_l = lds + ATT_VOFF;
  u32x4 kr[4], vr[4];
#pragma unroll
  for (int i = 0; i < 4; ++i) {
    const int piece = tid + i * NTHR, key = piece >> 3, c = piece & 7;
    if (blk > 0 || key >= 128) kr[i] = *(const u32x4*)(Kp + ((size_t)b * 2048 + (size_t)(blk - 1) * 128 + key) * 128 + kv * 64 + c * 8);
    const int d = piece >> 5, c2 = piece & 31;
    if (blk > 0 || c2 >= 16) vr[i] = *(const u32x4*)(Vtp + ((size_t)(b * 2 + kv) * 64 + d) * 2048 + (size_t)(blk - 1) * 128 + c2 * 8);
  }
#pragma unroll
  for (int i = 0; i < 4; ++i) {
    const int piece = tid + i * NTHR, key = piece >> 3, c = piece & 7;
    if (blk > 0 || key >= 128) *(u32x4*)(K_l + key * ATT_KSTR + c * 16) = kr[i];
    const int d = piece >> 5, c2 = piece & 31;
    if (blk > 0 || c2 >= 16) *(u32x4*)(Vt_l + d * ATT_VSTR + c2 * 16) = vr[i];
  }
  __syncthreads();
  const int pl = lane & 15;
#pragma unroll 1
  for (int g = 0; g < 4; ++g) {
    asm volatile("" ::: "memory");
    attn_core<true>(p, lane, K_l, ATT_KSTR, Vt_l, ATT_VSTR, wid, blk > 0, b * 2048 + blk * 128 + wid * 16 + pl, kv * 4 + g, wid * 16 + pl);
  }
  __syncthreads();
}

template <int WHICH, int NRW>
__device__ __forceinline__ void ln_rows(const Params& p, const int row0, const int lane, const f32x4 (&gv)[4], const f32x4 (&bv)[4]) {
  bf16_t* X1b = (bf16_t*)(p.ws + OFF_X1B);
  f32x4 v[NRW][4];
#pragma unroll
  for (int h = 0; h < NRW; ++h) {
    const int row = row0 + h;
    if (row < MP) {
      const bf16_t* xr = (const bf16_t*)(p.ws + (WHICH == 1 ? OFF_PRE1 : OFF_PRE2)) + (size_t)row * DM;
#pragma unroll
      for (int j = 0; j < 4; ++j) v[h][j] = unpk4(*(const u32x2*)(xr + j * 256 + lane * 4));
    } else {
      const float* SL = (const float*)(p.ws + (WHICH == 1 ? OFF_SLAB_WO : OFF_SLAB_DN)) + (size_t)(row - MP) * DM;
      constexpr int NS = (WHICH == 1) ? 8 : 11;
#pragma unroll
      for (int j = 0; j < 4; ++j) {
        f32x4 a;
        if (WHICH == 1) a = *(const f32x4*)(p.in[1] + (size_t)(row - MP) * DM + j * 256 + lane * 4) * ALPHA_F;
        else a = unpk4(*(const u32x2*)(X1b + (size_t)row * DM + j * 256 + lane * 4)) * ALPHA_F;
#pragma unroll
        for (int q = 0; q < NS; ++q) a += *(const f32x4*)(SL + (size_t)q * MS * DM + j * 256 + lane * 4);
        v[h][j] = a;
      }
    }
  }
  float s[NRW], s2[NRW];
#pragma unroll
  for (int h = 0; h < NRW; ++h) { s[h] = 0.f;
#pragma unroll
    for (int j = 0; j < 4; ++j) s[h] += (v[h][j].x + v[h][j].y) + (v[h][j].z + v[h][j].w); }
#pragma unroll
  for (int o = 1; o < 64; o <<= 1) {
#pragma unroll
    for (int h = 0; h < NRW; ++h) s[h] += __shfl_xor(s[h], o);
  }
#pragma unroll
  for (int h = 0; h < NRW; ++h) { const float mean = s[h] * (1.f / DM); s2[h] = 0.f;
#pragma unroll
    for (int j = 0; j < 4; ++j) { v[h][j] = v[h][j] - mean; s2[h] += (v[h][j].x * v[h][j].x + v[h][j].y * v[h][j].y) + (v[h][j].z * v[h][j].z + v[h][j].w * v[h][j].w); } }
#pragma unroll
  for (int o = 1; o < 64; o <<= 1) {
#pragma unroll
    for (int h = 0; h < NRW; ++h) s2[h] += __shfl_xor(s2[h], o);
  }
#pragma unroll
  for (int h = 0; h < NRW; ++h) {
    const int row = row0 + h;
    const float rstd = rsqrtf(s2[h] * (1.f / DM) + LN_EPS_F);
#pragma unroll
    for (int j = 0; j < 4; ++j) {
      const f32x4 o = v[h][j] * rstd * gv[j] + bv[j];
      if (WHICH == 1) *(u32x2*)(X1b + (size_t)row * DM + j * 256 + lane * 4) = pk4(o);
      else *(f32x4*)(p.out + (size_t)row * DM + j * 256 + lane * 4) = o;
    }
  }
}
template <int WHICH>
__device__ __forceinline__ void ln_phase(const Params& p) {
  const int lane = threadIdx.x & 63, wid = threadIdx.x >> 6;
  const int gw = blockIdx.x * NWAVE + wid, NGW = gridDim.x * NWAVE;
  const float* gam = p.in[WHICH == 1 ? 20 : 26]; const float* bet = p.in[WHICH == 1 ? 21 : 27];
  f32x4 gv[4], bv[4];
#pragma unroll
  for (int j = 0; j < 4; ++j) { gv[j] = *(const f32x4*)(gam + j * 256 + lane * 4); bv[j] = *(const f32x4*)(bet + j * 256 + lane * 4); }
  for (int rp = gw; rp < MP / 2; rp += NGW) ln_rows<WHICH, 2>(p, rp * 2, lane, gv, bv);
  for (int row = MP + gw; row < MT; row += NGW) ln_rows<WHICH, 1>(p, row, lane, gv, bv);
}

__device__ __forceinline__ void fixup_phase(const Params& p) {
  unsigned char* ws = p.ws;
  const int gt = blockIdx.x * NTHR + threadIdx.x, NGT = gridDim.x * NTHR;
  const float* HA0 = (const float*)(ws + OFF_HA0); const float* HG0 = (const float*)(ws + OFF_HG0); const float* HA1 = (const float*)(ws + OFF_HA1);
  bf16_t* H = (bf16_t*)(ws + OFF_H);
  constexpr int NJ4 = DFF / 4;
  for (int i = gt; i < NRB * 2 * NJ4; i += NGT) {
    const int j4 = i % NJ4, rl = (i / NJ4) & 1, rb = i / (2 * NJ4);
    if ((rb & 31) == 0) continue;
    const int j0 = j4 * 4;
    const f32x4 a0 = *(const f32x4*)(HA0 + ((size_t)rb * 2 + rl) * DFF + j0);
    const f32x4 g = *(const f32x4*)(HG0 + ((size_t)rb * 2 + rl) * DFF + j0);
    const f32x4 pm1 = *(const f32x4*)(HA1 + ((size_t)(rb - 1) * 2 + 1) * DFF + j0);
    const f32x4 pm2 = *(const f32x4*)(HA1 + ((size_t)(rb - 1) * 2 + 0) * DFF + j0);
    f32x4 am1, am2;
    if (rl == 0) { am1 = pm1; am2 = pm2; }
    else { am1 = *(const f32x4*)(HA0 + ((size_t)rb * 2 + 0) * DFF + j0); am2 = pm1; }
    const f32x4 w0 = *(const f32x4*)(p.in[23] + j0), w1 = *(const f32x4*)(p.in[23] + DFF + j0), w2 = *(const f32x4*)(p.in[23] + 2 * DFF + j0);
    const f32x4 cb = *(const f32x4*)(p.in[24] + j0);
    f32x4 h;
    h.x = gelu_tanh(cb.x + w0.x * am2.x + w1.x * am1.x + w2.x * a0.x) * g.x;
    h.y = gelu_tanh(cb.y + w0.y * am2.y + w1.y * am1.y + w2.y * a0.y) * g.y;
    h.z = gelu_tanh(cb.z + w0.z * am2.z + w1.z * am1.z + w2.z * a0.z) * g.z;
    h.w = gelu_tanh(cb.w + w0.w * am2.w + w1.w * am1.w + w2.w * a0.w) * g.w;
    *(u32x2*)(H + ((size_t)rb * 64 + rl) * DFF + j0) = pk4(h);
  }
}

#define XB_TMO      128
#define XB_XCNT(j)  (256  + 64 * (j))
#define XB_XSUB(j)  (1280 + 64 * (j))
#define XB_XGEN(j)  (2304 + 64 * (j))
#define XB_TOP      3328
#define XB_TOPGEN   3392
#define XCD_BAR_WORDS 3456
#define XB_SPIN_CAP (1u << 18)
__device__ __forceinline__ unsigned xb_ld(unsigned* p)              { return __hip_atomic_load(p, __ATOMIC_RELAXED, __HIP_MEMORY_SCOPE_AGENT); }
__device__ __forceinline__ unsigned xb_add(unsigned* p, unsigned v) { return __hip_atomic_fetch_add(p, v, __ATOMIC_RELAXED, __HIP_MEMORY_SCOPE_AGENT); }
__device__ __forceinline__ unsigned xb_xcc_id() { return (unsigned)__builtin_amdgcn_s_getreg((3 << 11) | 20) & 0xFu; }
#define XB_SPIN(cond, bar) do { unsigned _sp = 0; while (cond) { __builtin_amdgcn_s_sleep(1); \
    if ((++_sp & 255u) == 0u) { if (xb_ld(&(bar)[XB_TMO])) break; if (_sp > XB_SPIN_CAP) { atomicAdd(&(bar)[XB_TMO], 1u); break; } } } } while (0)
#define XB_EXIT 64
__device__ unsigned g_xbar[XCD_BAR_WORDS + 64];
struct XcdBarrier { unsigned* bar; unsigned x; volatile LAS unsigned* st; };
__device__ __forceinline__ XcdBarrier xcd_barrier_post(unsigned* bar, volatile LAS unsigned* st) {
    XcdBarrier b; b.bar = bar; b.x = xb_xcc_id(); b.st = st;
    if (threadIdx.x == 0) (void)xb_add(&bar[XB_XCNT(b.x)], 1u);
    return b;
}
__device__ __forceinline__ void xcd_barrier_complete(unsigned* bar, unsigned x, unsigned& nloc, unsigned& nx) {
    const unsigned G = gridDim.x * gridDim.y * gridDim.z;
    unsigned sum, cnt, mine, sp = 0u;
    for (;;) {
        sum = 0u; cnt = 0u; mine = 0u;
#pragma unroll
        for (unsigned j = 0; j < 16; ++j) { const unsigned c = xb_ld(&bar[XB_XCNT(j)]); sum += c; cnt += (c > 0u) ? 1u : 0u; mine = (j == x) ? c : mine; }
        if (sum == G) break;
        __builtin_amdgcn_s_sleep(1);
        if ((++sp & 255u) == 0u) { if (xb_ld(&bar[XB_TMO])) break; if (sp > XB_SPIN_CAP) { atomicAdd(&bar[XB_TMO], 1u); break; } }
    }
    nloc = mine > 0u ? mine : 1u; nx = cnt > 0u ? cnt : 1u;
}
__device__ __forceinline__ void xcd_barrier(const XcdBarrier& b) {
    asm volatile("s_waitcnt vmcnt(0)" ::: "memory");
    __syncthreads();
    if (threadIdx.x == 0) {
        unsigned* bar = b.bar;
        __builtin_amdgcn_s_waitcnt(0);
        unsigned nloc = b.st[0], nx = b.st[1];
        if (nloc == 0u) { xcd_barrier_complete(bar, b.x, nloc, nx); b.st[0] = nloc; b.st[1] = nx; }
        const unsigned old = xb_add(&bar[XB_XSUB(b.x)], 1u);
        const unsigned gen = old / nloc;
        if (old + 1u == (gen + 1u) * nloc) {
            __builtin_amdgcn_fence(__ATOMIC_RELEASE, "agent");
            asm volatile("s_waitcnt vmcnt(0)" ::: "memory");
            const unsigned og = xb_add(&bar[XB_TOP], 1u);
            const unsigned tg = og / nx;
            if (og + 1u == (tg + 1u) * nx) xb_add(&bar[XB_TOPGEN], 1u);
            else XB_SPIN(xb_ld(&bar[XB_TOPGEN]) == tg, bar);
            __builtin_amdgcn_fence(__ATOMIC_ACQUIRE, "agent");
            xb_add(&bar[XB_XGEN(b.x)], 1u);
            asm volatile("s_waitcnt vmcnt(0)" ::: "memory");
        } else {
            XB_SPIN(xb_ld(&bar[XB_XGEN(b.x)]) == gen, bar);
            __builtin_amdgcn_fence(__ATOMIC_ACQUIRE, "agent");
            asm volatile("s_waitcnt vmcnt(0)" ::: "memory");
        }
    }
    __syncthreads();
}
#define GSYNC() xcd_barrier(xb)

__device__ __forceinline__ void sample_merge(const Params& p) {
  unsigned char* ws = p.ws;
  const bf16_t* P = (const bf16_t*)(ws + OFF_P); bf16_t* Mg = (bf16_t*)(ws + OFF_MG);
  const float* SLG = (const float*)(ws + OFF_SLAB_GLU); const float* SLA = (const float*)(ws + OFF_SLAB_ATT);
  for (int i = blockIdx.x * NTHR + threadIdx.x; i < MS * (DM / 4); i += gridDim.x * NTHR) {
    const int r = i >> 8, j = (i & 255) * 4;
    const int tj = j >> 7, jl = j & 127, va = tj * 256 + (jl >> 6) * 128 + ((jl >> 4) & 3) * 32 + (jl & 15);
    f32x4 ya = f32x4{0.f, 0.f, 0.f, 0.f}, yb = ya, at = ya;
#pragma unroll
    for (int q = 0; q < 4; ++q) {
      ya += *(const f32x4*)(SLG + ((size_t)q * MS + r) * 2048 + va);
      yb += *(const f32x4*)(SLG + ((size_t)q * MS + r) * 2048 + va + 16);
      at += *(const f32x4*)(SLA + ((size_t)q * MS + r) * DM + j);
    }
    const size_t row = (size_t)MP + r;
    const f32x4 gs = unpk4(*(const u32x2*)(P + row * PW + 1024 + j)), ga = unpk4(*(const u32x2*)(P + row * PW + 2048 + j));
    f32x4 sv;
    sv.x = gs.x * ya.x * sigmoidf_(yb.x); sv.y = gs.y * ya.y * sigmoidf_(yb.y); sv.z = gs.z * ya.z * sigmoidf_(yb.z); sv.w = gs.w * ya.w * sigmoidf_(yb.w);
    sv = unpk4(pk4(sv));
    sv.x += ga.x * at.x; sv.y += ga.y * at.y; sv.z += ga.z * at.z; sv.w += ga.w * at.w;
    *(u32x2*)(Mg + row * DM + j) = pk4(sv);
  }
}

__global__ void __launch_bounds__(512) fwd_megakernel(Params p) {
  extern __shared__ __attribute__((aligned(16))) char lds[];
  cg::grid_group grid = cg::this_grid();
  volatile LAS unsigned* xst = (volatile LAS unsigned*)(lds + GEMM_LDS);
  if (threadIdx.x == 0) { xst[0] = 0u; xst[1] = 0u; }
  __syncthreads();
  XcdBarrier xb = xcd_barrier_post(g_xbar, xst);
  if (p.ws == nullptr) grid.sync();
  unsigned char* ws = p.ws;
  LAS unsigned char* glds = (LAS unsigned char*)lds;
  const int lane = threadIdx.x & 63, wid = threadIdx.x >> 6;
  const int gw = blockIdx.x * NWAVE + wid, NGW = gridDim.x * NWAVE;

  prep_phase(p, lds);
  GSYNC();
  gemm_phase<EPI_IN>(p, (const bf16_t*)(ws + OFF_B), (const bf16_t*)(ws + OFF_WIN), 1024, DIN, glds);
  GSYNC();
  {
    for (int bu = blockIdx.x; bu < 256; bu += gridDim.x) attn_block_unit(p, bu, lds, threadIdx.x);
    bf16_t* Hs = (bf16_t*)(lds + wid * 4352);
    constexpr int N_S1 = 8 * 32 * 16, N_SS = 32 * 32, N_AT = 256;
#pragma unroll 1
    for (int u = blockIdx.x * 16 + wid; u < 4096; u += ((u & 15) + NWAVE < 15) ? NWAVE : (gridDim.x * 16 - (u & 15) + wid)) {
      asm volatile("" ::: "memory");
      scan_end_unit(p, u, lane);
    }
    for (int i = gw; i < 2 * N_SS; i += NGW) { if ((i & 1) == 0) scan_unit<2>(p, i >> 1, lane, Hs); }
    for (int i = gw; i < 8 * N_AT; i += NGW) { if ((i & 7) == 1) attn_sample_unit(p, i >> 3, lane); }
    asm volatile("s_waitcnt vmcnt(0)" ::: "memory");
    __syncthreads();
#pragma unroll 1
    for (int u = blockIdx.x * 16 + wid; u < 4096; u += ((u & 15) + NWAVE < 16) ? NWAVE : (gridDim.x * 16 - (u & 15) + wid)) {
      asm volatile("" ::: "memory");
      scan_unit<1>(p, u, lane, Hs);
    }
  }
  GSYNC();
  gemm_phase<EPI_GLU>(p, (const bf16_t*)(ws + OFF_GY), (const bf16_t*)(ws + OFF_WGLU), 512, 2048, glds, (const bf16_t*)(ws + OFF_O), (const bf16_t*)(ws + OFF_WATT));
  GSYNC();
  gemm_phase<EPI_ATT>(p, (const bf16_t*)(ws + OFF_O), (const bf16_t*)(ws + OFF_WATT), 512, 1024, glds);
  sample_merge(p);
  GSYNC();
  gemm_phase<EPI_WO>(p, (const bf16_t*)(ws + OFF_MG), (const bf16_t*)(ws + OFF_WO), 1024, 1024, glds);
  GSYNC();
  ln_phase<1>(p);
  GSYNC();
  gemm_phase<EPI_UP>(p, (const bf16_t*)(ws + OFF_X1B), (const bf16_t*)(ws + OFF_WUP), 1024, 5632, glds);
  GSYNC();
  fixup_phase(p);
  GSYNC();
  gemm_phase<EPI_DOWN>(p, (const bf16_t*)(ws + OFF_H), (const bf16_t*)(ws + OFF_WDN), DFF, 1024, glds);
  GSYNC();
  ln_phase<2>(p);
  __syncthreads();
  if (threadIdx.x == 0) {
    unsigned* bar = g_xbar;
    const unsigned old = xb_add(&bar[XB_EXIT], 1u);
    if (old == gridDim.x - 1u) {
#pragma unroll
      for (int j = 0; j < 16; ++j) {
        __hip_atomic_store(&bar[XB_XCNT(j)], 0u, __ATOMIC_RELAXED, __HIP_MEMORY_SCOPE_AGENT);
        __hip_atomic_store(&bar[XB_XSUB(j)], 0u, __ATOMIC_RELAXED, __HIP_MEMORY_SCOPE_AGENT);
        __hip_atomic_store(&bar[XB_XGEN(j)], 0u, __ATOMIC_RELAXED, __HIP_MEMORY_SCOPE_AGENT);
      }
      __hip_atomic_store(&bar[XB_TOP], 0u, __ATOMIC_RELAXED, __HIP_MEMORY_SCOPE_AGENT);
      __hip_atomic_store(&bar[XB_TOPGEN], 0u, __ATOMIC_RELAXED, __HIP_MEMORY_SCOPE_AGENT);
      __hip_atomic_store(&bar[XB_TMO], 0u, __ATOMIC_RELAXED, __HIP_MEMORY_SCOPE_AGENT);
      __hip_atomic_store(&bar[XB_EXIT], 0u, __ATOMIC_RELAXED, __HIP_MEMORY_SCOPE_AGENT);
    }
  }
}

extern "C" void kernel_launch(void* const* d_in, const int* in_sizes, int n_in, void* d_out, int out_size, void* d_ws, size_t ws_size, hipStream_t stream) {
  static int grid_blocks = 0;
  if (grid_blocks == 0) {
    if (n_in != 28 || ws_size < WS_TOTAL) { fprintf(stderr, "kernel_launch: unexpected n_in %d or ws_size %zu (< %zu)\n", n_in, ws_size, (size_t)WS_TOTAL); grid_blocks = -1; return; }
    int dev = 0, cus = 0, per_cu = 0;
    (void)hipGetDevice(&dev);
    (void)hipDeviceGetAttribute(&cus, hipDeviceAttributeMultiprocessorCount, dev);
    (void)hipFuncSetAttribute((const void*)fwd_megakernel, hipFuncAttributeMaxDynamicSharedMemorySize, LDS_BYTES);
    (void)hipOccupancyMaxActiveBlocksPerMultiprocessor(&per_cu, (const void*)fwd_megakernel, NTHR, LDS_BYTES);
    if (per_cu < 1) { fprintf(stderr, "kernel_launch: occupancy query returned %d\n", per_cu); per_cu = 1; }
    if (per_cu > 1) per_cu = 1;
    grid_blocks = cus * per_cu;
    fprintf(stderr, "kernel_launch: cus %d per_cu %d grid %d\n", cus, per_cu, grid_blocks);
  }
  if (grid_blocks < 0) return;
  Params p{};
  for (int i = 0; i < 28; ++i) p.in[i] = (const float*)d_in[i];
  p.out = (float*)d_out; p.ws = (unsigned char*)d_ws;
  void* args[] = {&p};
  hipError_t e = hipLaunchCooperativeKernel((const void*)fwd_megakernel, dim3(grid_blocks), dim3(NTHR), args, LDS_BYTES, stream);
  if (e != hipSuccess) fprintf(stderr, "cooperative launch failed: %s (grid %d)\n", hipGetErrorString(e), grid_blocks);
}
```

```cpp
#include <hip/hip_runtime.h>
#include <hip/hip_cooperative_groups.h>
#include <cstdio>
#include <cstdint>
namespace cg = cooperative_groups;

typedef unsigned short bf16_t;
typedef short bf16x8 __attribute__((ext_vector_type(8)));
typedef short bf16x4 __attribute__((ext_vector_type(4)));
typedef float f32x4 __attribute__((ext_vector_type(4)));
typedef unsigned u32x2 __attribute__((ext_vector_type(2)));
typedef unsigned u32x4 __attribute__((ext_vector_type(4)));

constexpr int MP = 16384, MS = 512, MT = MP + MS;
constexpr int DM = 1024, DIN = 3328, PW = 3072, DFF = 2816;
constexpr int NRB = MP / 64;
constexpr float ALPHA_F = 1.189207115002721f;
constexpr float LN_EPS_F = 1e-5f;

constexpr size_t O_YP = 0, O_YS = 16777216, O_KP = 17301504, O_VP = 17432576, O_KS = 17563648, O_VS = 19660800,
                 O_HRP = 21757952, O_HIP = 21774336, O_HRS = 21790720, O_HIS = 22052864, O_CP = 22315008, O_CS = 22360064;

constexpr size_t OFF_P = 0;
constexpr size_t OFF_H = 0;
constexpr size_t OFF_B = (size_t)MT * PW * 2;
constexpr size_t OFF_GY = OFF_B, OFF_O = OFF_B + (size_t)MT * 512 * 2;
constexpr size_t OFF_C = OFF_B + (size_t)MT * DM * 2;
constexpr size_t OFF_MG = OFF_C;
constexpr size_t OFF_X1B = OFF_C + (size_t)MT * DM * 2;
constexpr size_t OFF_KP = OFF_C + (size_t)MT * DM * 2;
constexpr size_t OFF_VTP = OFF_KP + (size_t)8 * 2048 * 128 * 2;
constexpr size_t OFF_KS = OFF_VTP + (size_t)8 * 2048 * 128 * 2;
constexpr size_t OFF_VTS = OFF_KS + (size_t)128 * 144 * 128 * 2;
constexpr size_t OFF_W = OFF_C + (size_t)MT * DM * 4;
constexpr size_t OFF_WIN = OFF_W;
constexpr size_t OFF_WGLU = OFF_WIN + (size_t)DIN * 1024 * 2;
constexpr size_t OFF_WATT = OFF_WGLU + (size_t)2048 * 512 * 2;
constexpr size_t OFF_WO = OFF_WATT + (size_t)1024 * 512 * 2;
constexpr size_t OFF_WUP = OFF_WO + (size_t)1024 * 1024 * 2;
constexpr size_t OFF_WDN = OFF_WUP + (size_t)5632 * 1024 * 2;
constexpr size_t OFF_SSM = OFF_WDN + (size_t)1024 * DFF * 2;
constexpr size_t OFF_AR = OFF_SSM, OFF_AI = OFF_SSM + 8192, OFF_BB = OFF_SSM + 16384;
constexpr size_t OFF_E = OFF_BB + 131072;
constexpr size_t OFF_HA0 = OFF_E + (size_t)8 * 32 * 16 * 128 * 4;
constexpr size_t OFF_HG0 = OFF_HA0 + (size_t)NRB * 2 * DFF * 4;
constexpr size_t OFF_HA1 = OFF_HG0 + (size_t)NRB * 2 * DFF * 4;
constexpr size_t WS_END = OFF_HA1 + (size_t)NRB * 2 * DFF * 4;
static_assert(OFF_VTS + (size_t)128 * 144 * 128 * 2 <= OFF_W, "KV overlay overflow");
static_assert(WS_END <= (size_t)256 * 1024 * 1024, "workspace too large");

constexpr size_t OFF_BAR = WS_END;
constexpr size_t WS_TOTAL = OFF_BAR + 16384;
static_assert(WS_TOTAL <= (size_t)256 * 1024 * 1024, "workspace too large");
constexpr size_t OFF_SLAB_WO = OFF_P;
constexpr size_t OFF_SLAB_DN = OFF_B;
static_assert((size_t)11 * MS * DM * 4 <= (size_t)MT * DM * 2, "down slabs must fit the X1b region");
constexpr size_t OFF_SLAB_GLU = OFF_KP;
constexpr size_t OFF_SLAB_ATT = OFF_KP + (size_t)4 * MS * 2048 * 4;
static_assert(OFF_SLAB_ATT + (size_t)4 * MS * DM * 4 <= OFF_W, "GLU/attn slabs must fit the dead K/V + x1 region");
constexpr size_t OFF_PRE1 = OFF_B;
constexpr size_t OFF_PRE2 = OFF_C;
constexpr int GEMM_LDS = 131072;
constexpr int LDS_BYTES = GEMM_LDS + 16;
constexpr int NTHR = 512, NWAVE = 8;

struct Params {
  const float* in[28];
  float* out;
  unsigned char* ws;
};

typedef __bf16 bf16v2_t __attribute__((ext_vector_type(2)));
typedef float f32x2 __attribute__((ext_vector_type(2)));
__device__ __forceinline__ unsigned pk2(float lo, float hi) { f32x2 v = {lo, hi}; bf16v2_t b = __builtin_convertvector(v, bf16v2_t); return __builtin_bit_cast(unsigned, b); }
__device__ __forceinline__ bf16_t f2bf(float x) { return (bf16_t)(pk2(x, 0.f) & 0xffffu); }
__device__ __forceinline__ float bf2f(unsigned v16) { return __uint_as_float(v16 << 16); }
__device__ __forceinline__ float bflo(unsigned w) { return __uint_as_float(w << 16); }
__device__ __forceinline__ float bfhi(unsigned w) { return __uint_as_float(w & 0xffff0000u); }
__device__ __forceinline__ float rcp_nr(float d) { const float r = __builtin_amdgcn_rcpf(d); return fmaf(r, fmaf(-d, r, 1.f), r); }
__device__ __forceinline__ float sigmoidf_(float x) { return rcp_nr(1.f + __expf(fminf(-x, 80.f))); }
__device__ __forceinline__ float gelu_tanh(float x) { float z = 1.5957691216057308f * (x + 0.044715f * x * x * x); return x * rcp_nr(1.f + __expf(fminf(-z, 80.f))); }
__device__ __forceinline__ float wave_sum(float v) {
#pragma unroll
  for (int o = 1; o < 64; o <<= 1) v += __shfl_xor(v, o);
  return v;
}
__device__ __forceinline__ u32x2 pk4(f32x4 v) { u32x2 r; r.x = pk2(v.x, v.y); r.y = pk2(v.z, v.w); return r; }
__device__ __forceinline__ f32x4 unpk4(u32x2 w) { f32x4 r; r.x = bflo(w.x); r.y = bfhi(w.x); r.z = bflo(w.y); r.w = bfhi(w.y); return r; }


#define LAS __attribute__((address_space(3)))
namespace pg8 {
constexpr int BM = 256, BK = 64, HALF = 128, HTB = HALF * BK * 2, NXCD = 8, WGM = 8;
__device__ __forceinline__ int lds_byte(int r, int c) { const int st = (r >> 4) * 2 + (c >> 5), rr = r & 15, cc = c & 31, ob = rr * 64 + cc * 2; return st * 1024 + (ob ^ (((ob >> 9) & 1) << 5)); }
__device__ __forceinline__ void stage_rc(int b, int& R, int& C) { const int st = b / 1024, sb = b % 1024, swz = sb ^ (((sb >> 9) & 1) << 5); R = (st >> 1) * 16 + swz / 64; C = (st & 1) * 32 + (swz % 64) / 2; }
struct Unit { int pm, pn, k0, nk, slice; };
struct StaticOrder {
    int nM, nN, nwg, G, c;
    __device__ __forceinline__ void init(int M, int N, int G_, int c_) { nM = M / BM; nN = N / BM; nwg = nM * nN; G = G_; c = c_; }
    int nsplit, nslice_items, nt, glu;
    __device__ __forceinline__ bool next(int i, int& pm, int& pn, int& k0, int& nk, int& slice, int& src) const {
        const long L = (long)i * G + c;
        pm = 0; pn = 0; k0 = 0; nk = nt; slice = -1; src = 0;
        if (L < nwg) {
            int wgid = (int)L; { const int q = nwg / NXCD, r = nwg % NXCD, xcd = wgid % NXCD, off = wgid / NXCD; wgid = (xcd < r ? xcd * (q + 1) : r * (q + 1) + (xcd - r) * q) + off; }
            const int nig = WGM * nN, gid = wgid / nig, fm = gid * WGM, gsz = (nM - fm) < WGM ? (nM - fm) : WGM;
            pm = fm + ((wgid % nig) % gsz); pn = (wgid % nig) / gsz; return true;
        }
        if (nsplit == 0) return false;
        int sidx = (int)(L - nwg);
        if (sidx >= nslice_items) return false;
        int ncol = nN;
        if (glu && sidx >= 64) { sidx -= 64; src = 1; ncol = 4; }
        const int tl = sidx / nsplit; slice = sidx - tl * nsplit; pm = 64 + tl / ncol; pn = tl % ncol; nk = nt / nsplit; k0 = slice * nk; return true;
    }
};
}

enum { EPI_IN = 0, EPI_GLU = 1, EPI_ATT = 2, EPI_WO = 3, EPI_UP = 4, EPI_DOWN = 5 };

__device__ __forceinline__ float dpp_ror1(float v) { return __int_as_float(__builtin_amdgcn_update_dpp(0, __float_as_int(v), 0x121, 0xf, 0xf, false)); }
__device__ __forceinline__ float dpp_ror2(float v) { return __int_as_float(__builtin_amdgcn_update_dpp(0, __float_as_int(v), 0x122, 0xf, 0xf, false)); }
__device__ __forceinline__ float dpp_shr1_old(float old, float v) { return __int_as_float(__builtin_amdgcn_update_dpp(__float_as_int(old), __float_as_int(v), 0x111, 0xf, 0xf, false)); }
__device__ __forceinline__ float dpp_shr2_old(float old, float v) { return __int_as_float(__builtin_amdgcn_update_dpp(__float_as_int(old), __float_as_int(v), 0x112, 0xf, 0xf, false)); }
__device__ __forceinline__ f32x4 shr1v(f32x4 o, f32x4 v) { return f32x4{dpp_shr1_old(o.x, v.x), dpp_shr1_old(o.y, v.y), dpp_shr1_old(o.z, v.z), dpp_shr1_old(o.w, v.w)}; }
__device__ __forceinline__ f32x4 shr2v(f32x4 o, f32x4 v) { return f32x4{dpp_shr2_old(o.x, v.x), dpp_shr2_old(o.y, v.y), dpp_shr2_old(o.z, v.z), dpp_shr2_old(o.w, v.w)}; }
__device__ __forceinline__ f32x4 ror1v(f32x4 v) { return f32x4{dpp_ror1(v.x), dpp_ror1(v.y), dpp_ror1(v.z), dpp_ror1(v.w)}; }
__device__ __forceinline__ f32x4 ror2v(f32x4 v) { return f32x4{dpp_ror2(v.x), dpp_ror2(v.y), dpp_ror2(v.z), dpp_ror2(v.w)}; }

template <int EPI>
__device__ __forceinline__ void epilogue(const Params& p, f32x4 (&acc)[2][2][4][2], const int pm, const int pn, const int wr, const int wc, const int fr, const int fq) {
  unsigned char* ws = p.ws;
  bf16_t* P = (bf16_t*)(ws + OFF_P);
  if constexpr (EPI == EPI_IN) {
    bf16_t* Kp = (bf16_t*)(ws + OFF_KP); bf16_t* Ks = (bf16_t*)(ws + OFF_KS);
    bf16_t* Vtp = (bf16_t*)(ws + OFF_VTP); bf16_t* Vts = (bf16_t*)(ws + OFF_VTS);
#pragma unroll
    for (int bj = 0; bj < 2; ++bj) {
      const int col0 = pn * 256 + bj * 128;
#pragma unroll
      for (int ai = 0; ai < 2; ++ai)
#pragma unroll
        for (int m = 0; m < 4; ++m) {
          const int row = pm * 256 + ai * 128 + wr * 64 + m * 16 + fr;
#pragma unroll
          for (int n = 0; n < 2; ++n) {
            const int col = col0 + wc * 32 + n * 16 + fq * 4;
            f32x4 v = acc[ai][bj][m][n];
            if (col0 < 1024) {
              *(u32x2*)(P + (size_t)row * PW + col) = pk4(v);
            } else if (col0 >= 1280) {
              v.x = sigmoidf_(v.x); v.y = sigmoidf_(v.y); v.z = sigmoidf_(v.z); v.w = sigmoidf_(v.w);
              *(u32x2*)(P + (size_t)row * PW + col - 256) = pk4(v);
            } else if (col0 == 1024) {
              const int cc = col - 1024;
              if (row < MP) {
                *(u32x2*)(Kp + (size_t)row * 128 + cc) = pk4(v);
                const int pos = row & 2047;
                if (pos >= 1920) *(f32x4*)(p.out + O_KP + ((size_t)(row >> 11) * 128 + (pos - 1920)) * 128 + cc) = v;
              } else {
                const int s = row - MP, b = s >> 2, tt = s & 3;
                *(u32x2*)(Ks + ((size_t)b * 144 + 128 + tt) * 128 + cc) = pk4(v);
                *(f32x4*)(p.out + O_KS + ((size_t)b * 128 + 124 + tt) * 128 + cc) = v;
              }
            } else {
              const int cc = col - 1152, kv = cc >> 6, d = cc & 63;
              if (row < MP) {
                const int b = row >> 11, pos = row & 2047;
                bf16_t* dst = Vtp + ((size_t)(b * 2 + kv) * 64 + d) * 2048 + pos;
                dst[0] = f2bf(v.x); dst[2048] = f2bf(v.y); dst[4096] = f2bf(v.z); dst[6144] = f2bf(v.w);
                if (pos >= 1920) *(f32x4*)(p.out + O_VP + ((size_t)b * 128 + (pos - 1920)) * 128 + cc) = v;
              } else {
                const int s = row - MP, b = s >> 2, tt = s & 3;
                bf16_t* dst = Vts + ((size_t)(b * 2 + kv) * 64 + d) * 144 + 128 + tt;
                dst[0] = f2bf(v.x); dst[144] = f2bf(v.y); dst[288] = f2bf(v.z); dst[432] = f2bf(v.w);
                *(f32x4*)(p.out + O_VS + ((size_t)b * 128 + 124 + tt) * 128 + cc) = v;
              }
            }
          }
        }
    }
  } else if constexpr (EPI == EPI_GLU) {
    bf16_t* Mg = (bf16_t*)(ws + OFF_MG);
#pragma unroll
    for (int ai = 0; ai < 2; ++ai)
#pragma unroll
      for (int m = 0; m < 4; ++m) {
        const int row = pm * 256 + ai * 128 + wr * 64 + m * 16 + fr;
#pragma unroll
        for (int bj = 0; bj < 2; ++bj) {
          const int j0 = pn * 128 + bj * 64 + wc * 16 + fq * 4;
          const f32x4 ya = acc[ai][bj][m][0], yb = acc[ai][bj][m][1];
          const f32x4 gs = unpk4(*(const u32x2*)(P + (size_t)row * PW + 1024 + j0));
          f32x4 sv;
          sv.x = gs.x * ya.x * sigmoidf_(yb.x); sv.y = gs.y * ya.y * sigmoidf_(yb.y);
          sv.z = gs.z * ya.z * sigmoidf_(yb.z); sv.w = gs.w * ya.w * sigmoidf_(yb.w);
          *(u32x2*)(Mg + (size_t)row * DM + j0) = pk4(sv);
        }
      }
  } else if constexpr (EPI == EPI_ATT) {
    bf16_t* Mg = (bf16_t*)(ws + OFF_MG);
#pragma unroll
    for (int ai = 0; ai < 2; ++ai)
#pragma unroll
      for (int m = 0; m < 4; ++m) {
        const int row = pm * 256 + ai * 128 + wr * 64 + m * 16 + fr;
#pragma unroll
        for (int bj = 0; bj < 2; ++bj)
#pragma unroll
          for (int n = 0; n < 2; ++n) {
            const int col = pn * 256 + bj * 128 + wc * 32 + n * 16 + fq * 4;
            const f32x4 ga = unpk4(*(const u32x2*)(P + (size_t)row * PW + 2048 + col));
            const f32x4 sv = unpk4(*(const u32x2*)(Mg + (size_t)row * DM + col));
            f32x4 v = acc[ai][bj][m][n];
            v.x = sv.x + ga.x * v.x; v.y = sv.y + ga.y * v.y; v.z = sv.z + ga.z * v.z; v.w = sv.w + ga.w * v.w;
            *(u32x2*)(Mg + (size_t)row * DM + col) = pk4(v);
          }
      }
  } else if constexpr (EPI == EPI_WO || EPI == EPI_DOWN) {
    const bf16_t* X1b = (const bf16_t*)(ws + OFF_X1B);
#pragma unroll
    for (int ai = 0; ai < 2; ++ai)
#pragma unroll
      for (int m = 0; m < 4; ++m) {
        const int row = pm * 256 + ai * 128 + wr * 64 + m * 16 + fr;
#pragma unroll
        for (int bj = 0; bj < 2; ++bj)
#pragma unroll
          for (int n = 0; n < 2; ++n) {
            const int col = pn * 256 + bj * 128 + wc * 32 + n * 16 + fq * 4;
            f32x4 x;
            if constexpr (EPI == EPI_WO) x = *(const f32x4*)(p.in[0] + (size_t)row * DM + col);
            else x = unpk4(*(const u32x2*)(X1b + (size_t)row * DM + col));
            f32x4 v = acc[ai][bj][m][n];
            v.x += ALPHA_F * x.x; v.y += ALPHA_F * x.y; v.z += ALPHA_F * x.z; v.w += ALPHA_F * x.w;
            *(u32x2*)((bf16_t*)(ws + (EPI == EPI_WO ? OFF_PRE1 : OFF_PRE2)) + (size_t)row * DM + col) = pk4(v);
          }
      }
  } else {
    bf16_t* H = (bf16_t*)(ws + OFF_H);
    float* HA0 = (float*)(ws + OFF_HA0); float* HG0 = (float*)(ws + OFF_HG0); float* HA1 = (float*)(ws + OFF_HA1);
    const bool prompt = (pm < MP / 256);
#pragma unroll
    for (int bj = 0; bj < 2; ++bj) {
      const int j0 = pn * 128 + bj * 64 + wc * 16 + fq * 4;
      const f32x4 w0 = *(const f32x4*)(p.in[23] + j0), w1 = *(const f32x4*)(p.in[23] + DFF + j0), w2 = *(const f32x4*)(p.in[23] + 2 * DFF + j0);
      const f32x4 cb = *(const f32x4*)(p.in[24] + j0);
#pragma unroll
      for (int ai = 0; ai < 2; ++ai) {
        const int rblk = pm * 256 + ai * 128 + wr * 64;
#pragma unroll
        for (int m = 0; m < 4; ++m) {
          const int row = rblk + m * 16 + fr;
          const f32x4 a0 = acc[ai][bj][m][0], g = acc[ai][bj][m][1];
          f32x4 am1, am2; bool defer = false;
          if (prompt) {
            f32x4 o1 = f32x4{0.f, 0.f, 0.f, 0.f}, o2 = o1;
            if (m > 0) { o1 = ror1v(acc[ai][bj][m > 0 ? m - 1 : 0][0]); o2 = ror2v(acc[ai][bj][m > 0 ? m - 1 : 0][0]); }
            am1 = shr1v(o1, a0); am2 = shr2v(o2, a0);
            if (m == 0 && fr < 2 && (row & 2047) >= 2) defer = true;
            if (m == 3 && fr >= 14) *(f32x4*)(HA1 + ((size_t)(rblk >> 6) * 2 + (fr - 14)) * DFF + j0) = a0;
            const int pos = row & 2047;
            if (pos >= 2046) *(f32x4*)(p.out + O_CP + ((size_t)(row >> 11) * 2 + (pos - 2046)) * DFF + j0) = a0;
          } else {
            const int sidx = row - MP, b = sidx >> 2, tt = sidx & 3;
            const f32x4 st0 = *(const f32x4*)(p.in[6] + ((size_t)b * 2 + 0) * DFF + j0);
            const f32x4 st1 = *(const f32x4*)(p.in[6] + ((size_t)b * 2 + 1) * DFF + j0);
            const f32x4 s1 = ror1v(a0), s2 = ror2v(a0);
            am1 = (tt >= 1) ? s1 : st1;
            am2 = (tt >= 2) ? s2 : ((tt == 1) ? st1 : st0);
            if (tt >= 2) *(f32x4*)(p.out + O_CS + ((size_t)b * 2 + (tt - 2)) * DFF + j0) = a0;
          }
          if (!defer) {
            f32x4 h;
            h.x = gelu_tanh(cb.x + w0.x * am2.x + w1.x * am1.x + w2.x * a0.x) * g.x;
            h.y = gelu_tanh(cb.y + w0.y * am2.y + w1.y * am1.y + w2.y * a0.y) * g.y;
            h.z = gelu_tanh(cb.z + w0.z * am2.z + w1.z * am1.z + w2.z * a0.z) * g.z;
            h.w = gelu_tanh(cb.w + w0.w * am2.w + w1.w * am1.w + w2.w * a0.w) * g.w;
            *(u32x2*)(H + (size_t)row * DFF + j0) = pk4(h);
          } else {
            *(f32x4*)(HA0 + ((size_t)(rblk >> 6) * 2 + fr) * DFF + j0) = a0;
            *(f32x4*)(HG0 + ((size_t)(rblk >> 6) * 2 + fr) * DFF + j0) = g;
          }
        }
      }
    }
  }
}

template <int EPI>
__device__ __forceinline__ void gemm_phase(const Params& p, const bf16_t* __restrict__ gA, const bf16_t* __restrict__ gBt, const int K, const int N, LAS unsigned char* lds,
                                           const bf16_t* __restrict__ gA2 = nullptr, const bf16_t* __restrict__ gBt2 = nullptr) {
    using namespace pg8;
    int tid_ = threadIdx.x; asm volatile("" : "+v"(tid_));
    const int tid = tid_, wid = __builtin_amdgcn_readfirstlane(tid >> 6), lane = tid & 63, wr = wid >> 2, wc = wid & 3, fr = lane & 15, fq = lane >> 4;
    const int nt = K / BK;
    constexpr bool SPLIT = (EPI == EPI_WO || EPI == EPI_DOWN || EPI == EPI_GLU);
    constexpr bool PROMPT_ONLY = SPLIT || (EPI == EPI_ATT);
    constexpr int NSPLIT = (EPI == EPI_WO) ? 8 : (EPI == EPI_DOWN ? 11 : 4);
    StaticOrder S; S.init(PROMPT_ONLY ? MP : MT, N, gridDim.x, blockIdx.x);
    const int nN_ = N / BM;
    S.nt = nt; S.nsplit = SPLIT ? NSPLIT : 0; S.glu = (EPI == EPI_GLU) ? 1 : 0;
    S.nslice_items = (EPI == EPI_GLU) ? 96 : 2 * nN_ * NSPLIT;
    unsigned voff[2];
#pragma unroll
    for (int i = 0; i < 2; ++i) { int R, C; stage_rc(tid * 16 + i * 8192, R, C); voff[i] = (unsigned)(R * K + C) * 2u; }
    const size_t kstep = (size_t)(BK * 2);
    const size_t hstep = (size_t)HALF * K * 2;
    const size_t tstep = 2 * hstep;
    const unsigned ldsw = (unsigned)wid * 1024u;
    const int aoff = lds_byte(wr * 64 + fr, fq * 8), boff = lds_byte(wc * 32 + fr, fq * 8);
#define PG8_SA(b, h) (((b) * 2 + (h)) * HTB)
#define PG8_SB(b, h) ((4 + (b) * 2 + (h)) * HTB)
#define PG8_STAGE(bufoff, gbase) do { _Pragma("unroll") for (int _i = 0; _i < 2; ++_i) \
        __builtin_amdgcn_global_load_lds((const unsigned*)((const char*)(gbase) + voff[_i]), (LAS unsigned*)(lds + (bufoff) + ldsw + _i * 8192), 16, 0, 0); } while (0)
#define PG8_LDA(dst, b, h) do { _Pragma("unroll") for (int m = 0; m < 4; ++m) _Pragma("unroll") for (int k = 0; k < 2; ++k) dst[m][k] = *(const LAS bf16x8*)(lds + PG8_SA(b, h) + aoff + m * 2048 + k * 1024); } while (0)
#define PG8_LDB(dst, b, h) do { _Pragma("unroll") for (int n = 0; n < 2; ++n) _Pragma("unroll") for (int k = 0; k < 2; ++k) dst[n][k] = *(const LAS bf16x8*)(lds + PG8_SB(b, h) + boff + n * 2048 + k * 1024); } while (0)
#define PG8_MMA(ai, bj, At, Bt) do { __builtin_amdgcn_s_setprio(1); _Pragma("unroll") for (int m = 0; m < 4; ++m) _Pragma("unroll") for (int n = 0; n < 2; ++n) _Pragma("unroll") for (int k = 0; k < 2; ++k) \
        acc[ai][bj][m][n] = __builtin_amdgcn_mfma_f32_16x16x32_bf16(Bt[n][k], At[m][k], acc[ai][bj][m][n], 0, 0, 0); __builtin_amdgcn_s_setprio(0); } while (0)
#define PG8_WAIT_V(n) asm volatile("s_waitcnt vmcnt(" #n ")" ::: "memory")
#define PG8_WAIT_L(n) asm volatile("s_waitcnt lgkmcnt(" #n ")" ::: "memory")
#define PG8_BAR __builtin_amdgcn_s_barrier()
#define PG8_SCHED __builtin_amdgcn_sched_barrier(0)
    int ui = 0, cur_pm, cur_pn, cur_k0, cur_nk, cur_slice, cur_src, nxt_pm, nxt_pn, nxt_k0, nxt_nk, nxt_slice, nxt_src;
    if (!S.next(0, cur_pm, cur_pn, cur_k0, cur_nk, cur_slice, cur_src)) return;
    f32x4 acc[2][2][4][2];
#pragma unroll
    for (int a = 0; a < 2; ++a)
#pragma unroll
        for (int b = 0; b < 2; ++b)
#pragma unroll
            for (int m = 0; m < 4; ++m)
#pragma unroll
                for (int n = 0; n < 2; ++n) acc[a][b][m][n] = (f32x4){0.f, 0.f, 0.f, 0.f};
    bf16x8 At[4][2], B0[2][2], B1[2][2];
    const char* cA = (const char*)((EPI == EPI_GLU && cur_src) ? gA2 : gA) + (size_t)cur_pm * tstep + (size_t)cur_k0 * kstep;
    const char* cB = (const char*)((EPI == EPI_GLU && cur_src) ? gBt2 : gBt) + (size_t)cur_pn * tstep + (size_t)cur_k0 * kstep;
    PG8_STAGE(PG8_SB(0, 0), cB); PG8_STAGE(PG8_SB(0, 1), cB + hstep); PG8_STAGE(PG8_SA(0, 0), cA); PG8_STAGE(PG8_SA(0, 1), cA + hstep);
    if (wr == 1) PG8_BAR;
    PG8_WAIT_V(2); PG8_BAR;
    PG8_STAGE(PG8_SB(1, 0), cB + kstep); PG8_STAGE(PG8_SA(1, 0), cA + kstep); PG8_STAGE(PG8_SB(1, 1), cB + hstep + kstep);
    PG8_WAIT_V(6); PG8_BAR;
    for (;;) {
        const bool has_next = S.next(ui + 1, nxt_pm, nxt_pn, nxt_k0, nxt_nk, nxt_slice, nxt_src);
        const char* nA = has_next ? (const char*)((EPI == EPI_GLU && nxt_src) ? gA2 : gA) + (size_t)nxt_pm * tstep + (size_t)nxt_k0 * kstep : cA;
        const char* nB = has_next ? (const char*)((EPI == EPI_GLU && nxt_src) ? gBt2 : gBt) + (size_t)nxt_pn * tstep + (size_t)nxt_k0 * kstep : cB;
        const int cnk = cur_nk;
        for (int t = 0; t < cnk; t += 2) {
            const bool last = (t == cnk - 2);
            const char* a1 = cA + (size_t)(t + 1) * kstep;
            const char* a2 = last ? nA : cA + (size_t)(t + 2) * kstep; const char* b2 = last ? nB : cB + (size_t)(t + 2) * kstep;
            const char* a3 = a2 + kstep; const char* b3 = b2 + kstep;
            PG8_LDB(B0, 0, 0); PG8_LDB(B1, 0, 1); PG8_SCHED; PG8_LDA(At, 0, 0); PG8_STAGE(PG8_SA(1, 1), a1 + hstep);
            PG8_WAIT_V(8); PG8_WAIT_L(0); PG8_BAR; PG8_MMA(0, 0, At, B0); PG8_MMA(0, 1, At, B1); PG8_BAR; PG8_SCHED;
            PG8_LDA(At, 0, 1); PG8_STAGE(PG8_SB(0, 0), b2); PG8_STAGE(PG8_SB(0, 1), b2 + hstep); PG8_STAGE(PG8_SA(0, 0), a2);
            PG8_WAIT_V(8); PG8_WAIT_L(0); PG8_BAR; PG8_MMA(1, 0, At, B0); PG8_MMA(1, 1, At, B1); PG8_BAR; PG8_SCHED;
            PG8_LDB(B0, 1, 0); PG8_LDB(B1, 1, 1); PG8_SCHED; PG8_LDA(At, 1, 0); PG8_STAGE(PG8_SA(0, 1), a2 + hstep);
            PG8_WAIT_V(8); PG8_WAIT_L(0); PG8_BAR; PG8_MMA(0, 0, At, B0); PG8_MMA(0, 1, At, B1); PG8_BAR; PG8_SCHED;
            PG8_LDA(At, 1, 1); PG8_STAGE(PG8_SB(1, 0), b3); PG8_STAGE(PG8_SB(1, 1), b3 + hstep); PG8_STAGE(PG8_SA(1, 0), a3);
            PG8_WAIT_V(8); PG8_WAIT_L(0); PG8_BAR; PG8_MMA(1, 0, At, B0); PG8_MMA(1, 1, At, B1); PG8_BAR; PG8_SCHED;
        }
        if (wr == 0) PG8_BAR;
        if (SPLIT && cur_slice >= 0) {
            const int ldc = (EPI == EPI_GLU && cur_src == 0) ? 2048 : DM;
            float* SL = (float*)(p.ws + (EPI == EPI_WO ? OFF_SLAB_WO : (EPI == EPI_DOWN ? OFF_SLAB_DN : (cur_src ? OFF_SLAB_ATT : OFF_SLAB_GLU)))) + (size_t)cur_slice * MS * ldc;
#pragma unroll
            for (int ai = 0; ai < 2; ++ai)
#pragma unroll
                for (int m = 0; m < 4; ++m) {
                    const int rs = (cur_pm - 64) * 256 + ai * 128 + wr * 64 + m * 16 + fr;
#pragma unroll
                    for (int bj = 0; bj < 2; ++bj)
#pragma unroll
                        for (int n = 0; n < 2; ++n) *(f32x4*)(SL + (size_t)rs * ldc + cur_pn * 256 + bj * 128 + wc * 32 + n * 16 + fq * 4) = acc[ai][bj][m][n];
                }
        } else epilogue<EPI>(p, acc, cur_pm, cur_pn, wr, wc, fr, fq);
        if (!has_next) break;
#pragma unroll
        for (int a = 0; a < 2; ++a)
#pragma unroll
            for (int b = 0; b < 2; ++b)
#pragma unroll
                for (int m = 0; m < 4; ++m)
#pragma unroll
                    for (int n = 0; n < 2; ++n) acc[a][b][m][n] = (f32x4){0.f, 0.f, 0.f, 0.f};
        cur_pm = nxt_pm; cur_pn = nxt_pn; cur_k0 = nxt_k0; cur_nk = nxt_nk; cur_slice = nxt_slice; cur_src = nxt_src; cA = nA; cB = nB; ++ui;
        if (wr == 1) PG8_BAR;
    }
    PG8_WAIT_V(0);
    PG8_BAR;
#undef PG8_SA
#undef PG8_SB
#undef PG8_STAGE
#undef PG8_LDA
#undef PG8_LDB
#undef PG8_MMA
#undef PG8_WAIT_V
#undef PG8_WAIT_L
#undef PG8_BAR
#undef PG8_SCHED
}

template <int MODE>
__device__ __forceinline__ int dest_row(int n, int HH) {
  if (MODE == 0) return n;
  const int part = n >= HH ? 1 : 0, j = n - part * HH;
  const int tj = j >> 7, jl = j & 127, bj = jl >> 6, wcj = (jl >> 4) & 3, w = jl & 15;
  return tj * 256 + bj * 128 + wcj * 32 + part * 16 + w;
}
template <int MODE>
__device__ __forceinline__ void transpose_item(const float* __restrict__ W, int K, int N, bf16_t* __restrict__ WT, int HH, float* scr, int item, int lane) {
  const int nblk = N / 32, kb = item / nblk, nb = item - kb * nblk, k0 = 32 * kb, n0 = 32 * nb;
#pragma unroll 8
  for (int i = 0; i < 16; ++i) { const int kk = 2 * i + (lane >> 5); scr[kk * 33 + (lane & 31)] = W[(size_t)(k0 + kk) * N + n0 + (lane & 31)]; }
  asm volatile("s_waitcnt lgkmcnt(0)" ::: "memory");
  const int c = lane & 3;
#pragma unroll
  for (int j = 0; j < 2; ++j) {
    const int n = (lane >> 2) + 16 * j; const float* sp = scr + (8 * c) * 33 + n;
    u32x4 o; o.x = pk2(sp[0], sp[33]); o.y = pk2(sp[66], sp[99]); o.z = pk2(sp[132], sp[165]); o.w = pk2(sp[198], sp[231]);
    *(u32x4*)(WT + (size_t)dest_row<MODE>(n0 + n, HH) * K + k0 + 8 * c) = o;
  }
  asm volatile("s_waitcnt lgkmcnt(0)" ::: "memory");
}

__device__ __forceinline__ void prep_phase(const Params& p, char* lds) {
  unsigned char* ws = p.ws;
  const int tid = threadIdx.x, lane = tid & 63, wid = tid >> 6;
  const int gt = blockIdx.x * NTHR + tid, NGT = gridDim.x * NTHR;
  const int gw = blockIdx.x * NWAVE + wid, NGW = gridDim.x * NWAVE;
  {
    bf16_t* Xb = (bf16_t*)(ws + OFF_B);
    const int nchunk = MT * DM / 8, npc = MP * DM / 8;
    const int nmain = (nchunk / (4 * NGT)) * (4 * NGT);
    for (int i0 = gt; i0 < nmain / 4; i0 += NGT) {
      f32x4 a[4], b[4];
#pragma unroll
      for (int q = 0; q < 4; ++q) {
        const int i = i0 + q * (nmain / 4);
        const float* sp = (i < npc) ? p.in[0] + (size_t)i * 8 : p.in[1] + (size_t)(i - npc) * 8;
        a[q] = *(const f32x4*)sp; b[q] = *(const f32x4*)(sp + 4);
      }
#pragma unroll
      for (int q = 0; q < 4; ++q) {
        const int i = i0 + q * (nmain / 4);
        u32x4 o; o.x = pk2(a[q].x, a[q].y); o.y = pk2(a[q].z, a[q].w); o.z = pk2(b[q].x, b[q].y); o.w = pk2(b[q].z, b[q].w);
        *(u32x4*)(Xb + (size_t)i * 8) = o;
      }
    }
    for (int i = nmain + gt; i < nchunk; i += NGT) {
      const float* sp = (i < npc) ? p.in[0] + (size_t)i * 8 : p.in[1] + (size_t)(i - npc) * 8;
      const f32x4 a = *(const f32x4*)sp, b = *(const f32x4*)(sp + 4);
      u32x4 o; o.x = pk2(a.x, a.y); o.y = pk2(a.z, a.w); o.z = pk2(b.x, b.y); o.w = pk2(b.z, b.w);
      *(u32x4*)(Xb + (size_t)i * 8) = o;
    }
  }
  {
    float* scr = (float*)(lds + wid * 8704);
    constexpr int I_IN = 32 * 104, I_GLU = 16 * 64, I_ATT = 16 * 32, I_O = 32 * 32, I_UP = 32 * 176, I_DN = 88 * 32;
    constexpr int NIT = I_IN + I_GLU + I_ATT + I_O + I_UP + I_DN;
    for (int it = gw; it < NIT; it += NGW) {
      int r = it;
      if (r < I_IN) { transpose_item<0>(p.in[7], 1024, DIN, (bf16_t*)(ws + OFF_WIN), 0, scr, r, lane); continue; } r -= I_IN;
      if (r < I_GLU) { transpose_item<1>(p.in[16], 512, 2048, (bf16_t*)(ws + OFF_WGLU), 1024, scr, r, lane); continue; } r -= I_GLU;
      if (r < I_ATT) { transpose_item<0>(p.in[18], 512, 1024, (bf16_t*)(ws + OFF_WATT), 0, scr, r, lane); continue; } r -= I_ATT;
      if (r < I_O) { transpose_item<0>(p.in[19], 1024, 1024, (bf16_t*)(ws + OFF_WO), 0, scr, r, lane); continue; } r -= I_O;
      if (r < I_UP) { transpose_item<1>(p.in[22], 1024, 5632, (bf16_t*)(ws + OFF_WUP), DFF, scr, r, lane); continue; } r -= I_UP;
      transpose_item<0>(p.in[25], DFF, 1024, (bf16_t*)(ws + OFF_WDN), 0, scr, r, lane);
    }
  }
  {
    bf16_t* Ks = (bf16_t*)(ws + OFF_KS); bf16_t* Vts = (bf16_t*)(ws + OFF_VTS);
    const float* ck = p.in[2]; const float* cv = p.in[3];
    for (int i = gt; i < 128 * 128 * 16; i += NGT) {
      const int c8 = i & 15, w = (i >> 4) & 127, b = i >> 11;
      const float* s = ck + ((size_t)b * 128 + w) * 128 + c8 * 8;
      const f32x4 a = *(const f32x4*)s, bq = *(const f32x4*)(s + 4);
      u32x4 o; o.x = pk2(a.x, a.y); o.y = pk2(a.z, a.w); o.z = pk2(bq.x, bq.y); o.w = pk2(bq.z, bq.w);
      *(u32x4*)(Ks + ((size_t)b * 144 + w) * 128 + c8 * 8) = o;
    }
    for (int i = gt; i < 128 * 12 * 16; i += NGT) {
      const int c8 = i & 15, r = (i >> 4) % 12, b = i / 192;
      *(u32x4*)(Ks + ((size_t)b * 144 + 132 + r) * 128 + c8 * 8) = u32x4{0u, 0u, 0u, 0u};
    }
    for (int i = gt; i < 128 * 16 * 128; i += NGT) {
      const int kvd = i & 127, w8 = (i >> 7) & 15, b = i >> 11;
      const float* s = cv + ((size_t)b * 128 + w8 * 8) * 128 + kvd;
      u32x4 o; o.x = pk2(s[0], s[128]); o.y = pk2(s[256], s[384]); o.z = pk2(s[512], s[640]); o.w = pk2(s[768], s[896]);
      *(u32x4*)(Vts + ((size_t)b * 128 + kvd) * 144 + w8 * 8) = o;
    }
    for (int i = gt; i < 128 * 128 * 3; i += NGT) {
      const int q = i % 3, r = i / 3;
      *(u32x2*)(Vts + (size_t)r * 144 + 132 + q * 4) = u32x2{0u, 0u};
    }
    for (int i = gt; i < 128 * 124 * 32; i += NGT) {
      const int c4 = i & 31, w = (i >> 5) % 124, b = i / (124 * 32);
      const size_t so = ((size_t)b * 128 + w + 4) * 128 + c4 * 4, dof = ((size_t)b * 128 + w) * 128 + c4 * 4;
      *(f32x4*)(p.out + O_KS + dof) = *(const f32x4*)(ck + so);
      *(f32x4*)(p.out + O_VS + dof) = *(const f32x4*)(cv + so);
    }
  }
  {
    float* AR = (float*)(ws + OFF_AR); float* AI = (float*)(ws + OFF_AI); bf16_t* BB = (bf16_t*)(ws + OFF_BB);
    for (int i = gt; i < 2048; i += NGT) {
      const int g = i >> 6, pp = i & 63;
      const float lr = p.in[8][i], li = p.in[9][i], dt = expf(p.in[10][g]);
      const float mag = expf(lr * dt), ang = li * dt;
      const float abr = mag * cosf(ang), abi = mag * sinf(ang);
      const float den = lr * lr + li * li, nr = abr - 1.f;
      const float cr = (nr * lr + abi * li) / den, ci = (abi * lr - nr * li) / den;
      AR[i] = abr; AI[i] = abi;
      const float* br = p.in[11] + (size_t)i * 16; const float* bi = p.in[12] + (size_t)i * 16;
      bf16_t* dre = BB + ((size_t)g * 128 + pp) * 16; bf16_t* dim_ = BB + ((size_t)g * 128 + 64 + pp) * 16;
#pragma unroll
      for (int c = 0; c < 16; ++c) {
        dre[c] = f2bf(cr * br[c] - ci * bi[c]);
        dim_[c] = f2bf(cr * bi[c] + ci * br[c]);
      }
    }
  }
}

#define CMUL_ACC(dr, di, ar_, ai_, br_, bi_) do { const float t_r = (ar_) * (br_) - (ai_) * (bi_); const float t_i = (ar_) * (bi_) + (ai_) * (br_); dr += t_r; di += t_i; } while (0)

template <int MODE>
__device__ __forceinline__ void scan_unit(const Params& p, int u, int lane, bf16_t* Hs) {
  unsigned char* ws = p.ws;
  const int pl = lane & 15, q4 = lane >> 4;
  const bf16_t* P = (const bf16_t*)(ws + OFF_P);
  const float* AR = (const float*)(ws + OFF_AR); const float* AI = (const float*)(ws + OFF_AI);
  const bf16_t* BB = (const bf16_t*)(ws + OFF_BB);
  float* E = (float*)(ws + OFF_E);
  int g, s = 0, c = 0, R0, ntile;
  if (MODE == 2) { g = u & 31; const int ti = u >> 5; R0 = MP + ti * 16; ntile = 1; s = ti; }
  else { c = u & 15; g = (u >> 4) & 31; s = u >> 9; R0 = s * 2048 + c * 128; ntile = 8; }
  float ar[4], ai[4], a4r[4], a4i[4], a8r[4], a8i[4], a128r[4], a128i[4];
#pragma unroll
  for (int q = 0; q < 4; ++q) {
    const float r1 = AR[g * 64 + q * 16 + pl], i1 = AI[g * 64 + q * 16 + pl];
    ar[q] = r1; ai[q] = i1;
    const float r2 = r1 * r1 - i1 * i1, i2 = 2.f * r1 * i1;
    const float r4 = r2 * r2 - i2 * i2, i4 = 2.f * r2 * i2;
    const float r8 = r4 * r4 - i4 * i4, i8 = 2.f * r4 * i4;
    a4r[q] = r4; a4i[q] = i4; a8r[q] = r8; a8i[q] = i8;
    const float r16 = r8 * r8 - i8 * i8, i16 = 2.f * r8 * i8;
    const float r32 = r16 * r16 - i16 * i16, i32 = 2.f * r16 * i16;
    const float r64 = r32 * r32 - i32 * i32, i64 = 2.f * r32 * i32;
    a128r[q] = r64 * r64 - i64 * i64; a128i[q] = 2.f * r64 * i64;
  }
  bf16x4 bb[8];
#pragma unroll
  for (int pt = 0; pt < 8; ++pt) bb[pt] = *(const bf16x4*)(BB + ((size_t)g * 128 + pt * 16 + pl) * 16 + q4 * 4);
  bf16x8 cm[4]; bf16x4 dmv;
  if (MODE != 0) {
#pragma unroll
    for (int ks = 0; ks < 4; ++ks) {
      const float* src = ((ks < 2) ? p.in[13] : p.in[14]) + ((size_t)g * 16 + pl) * 64 + (ks & 1) * 32 + q4 * 8;
      const float sg = (ks < 2) ? 1.f : -1.f;
      const f32x4 x0 = *(const f32x4*)src, x1 = *(const f32x4*)(src + 4);
      u32x4 o; o.x = pk2(sg * x0.x, sg * x0.y); o.y = pk2(sg * x0.z, sg * x0.w); o.z = pk2(sg * x1.x, sg * x1.y); o.w = pk2(sg * x1.z, sg * x1.w);
      cm[ks] = __builtin_bit_cast(bf16x8, o);
    }
    const float dv = p.in[15][g * 16 + pl];
    u32x2 o;
    o.x = pk2((q4 * 4 + 0 == pl) ? dv : 0.f, (q4 * 4 + 1 == pl) ? dv : 0.f);
    o.y = pk2((q4 * 4 + 2 == pl) ? dv : 0.f, (q4 * 4 + 3 == pl) ? dv : 0.f);
    dmv = __builtin_bit_cast(bf16x4, o);
  }
  float hr[4], hi[4];
#pragma unroll
  for (int q = 0; q < 4; ++q) { hr[q] = 0.f; hi[q] = 0.f; }
  if (MODE == 1) {
    const float* Eb = E + ((size_t)(s * 32 + g) * 16) * 128;
#pragma unroll
    for (int bt = 0; bt < 3; ++bt) {
      if (bt * 5 < c) {
        float er[5][4], ei[5][4];
#pragma unroll
        for (int k = 0; k < 5; ++k)
#pragma unroll
          for (int q = 0; q < 4; ++q) { er[k][q] = Eb[(bt * 5 + k) * 128 + q * 16 + pl]; ei[k][q] = Eb[(bt * 5 + k) * 128 + 64 + q * 16 + pl]; }
#pragma unroll
        for (int k = 0; k < 5; ++k) {
          const bool on = (bt * 5 + k) < c;
#pragma unroll
          for (int q = 0; q < 4; ++q) {
            const float nr_ = a128r[q] * hr[q] - a128i[q] * hi[q] + er[k][q];
            const float ni_ = a128r[q] * hi[q] + a128i[q] * hr[q] + ei[k][q];
            hr[q] = on ? nr_ : hr[q]; hi[q] = on ? ni_ : hi[q];
          }
        }
      }
    }
  }
  if (MODE == 2) {
    const int b = s * 4 + q4;
#pragma unroll
    for (int q = 0; q < 4; ++q) {
      hr[q] = p.in[4][((size_t)b * 32 + g) * 64 + q * 16 + pl];
      hi[q] = p.in[5][((size_t)b * 32 + g) * 64 + q * 16 + pl];
    }
  }
  const bf16_t* up = P + (size_t)(R0 + pl) * PW + g * 16 + q4 * 4;
  bf16x4 uf_next = *(const bf16x4*)up;
#pragma unroll 2
  for (int tile = 0; tile < ntile; ++tile) {
    const int Rt = R0 + tile * 16;
    const bf16x4 uf = uf_next;
    if (tile + 1 < ntile) uf_next = *(const bf16x4*)(up + (size_t)(tile + 1) * 16 * PW);
    f32x4 xr[4], xi[4];
    const f32x4 z4 = f32x4{0.f, 0.f, 0.f, 0.f};
#pragma unroll
    for (int q = 0; q < 4; ++q) {
      xr[q] = __builtin_amdgcn_mfma_f32_16x16x16bf16_1k(uf, bb[q], z4, 0, 0, 0);
      xi[q] = __builtin_amdgcn_mfma_f32_16x16x16bf16_1k(uf, bb[q + 4], z4, 0, 0, 0);
    }
#pragma unroll
    for (int q = 0; q < 4; ++q) {
      float s0r = xr[q].x, s0i = xi[q].x, s1r = xr[q].y, s1i = xi[q].y, s2r = xr[q].z, s2i = xi[q].z, s3r = xr[q].w, s3i = xi[q].w;
      if (MODE == 2 || q4 == 0) CMUL_ACC(s0r, s0i, ar[q], ai[q], hr[q], hi[q]);
      CMUL_ACC(s1r, s1i, ar[q], ai[q], s0r, s0i);
      CMUL_ACC(s2r, s2i, ar[q], ai[q], s1r, s1i);
      CMUL_ACC(s3r, s3i, ar[q], ai[q], s2r, s2i);
      if (MODE != 2) {
        float Ir = s3r, Ii = s3i;
        float tr = __shfl_up(Ir, 16), ti = __shfl_up(Ii, 16);
        if (q4 >= 1) CMUL_ACC(Ir, Ii, a4r[q], a4i[q], tr, ti);
        tr = __shfl_up(Ir, 32); ti = __shfl_up(Ii, 32);
        if (q4 >= 2) CMUL_ACC(Ir, Ii, a8r[q], a8i[q], tr, ti);
        float cr = __shfl_up(Ir, 16), ci = __shfl_up(Ii, 16);
        if (q4 == 0) { cr = 0.f; ci = 0.f; }
        float t1r = ar[q] * cr - ai[q] * ci, t1i = ar[q] * ci + ai[q] * cr; s0r += t1r; s0i += t1i;
        float t2r = ar[q] * t1r - ai[q] * t1i, t2i = ar[q] * t1i + ai[q] * t1r; s1r += t2r; s1i += t2i;
        float t3r = ar[q] * t2r - ai[q] * t2i, t3i = ar[q] * t2i + ai[q] * t2r; s2r += t3r; s2i += t3i;
        float t4r = ar[q] * t3r - ai[q] * t3i, t4i = ar[q] * t3i + ai[q] * t3r; s3r += t4r; s3i += t4i;
        hr[q] = __shfl(s3r, 48 + pl); hi[q] = __shfl(s3i, 48 + pl);
      } else {
        hr[q] = s3r; hi[q] = s3i;
      }
      xr[q] = f32x4{s0r, s1r, s2r, s3r}; xi[q] = f32x4{s0i, s1i, s2i, s3i};
    }
    if (MODE != 0) {
#pragma unroll
      for (int q = 0; q < 4; ++q) {
        Hs[(q4 * 4 + 0) * 136 + q * 16 + pl] = f2bf(xr[q].x); Hs[(q4 * 4 + 1) * 136 + q * 16 + pl] = f2bf(xr[q].y);
        Hs[(q4 * 4 + 2) * 136 + q * 16 + pl] = f2bf(xr[q].z); Hs[(q4 * 4 + 3) * 136 + q * 16 + pl] = f2bf(xr[q].w);
        Hs[(q4 * 4 + 0) * 136 + 64 + q * 16 + pl] = f2bf(xi[q].x); Hs[(q4 * 4 + 1) * 136 + 64 + q * 16 + pl] = f2bf(xi[q].y);
        Hs[(q4 * 4 + 2) * 136 + 64 + q * 16 + pl] = f2bf(xi[q].z); Hs[(q4 * 4 + 3) * 136 + 64 + q * 16 + pl] = f2bf(xi[q].w);
      }
      asm volatile("s_waitcnt lgkmcnt(0)" ::: "memory");
      f32x4 y = z4;
#pragma unroll
      for (int ks = 0; ks < 4; ++ks) {
        const bf16x8 hf = *(const bf16x8*)(Hs + pl * 136 + ks * 32 + q4 * 8);
        y = __builtin_amdgcn_mfma_f32_16x16x32_bf16(hf, cm[ks], y, 0, 0, 0);
      }
      y = __builtin_amdgcn_mfma_f32_16x16x16bf16_1k(uf, dmv, y, 0, 0, 0);
      asm volatile("s_waitcnt lgkmcnt(0)" ::: "memory");
      bf16_t* GY = (bf16_t*)(ws + OFF_GY);
      bf16_t* dst = GY + (size_t)(Rt + q4 * 4) * 512 + g * 16 + pl;
      dst[0] = f2bf(gelu_tanh(y.x)); dst[512] = f2bf(gelu_tanh(y.y)); dst[1024] = f2bf(gelu_tanh(y.z)); dst[1536] = f2bf(gelu_tanh(y.w));
    }
  }
  if (MODE == 0) {
    if (q4 == 0) {
      float* Eb = E + ((size_t)(s * 32 + g) * 16 + c) * 128;
#pragma unroll
      for (int q = 0; q < 4; ++q) { Eb[q * 16 + pl] = hr[q]; Eb[64 + q * 16 + pl] = hi[q]; }
    }
  } else if (MODE == 1) {
    if (c == 15 && q4 == 0) {
#pragma unroll
      for (int q = 0; q < 4; ++q) {
        p.out[O_HRP + ((size_t)s * 32 + g) * 64 + q * 16 + pl] = hr[q];
        p.out[O_HIP + ((size_t)s * 32 + g) * 64 + q * 16 + pl] = hi[q];
      }
    }
  } else {
    const int b = s * 4 + q4;
#pragma unroll
    for (int q = 0; q < 4; ++q) {
      p.out[O_HRS + ((size_t)b * 32 + g) * 64 + q * 16 + pl] = hr[q];
      p.out[O_HIS + ((size_t)b * 32 + g) * 64 + q * 16 + pl] = hi[q];
    }
  }
}

__device__ __forceinline__ void scan_end_unit(const Params& p, int u, int lane) {
  unsigned char* ws = p.ws;
  const int pl = lane & 15, q4 = lane >> 4;
  const bf16_t* P = (const bf16_t*)(ws + OFF_P);
  const float* AR = (const float*)(ws + OFF_AR); const float* AI = (const float*)(ws + OFF_AI);
  const bf16_t* BB = (const bf16_t*)(ws + OFF_BB);
  float* E = (float*)(ws + OFF_E);
  const int c = u & 15, g = (u >> 4) & 31, s = u >> 9, R0 = s * 2048 + c * 128;
  float ar[4], ai[4], wr_[4], wi_[4], a16r[4], a16i[4];
#pragma unroll
  for (int q = 0; q < 4; ++q) {
    const float r1 = AR[g * 64 + q * 16 + pl], i1 = AI[g * 64 + q * 16 + pl];
    ar[q] = r1; ai[q] = i1;
    const float r2 = r1 * r1 - i1 * i1, i2 = 2.f * r1 * i1;
    const float r4 = r2 * r2 - i2 * i2, i4 = 2.f * r2 * i2;
    const float r8 = r4 * r4 - i4 * i4, i8 = 2.f * r4 * i4;
    const float r12 = r8 * r4 - i8 * i4, i12 = r8 * i4 + i8 * r4;
    a16r[q] = r8 * r8 - i8 * i8; a16i[q] = 2.f * r8 * i8;
    wr_[q] = (q4 == 0) ? r12 : (q4 == 1) ? r8 : (q4 == 2) ? r4 : 1.f;
    wi_[q] = (q4 == 0) ? i12 : (q4 == 1) ? i8 : (q4 == 2) ? i4 : 0.f;
  }
  bf16x4 bb[8];
#pragma unroll
  for (int pt = 0; pt < 8; ++pt) bb[pt] = *(const bf16x4*)(BB + ((size_t)g * 128 + pt * 16 + pl) * 16 + q4 * 4);
  float er[4], ei[4];
#pragma unroll
  for (int q = 0; q < 4; ++q) { er[q] = 0.f; ei[q] = 0.f; }
  const bf16_t* up = P + (size_t)(R0 + pl) * PW + g * 16 + q4 * 4;
  bf16x4 uf_next = *(const bf16x4*)up;
  const f32x4 z4 = f32x4{0.f, 0.f, 0.f, 0.f};
#pragma unroll 2
  for (int tile = 0; tile < 8; ++tile) {
    const bf16x4 uf = uf_next;
    if (tile + 1 < 8) uf_next = *(const bf16x4*)(up + (size_t)(tile + 1) * 16 * PW);
#pragma unroll
    for (int q = 0; q < 4; ++q) {
      const f32x4 xr = __builtin_amdgcn_mfma_f32_16x16x16bf16_1k(uf, bb[q], z4, 0, 0, 0);
      const f32x4 xi = __builtin_amdgcn_mfma_f32_16x16x16bf16_1k(uf, bb[q + 4], z4, 0, 0, 0);
      float tr = xr.x, ti = xi.x, nr_, ni_;
      nr_ = ar[q] * tr - ai[q] * ti + xr.y; ni_ = ar[q] * ti + ai[q] * tr + xi.y; tr = nr_; ti = ni_;
      nr_ = ar[q] * tr - ai[q] * ti + xr.z; ni_ = ar[q] * ti + ai[q] * tr + xi.z; tr = nr_; ti = ni_;
      nr_ = ar[q] * tr - ai[q] * ti + xr.w; ni_ = ar[q] * ti + ai[q] * tr + xi.w; tr = nr_; ti = ni_;
      float sr = wr_[q] * tr - wi_[q] * ti, si = wr_[q] * ti + wi_[q] * tr;
      sr += __shfl_xor(sr, 16); si += __shfl_xor(si, 16);
      sr += __shfl_xor(sr, 32); si += __shfl_xor(si, 32);
      nr_ = a16r[q] * er[q] - a16i[q] * ei[q] + sr; ni_ = a16r[q] * ei[q] + a16i[q] * er[q] + si;
      er[q] = nr_; ei[q] = ni_;
    }
  }
  if (q4 == 0) {
    float* Eb = E + ((size_t)(s * 32 + g) * 16 + c) * 128;
#pragma unroll
    for (int q = 0; q < 4; ++q) { Eb[q * 16 + pl] = er[q]; Eb[64 + q * 16 + pl] = ei[q]; }
  }
}

template <bool LDSRC>
__device__ __forceinline__ void attn_core(const Params& p, const int lane, const char* kptr, const int kstride, const char* vptr, const int vstride,
                                          const int kt0, const int has_prev, const int row_q, const int h_q, const int i_q) {
  unsigned char* ws = p.ws;
  const int pl = lane & 15, q4 = lane >> 4;
  const bf16_t* P = (const bf16_t*)(ws + OFF_P);
  const float sink = p.in[17][h_q];
  const bf16_t* qp = P + (size_t)row_q * PW + 512 + h_q * 64 + q4 * 8;
  const bf16x8 qf0 = *(const bf16x8*)qp, qf1 = *(const bf16x8*)(qp + 32);
  u32x4 vfr[LDSRC ? 1 : 5][4];
  if constexpr (!LDSRC) {
#pragma unroll
    for (int pp = 0; pp < 5; ++pp) {
      int TA = kt0 + 2 * pp, TB = kt0 + ((2 * pp + 1 < 9) ? 2 * pp + 1 : 2 * pp);
      if (!has_prev) { if (TA < 8) TA = 8; if (TB < 8) TB = 8; }
#pragma unroll
      for (int dt = 0; dt < 4; ++dt) {
        const char* vp = vptr + (dt * 16 + pl) * vstride + q4 * 8;
        const u32x2 va = *(const u32x2*)(vp + TA * 32), vb = *(const u32x2*)(vp + TB * 32);
        vfr[pp][dt] = u32x4{va.x, va.y, vb.x, vb.y};
      }
    }
  }
  f32x4 sa[9];
#pragma unroll
  for (int kt = 0; kt < 9; ++kt) {
    int T = kt0 + kt; if (!has_prev && T < 8) T = 8;
    const char* kp = kptr + (T * 16 + pl) * kstride + q4 * 16;
    bf16x8 k0, k1;
    if constexpr (LDSRC) { k0 = *(const LAS bf16x8*)(const LAS char*)kp; k1 = *(const LAS bf16x8*)(const LAS char*)(kp + 64); }
    else { k0 = *(const bf16x8*)kp; k1 = *(const bf16x8*)(kp + 64); }
    f32x4 a = f32x4{0.f, 0.f, 0.f, 0.f};
    a = __builtin_amdgcn_mfma_f32_16x16x32_bf16(k0, qf0, a, 0, 0, 0);
    a = __builtin_amdgcn_mfma_f32_16x16x32_bf16(k1, qf1, a, 0, 0, 0);
    sa[kt] = a;
  }
  const int lo = has_prev ? (i_q + 1) : ((i_q + 1) > 128 ? (i_q + 1) : 128);
  const unsigned span = (unsigned)(i_q + 128 - lo);
  const int dbase = q4 * 4 - lo;
  float mx = -INFINITY;
#pragma unroll
  for (int kt = 0; kt < 9; ++kt) {
#pragma unroll
    for (int r = 0; r < 4; ++r) {
      const int d = (kt0 + kt) * 16 + r + dbase;
      const float v = ((unsigned)d <= span) ? sa[kt][r] : -INFINITY;
      sa[kt][r] = v; mx = fmaxf(mx, v);
    }
  }
  mx = fmaxf(mx, __shfl_xor(mx, 16)); mx = fmaxf(mx, __shfl_xor(mx, 32));
  const float mfin = fmaxf(mx * 0.125f, sink);
  const float cl = 0.125f * 1.4426950408889634f, ml = mfin * 1.4426950408889634f;
  float sum = 0.f;
#pragma unroll
  for (int kt = 0; kt < 9; ++kt) {
#pragma unroll
    for (int r = 0; r < 4; ++r) { const float e = __builtin_amdgcn_exp2f(fmaf(sa[kt][r], cl, -ml)); sa[kt][r] = e; sum += e; }
  }
  sum += __shfl_xor(sum, 16); sum += __shfl_xor(sum, 32);
  const float inv = 1.f / (sum + __builtin_amdgcn_exp2f((sink - mfin) * 1.4426950408889634f));
  f32x4 oa[4];
#pragma unroll
  for (int dt = 0; dt < 4; ++dt) oa[dt] = f32x4{0.f, 0.f, 0.f, 0.f};
#pragma unroll
  for (int pp = 0; pp < 5; ++pp) {
    const int kA = 2 * pp, kB = (2 * pp + 1 < 9) ? 2 * pp + 1 : 2 * pp;
    u32x4 pw;
    pw.x = pk2(sa[kA][0] * inv, sa[kA][1] * inv); pw.y = pk2(sa[kA][2] * inv, sa[kA][3] * inv);
    if (2 * pp + 1 < 9) { pw.z = pk2(sa[kB][0] * inv, sa[kB][1] * inv); pw.w = pk2(sa[kB][2] * inv, sa[kB][3] * inv); }
    else { pw.z = 0u; pw.w = 0u; }
    const bf16x8 pf = __builtin_bit_cast(bf16x8, pw);
    if constexpr (LDSRC) {
      int TA = kt0 + 2 * pp, TB = kt0 + ((2 * pp + 1 < 9) ? 2 * pp + 1 : 2 * pp);
      if (!has_prev) { if (TA < 8) TA = 8; if (TB < 8) TB = 8; }
#pragma unroll
      for (int dt = 0; dt < 4; ++dt) {
        const char* vp = vptr + (dt * 16 + pl) * vstride + q4 * 8;
        const u32x2 va = *(const LAS u32x2*)(const LAS char*)(vp + TA * 32), vb = *(const LAS u32x2*)(const LAS char*)(vp + TB * 32);
        oa[dt] = __builtin_amdgcn_mfma_f32_16x16x32_bf16(__builtin_bit_cast(bf16x8, u32x4{va.x, va.y, vb.x, vb.y}), pf, oa[dt], 0, 0, 0);
      }
    } else {
#pragma unroll
      for (int dt = 0; dt < 4; ++dt) oa[dt] = __builtin_amdgcn_mfma_f32_16x16x32_bf16(__builtin_bit_cast(bf16x8, vfr[pp][dt]), pf, oa[dt], 0, 0, 0);
    }
  }
  bf16_t* O = (bf16_t*)(ws + OFF_O);
#pragma unroll
  for (int dt = 0; dt < 4; ++dt) *(u32x2*)(O + (size_t)row_q * 512 + h_q * 64 + dt * 16 + q4 * 4) = pk4(oa[dt]);
}

__device__ __forceinline__ void attn_sample_unit(const Params& p, int us, int lane) {
  const int pl = lane & 15, kv = us & 1, b = us >> 1, tt = pl >> 2, g = pl & 3;
  const bf16_t* Ks = (const bf16_t*)(p.ws + OFF_KS); const bf16_t* Vts = (const bf16_t*)(p.ws + OFF_VTS);
  attn_core<false>(p, lane, (const char*)(Ks + (size_t)b * 144 * 128 + kv * 64), 256, (const char*)(Vts + (size_t)(b * 2 + kv) * 64 * 144), 288,
                   0, 1, MP + b * 4 + tt, kv * 4 + g, tt);
}

constexpr int ATT_KSTR = 144, ATT_VSTR = 528, ATT_VOFF = 256 * ATT_KSTR;
__device__ __forceinline__ void attn_block_unit(const Params& p, int bu, char* lds, int tid) {
  const int b = bu >> 5, kv = (bu >> 4) & 1, blk = bu & 15, lane = tid & 63, wid = tid >> 6;
  const bf16_t* Kp = (const bf16_t*)(p.ws + OFF_KP); const bf16_t* Vtp = (const bf16_t*)(p.ws + OFF_VTP);
  char* K_l = lds; char* Vt_l = lds + ATT_VOFF;
  u32x4 kr[4], vr[4];
#pragma unroll
  for (int i = 0; i < 4; ++i) {
    const int piece = tid + i * NTHR, key = piece >> 3, c = piece & 7;
    if (blk > 0 || key >= 128) kr[i] = *(const u32x4*)(Kp + ((size_t)b * 2048 + (size_t)(blk - 1) * 128 + key) * 128 + kv * 64 + c * 8);
    const int d = piece >> 5, c2 = piece & 31;
    if (blk > 0 || c2 >= 16) vr[i] = *(const u32x4*)(Vtp + ((size_t)(b * 2 + kv) * 64 + d) * 2048 + (size_t)(blk - 1) * 128 + c2 * 8);
  }
#pragma unroll
  for (int i = 0; i < 4; ++i) {
    const int piece = tid + i * NTHR, key = piece >> 3, c = piece & 7;
    if (blk > 0 || key >= 128) *(u32x4*)(K_l + key * ATT_KSTR + c * 16) = kr[i];
    const int d = piece >> 5, c2 = piece & 31;
    if (blk > 0 || c2 >= 16) *(u32x4*)(Vt_l + d * ATT_VSTR + c2 * 16) = vr[i];
  }
  __syncthreads();
  const int pl = lane & 15;
#pragma unroll 1
  for (int g = 0; g < 4; ++g) {
    asm volatile("" ::: "memory");
    attn_core<true>(p, lane, K_l, ATT_KSTR, Vt_l, ATT_VSTR, wid, blk > 0, b * 2048 + blk * 128 + wid * 16 + pl, kv * 4 + g, wid * 16 + pl);
  }
  __syncthreads();
}

template <int WHICH, int NRW>
__device__ __forceinline__ void ln_rows(const Params& p, const int row0, const int lane, const f32x4 (&gv)[4], const f32x4 (&bv)[4]) {
  bf16_t* X1b = (bf16_t*)(p.ws + OFF_X1B);
  f32x4 v[NRW][4];
#pragma unroll
  for (int h = 0; h < NRW; ++h) {
    const int row = row0 + h;
    if (row < MP) {
      const bf16_t* xr = (const bf16_t*)(p.ws + (WHICH == 1 ? OFF_PRE1 : OFF_PRE2)) + (size_t)row * DM;
#pragma unroll
      for (int j = 0; j < 4; ++j) v[h][j] = unpk4(*(const u32x2*)(xr + j * 256 + lane * 4));
    } else {
      const float* SL = (const float*)(p.ws + (WHICH == 1 ? OFF_SLAB_WO : OFF_SLAB_DN)) + (size_t)(row - MP) * DM;
      constexpr int NS = (WHICH == 1) ? 8 : 11;
#pragma unroll
      for (int j = 0; j < 4; ++j) {
        f32x4 a;
        if (WHICH == 1) a = *(const f32x4*)(p.in[1] + (size_t)(row - MP) * DM + j * 256 + lane * 4) * ALPHA_F;
        else a = unpk4(*(const u32x2*)(X1b + (size_t)row * DM + j * 256 + lane * 4)) * ALPHA_F;
#pragma unroll
        for (int q = 0; q < NS; ++q) a += *(const f32x4*)(SL + (size_t)q * MS * DM + j * 256 + lane * 4);
        v[h][j] = a;
      }
    }
  }
  float s[NRW], s2[NRW];
#pragma unroll
  for (int h = 0; h < NRW; ++h) { s[h] = 0.f;
#pragma unroll
    for (int j = 0; j < 4; ++j) s[h] += (v[h][j].x + v[h][j].y) + (v[h][j].z + v[h][j].w); }
#pragma unroll
  for (int o = 1; o < 64; o <<= 1) {
#pragma unroll
    for (int h = 0; h < NRW; ++h) s[h] += __shfl_xor(s[h], o);
  }
#pragma unroll
  for (int h = 0; h < NRW; ++h) { const float mean = s[h] * (1.f / DM); s2[h] = 0.f;
#pragma unroll
    for (int j = 0; j < 4; ++j) { v[h][j] = v[h][j] - mean; s2[h] += (v[h][j].x * v[h][j].x + v[h][j].y * v[h][j].y) + (v[h][j].z * v[h][j].z + v[h][j].w * v[h][j].w); } }
#pragma unroll
  for (int o = 1; o < 64; o <<= 1) {
#pragma unroll
    for (int h = 0; h < NRW; ++h) s2[h] += __shfl_xor(s2[h], o);
  }
#pragma unroll
  for (int h = 0; h < NRW; ++h) {
    const int row = row0 + h;
    const float rstd = rsqrtf(s2[h] * (1.f / DM) + LN_EPS_F);
#pragma unroll
    for (int j = 0; j < 4; ++j) {
      const f32x4 o = v[h][j] * rstd * gv[j] + bv[j];
      if (WHICH == 1) *(u32x2*)(X1b + (size_t)row * DM + j * 256 + lane * 4) = pk4(o);
      else *(f32x4*)(p.out + (size_t)row * DM + j * 256 + lane * 4) = o;
    }
  }
}
template <int WHICH>
__device__ __forceinline__ void ln_phase(const Params& p) {
  const int lane = threadIdx.x & 63, wid = threadIdx.x >> 6;
  const int gw = blockIdx.x * NWAVE + wid, NGW = gridDim.x * NWAVE;
  const float* gam = p.in[WHICH == 1 ? 20 : 26]; const float* bet = p.in[WHICH == 1 ? 21 : 27];
  f32x4 gv[4], bv[4];
#pragma unroll
  for (int j = 0; j < 4; ++j) { gv[j] = *(const f32x4*)(gam + j * 256 + lane * 4); bv[j] = *(const f32x4*)(bet + j * 256 + lane * 4); }
  for (int rp = gw; rp < MP / 2; rp += NGW) ln_rows<WHICH, 2>(p, rp * 2, lane, gv, bv);
  for (int row = MP + gw; row < MT; row += NGW) ln_rows<WHICH, 1>(p, row, lane, gv, bv);
}

__device__ __forceinline__ void fixup_phase(const Params& p) {
  unsigned char* ws = p.ws;
  const int gt = blockIdx.x * NTHR + threadIdx.x, NGT = gridDim.x * NTHR;
  const float* HA0 = (const float*)(ws + OFF_HA0); const float* HG0 = (const float*)(ws + OFF_HG0); const float* HA1 = (const float*)(ws + OFF_HA1);
  bf16_t* H = (bf16_t*)(ws + OFF_H);
  constexpr int NJ4 = DFF / 4;
  for (int i = gt; i < NRB * 2 * NJ4; i += NGT) {
    const int j4 = i % NJ4, rl = (i / NJ4) & 1, rb = i / (2 * NJ4);
    if ((rb & 31) == 0) continue;
    const int j0 = j4 * 4;
    const f32x4 a0 = *(const f32x4*)(HA0 + ((size_t)rb * 2 + rl) * DFF + j0);
    const f32x4 g = *(const f32x4*)(HG0 + ((size_t)rb * 2 + rl) * DFF + j0);
    const f32x4 pm1 = *(const f32x4*)(HA1 + ((size_t)(rb - 1) * 2 + 1) * DFF + j0);
    const f32x4 pm2 = *(const f32x4*)(HA1 + ((size_t)(rb - 1) * 2 + 0) * DFF + j0);
    f32x4 am1, am2;
    if (rl == 0) { am1 = pm1; am2 = pm2; }
    else { am1 = *(const f32x4*)(HA0 + ((size_t)rb * 2 + 0) * DFF + j0); am2 = pm1; }
    const f32x4 w0 = *(const f32x4*)(p.in[23] + j0), w1 = *(const f32x4*)(p.in[23] + DFF + j0), w2 = *(const f32x4*)(p.in[23] + 2 * DFF + j0);
    const f32x4 cb = *(const f32x4*)(p.in[24] + j0);
    f32x4 h;
    h.x = gelu_tanh(cb.x + w0.x * am2.x + w1.x * am1.x + w2.x * a0.x) * g.x;
    h.y = gelu_tanh(cb.y + w0.y * am2.y + w1.y * am1.y + w2.y * a0.y) * g.y;
    h.z = gelu_tanh(cb.z + w0.z * am2.z + w1.z * am1.z + w2.z * a0.z) * g.z;
    h.w = gelu_tanh(cb.w + w0.w * am2.w + w1.w * am1.w + w2.w * a0.w) * g.w;
    *(u32x2*)(H + ((size_t)rb * 64 + rl) * DFF + j0) = pk4(h);
  }
}

#define XB_TMO      128
#define XB_XCNT(j)  (256  + 64 * (j))
#define XB_XSUB(j)  (1280 + 64 * (j))
#define XB_XGEN(j)  (2304 + 64 * (j))
#define XB_TOP      3328
#define XB_TOPGEN   3392
#define XCD_BAR_WORDS 3456
#define XB_SPIN_CAP (1u << 18)
__device__ __forceinline__ unsigned xb_ld(unsigned* p)              { return __hip_atomic_load(p, __ATOMIC_RELAXED, __HIP_MEMORY_SCOPE_AGENT); }
__device__ __forceinline__ unsigned xb_add(unsigned* p, unsigned v) { return __hip_atomic_fetch_add(p, v, __ATOMIC_RELAXED, __HIP_MEMORY_SCOPE_AGENT); }
__device__ __forceinline__ unsigned xb_xcc_id() { return (unsigned)__builtin_amdgcn_s_getreg((3 << 11) | 20) & 0xFu; }
#define XB_SPIN(cond, bar) do { unsigned _sp = 0; while (cond) { __builtin_amdgcn_s_sleep(1); \
    if ((++_sp & 255u) == 0u) { if (xb_ld(&(bar)[XB_TMO])) break; if (_sp > XB_SPIN_CAP) { atomicAdd(&(bar)[XB_TMO], 1u); break; } } } } while (0)
#define XB_EXIT 64
__device__ unsigned g_xbar[XCD_BAR_WORDS + 64];
struct XcdBarrier { unsigned* bar; unsigned x; volatile LAS unsigned* st; };
__device__ __forceinline__ XcdBarrier xcd_barrier_post(unsigned* bar, volatile LAS unsigned* st) {
    XcdBarrier b; b.bar = bar; b.x = xb_xcc_id(); b.st = st;
    if (threadIdx.x == 0) (void)xb_add(&bar[XB_XCNT(b.x)], 1u);
    return b;
}
__device__ __forceinline__ void xcd_barrier_complete(unsigned* bar, unsigned x, unsigned& nloc, unsigned& nx) {
    const unsigned G = gridDim.x * gridDim.y * gridDim.z;
    unsigned sum, cnt, mine, sp = 0u;
    for (;;) {
        sum = 0u; cnt = 0u; mine = 0u;
#pragma unroll
        for (unsigned j = 0; j < 16; ++j) { const unsigned c = xb_ld(&bar[XB_XCNT(j)]); sum += c; cnt += (c > 0u) ? 1u : 0u; mine = (j == x) ? c : mine; }
        if (sum == G) break;
        __builtin_amdgcn_s_sleep(1);
        if ((++sp & 255u) == 0u) { if (xb_ld(&bar[XB_TMO])) break; if (sp > XB_SPIN_CAP) { atomicAdd(&bar[XB_TMO], 1u); break; } }
    }
    nloc = mine > 0u ? mine : 1u; nx = cnt > 0u ? cnt : 1u;
}
__device__ __forceinline__ void xcd_barrier(const XcdBarrier& b) {
    asm volatile("s_waitcnt vmcnt(0)" ::: "memory");
    __syncthreads();
    if (threadIdx.x == 0) {
        unsigned* bar = b.bar;
        __builtin_amdgcn_s_waitcnt(0);
        unsigned nloc = b.st[0], nx = b.st[1];
        if (nloc == 0u) { xcd_barrier_complete(bar, b.x, nloc, nx); b.st[0] = nloc; b.st[1] = nx; }
        const unsigned old = xb_add(&bar[XB_XSUB(b.x)], 1u);
        const unsigned gen = old / nloc;
        if (old + 1u == (gen + 1u) * nloc) {
            __builtin_amdgcn_fence(__ATOMIC_RELEASE, "agent");
            asm volatile("s_waitcnt vmcnt(0)" ::: "memory");
            const unsigned og = xb_add(&bar[XB_TOP], 1u);
            const unsigned tg = og / nx;
            if (og + 1u == (tg + 1u) * nx) xb_add(&bar[XB_TOPGEN], 1u);
            else XB_SPIN(xb_ld(&bar[XB_TOPGEN]) == tg, bar);
            __builtin_amdgcn_fence(__ATOMIC_ACQUIRE, "agent");
            xb_add(&bar[XB_XGEN(b.x)], 1u);
            asm volatile("s_waitcnt vmcnt(0)" ::: "memory");
        } else {
            XB_SPIN(xb_ld(&bar[XB_XGEN(b.x)]) == gen, bar);
            __builtin_amdgcn_fence(__ATOMIC_ACQUIRE, "agent");
            asm volatile("s_waitcnt vmcnt(0)" ::: "memory");
        }
    }
    __syncthreads();
}
#define GSYNC() xcd_barrier(xb)

__device__ __forceinline__ void sample_merge(const Params& p) {
  unsigned char* ws = p.ws;
  const bf16_t* P = (const bf16_t*)(ws + OFF_P); bf16_t* Mg = (bf16_t*)(ws + OFF_MG);
  const float* SLG = (const float*)(ws + OFF_SLAB_GLU); const float* SLA = (const float*)(ws + OFF_SLAB_ATT);
  for (int i = blockIdx.x * NTHR + threadIdx.x; i < MS * (DM / 4); i += gridDim.x * NTHR) {
    const int r = i >> 8, j = (i & 255) * 4;
    const int tj = j >> 7, jl = j & 127, va = tj * 256 + (jl >> 6) * 128 + ((jl >> 4) & 3) * 32 + (jl & 15);
    f32x4 ya = f32x4{0.f, 0.f, 0.f, 0.f}, yb = ya, at = ya;
#pragma unroll
    for (int q = 0; q < 4; ++q) {
      ya += *(const f32x4*)(SLG + ((size_t)q * MS + r) * 2048 + va);
      yb += *(const f32x4*)(SLG + ((size_t)q * MS + r) * 2048 + va + 16);
      at += *(const f32x4*)(SLA + ((size_t)q * MS + r) * DM + j);
    }
    const size_t row = (size_t)MP + r;
    const f32x4 gs = unpk4(*(const u32x2*)(P + row * PW + 1024 + j)), ga = unpk4(*(const u32x2*)(P + row * PW + 2048 + j));
    f32x4 sv;
    sv.x = gs.x * ya.x * sigmoidf_(yb.x); sv.y = gs.y * ya.y * sigmoidf_(yb.y); sv.z = gs.z * ya.z * sigmoidf_(yb.z); sv.w = gs.w * ya.w * sigmoidf_(yb.w);
    sv = unpk4(pk4(sv));
    sv.x += ga.x * at.x; sv.y += ga.y * at.y; sv.z += ga.z * at.z; sv.w += ga.w * at.w;
    *(u32x2*)(Mg + row * DM + j) = pk4(sv);
  }
}

__global__ void __launch_bounds__(512) fwd_megakernel(Params p) {
  extern __shared__ __attribute__((aligned(16))) char lds[];
  volatile LAS unsigned* xst = (volatile LAS unsigned*)(lds + GEMM_LDS);
  if (threadIdx.x == 0) { xst[0] = 0u; xst[1] = 0u; }
  __syncthreads();
  XcdBarrier xb = xcd_barrier_post(g_xbar, xst);
  unsigned char* ws = p.ws;
  LAS unsigned char* glds = (LAS unsigned char*)lds;
  const int lane = threadIdx.x & 63, wid = threadIdx.x >> 6;
  const int gw = blockIdx.x * NWAVE + wid, NGW = gridDim.x * NWAVE;

  prep_phase(p, lds);
  GSYNC();
  gemm_phase<EPI_IN>(p, (const bf16_t*)(ws + OFF_B), (const bf16_t*)(ws + OFF_WIN), 1024, DIN, glds);
  GSYNC();
  {
    for (int bu = blockIdx.x; bu < 256; bu += gridDim.x) attn_block_unit(p, bu, lds, threadIdx.x);
    bf16_t* Hs = (bf16_t*)(lds + wid * 4352);
    constexpr int N_S1 = 8 * 32 * 16, N_SS = 32 * 32, N_AT = 256;
#pragma unroll 1
    for (int u = blockIdx.x * 16 + wid; u < 4096; u += ((u & 15) + NWAVE < 15) ? NWAVE : (gridDim.x * 16 - (u & 15) + wid)) {
      asm volatile("" ::: "memory");
      scan_end_unit(p, u, lane);
    }
    for (int i = gw; i < 2 * N_SS; i += NGW) { if ((i & 1) == 0) scan_unit<2>(p, i >> 1, lane, Hs); }
    for (int i = gw; i < 8 * N_AT; i += NGW) { if ((i & 7) == 1) attn_sample_unit(p, i >> 3, lane); }
    asm volatile("s_waitcnt vmcnt(0)" ::: "memory");
    __syncthreads();
#pragma unroll 1
    for (int u = blockIdx.x * 16 + wid; u < 4096; u += ((u & 15) + NWAVE < 16) ? NWAVE : (gridDim.x * 16 - (u & 15) + wid)) {
      asm volatile("" ::: "memory");
      scan_unit<1>(p, u, lane, Hs);
    }
  }
  GSYNC();
  gemm_phase<EPI_GLU>(p, (const bf16_t*)(ws + OFF_GY), (const bf16_t*)(ws + OFF_WGLU), 512, 2048, glds, (const bf16_t*)(ws + OFF_O), (const bf16_t*)(ws + OFF_WATT));
  GSYNC();
  gemm_phase<EPI_ATT>(p, (const bf16_t*)(ws + OFF_O), (const bf16_t*)(ws + OFF_WATT), 512, 1024, glds);
  sample_merge(p);
  GSYNC();
  gemm_phase<EPI_WO>(p, (const bf16_t*)(ws + OFF_MG), (const bf16_t*)(ws + OFF_WO), 1024, 1024, glds);
  GSYNC();
  ln_phase<1>(p);
  GSYNC();
  gemm_phase<EPI_UP>(p, (const bf16_t*)(ws + OFF_X1B), (const bf16_t*)(ws + OFF_WUP), 1024, 5632, glds);
  GSYNC();
  fixup_phase(p);
  GSYNC();
  gemm_phase<EPI_DOWN>(p, (const bf16_t*)(ws + OFF_H), (const bf16_t*)(ws + OFF_WDN), DFF, 1024, glds);
  GSYNC();
  ln_phase<2>(p);
  __syncthreads();
  if (threadIdx.x == 0) {
    unsigned* bar = g_xbar;
    const unsigned old = xb_add(&bar[XB_EXIT], 1u);
    if (old == gridDim.x - 1u) {
#pragma unroll
      for (int j = 0; j < 16; ++j) {
        __hip_atomic_store(&bar[XB_XCNT(j)], 0u, __ATOMIC_RELAXED, __HIP_MEMORY_SCOPE_AGENT);
        __hip_atomic_store(&bar[XB_XSUB(j)], 0u, __ATOMIC_RELAXED, __HIP_MEMORY_SCOPE_AGENT);
        __hip_atomic_store(&bar[XB_XGEN(j)], 0u, __ATOMIC_RELAXED, __HIP_MEMORY_SCOPE_AGENT);
      }
      __hip_atomic_store(&bar[XB_TOP], 0u, __ATOMIC_RELAXED, __HIP_MEMORY_SCOPE_AGENT);
      __hip_atomic_store(&bar[XB_TOPGEN], 0u, __ATOMIC_RELAXED, __HIP_MEMORY_SCOPE_AGENT);
      __hip_atomic_store(&bar[XB_TMO], 0u, __ATOMIC_RELAXED, __HIP_MEMORY_SCOPE_AGENT);
      __hip_atomic_store(&bar[XB_EXIT], 0u, __ATOMIC_RELAXED, __HIP_MEMORY_SCOPE_AGENT);
    }
  }
}

extern "C" void kernel_launch(void* const* d_in, const int* in_sizes, int n_in, void* d_out, int out_size, void* d_ws, size_t ws_size, hipStream_t stream) {
  static int grid_blocks = 0;
  if (grid_blocks == 0) {
    if (n_in != 28 || ws_size < WS_TOTAL) { fprintf(stderr, "kernel_launch: unexpected n_in %d or ws_size %zu (< %zu)\n", n_in, ws_size, (size_t)WS_TOTAL); grid_blocks = -1; return; }
    int dev = 0, cus = 0, per_cu = 0;
    (void)hipGetDevice(&dev);
    (void)hipDeviceGetAttribute(&cus, hipDeviceAttributeMultiprocessorCount, dev);
    (void)hipFuncSetAttribute((const void*)fwd_megakernel, hipFuncAttributeMaxDynamicSharedMemorySize, LDS_BYTES);
    (void)hipOccupancyMaxActiveBlocksPerMultiprocessor(&per_cu, (const void*)fwd_megakernel, NTHR, LDS_BYTES);
    if (per_cu < 1) { fprintf(stderr, "kernel_launch: occupancy query returned %d\n", per_cu); per_cu = 1; }
    if (per_cu > 1) per_cu = 1;
    grid_blocks = cus * per_cu;
    fprintf(stderr, "kernel_launch: cus %d per_cu %d grid %d\n", cus, per_cu, grid_blocks);
  }
  if (grid_blocks < 0) return;
  Params p{};
  for (int i = 0; i < 28; ++i) p.in[i] = (const float*)d_in[i];
  p.out = (float*)d_out; p.ws = (unsigned char*)d_ws;
  void* args[] = {&p};
  hipError_t e = hipLaunchCooperativeKernel((const void*)fwd_megakernel, dim3(grid_blocks), dim3(NTHR), args, LDS_BYTES, stream);
  if (e != hipSuccess) fprintf(stderr, "cooperative launch failed: %s (grid %d)\n", hipGetErrorString(e), grid_blocks);
}
```

```cpp
#include <hip/hip_runtime.h>
#include <hip/hip_cooperative_groups.h>
#include <cstdio>
#include <cstdint>
namespace cg = cooperative_groups;

typedef unsigned short bf16_t;
typedef short bf16x8 __attribute__((ext_vector_type(8)));
typedef short bf16x4 __attribute__((ext_vector_type(4)));
typedef float f32x4 __attribute__((ext_vector_type(4)));
typedef unsigned u32x2 __attribute__((ext_vector_type(2)));
typedef unsigned u32x4 __attribute__((ext_vector_type(4)));

constexpr int MP = 16384, MS = 512, MT = MP + MS;
constexpr int DM = 1024, DIN = 3328, PW = 3072, DFF = 2816;
constexpr int NRB = MP / 64;
constexpr float ALPHA_F = 1.189207115002721f;
constexpr float LN_EPS_F = 1e-5f;

constexpr size_t O_YP = 0, O_YS = 16777216, O_KP = 17301504, O_VP = 17432576, O_KS = 17563648, O_VS = 19660800,
                 O_HRP = 21757952, O_HIP = 21774336, O_HRS = 21790720, O_HIS = 22052864, O_CP = 22315008, O_CS = 22360064;

constexpr size_t OFF_P = 0;
constexpr size_t OFF_H = 0;
constexpr size_t OFF_B = (size_t)MT * PW * 2;
constexpr size_t OFF_GY = OFF_B, OFF_O = OFF_B + (size_t)MT * 512 * 2;
constexpr size_t OFF_C = OFF_B + (size_t)MT * DM * 2;
constexpr size_t OFF_MG = OFF_C;
constexpr size_t OFF_X1B = OFF_C + (size_t)MT * DM * 2;
constexpr size_t OFF_KP = OFF_C + (size_t)MT * DM * 2;
constexpr size_t OFF_VTP = OFF_KP + (size_t)8 * 2048 * 128 * 2;
constexpr size_t OFF_KS = OFF_VTP + (size_t)8 * 2048 * 128 * 2;
constexpr size_t OFF_VTS = OFF_KS + (size_t)128 * 144 * 128 * 2;
constexpr size_t OFF_W = OFF_C + (size_t)MT * DM * 4;
constexpr size_t OFF_WIN = OFF_W;
constexpr size_t OFF_WGLU = OFF_WIN + (size_t)DIN * 1024 * 2;
constexpr size_t OFF_WATT = OFF_WGLU + (size_t)2048 * 512 * 2;
constexpr size_t OFF_WO = OFF_WATT + (size_t)1024 * 512 * 2;
constexpr size_t OFF_WUP = OFF_WO + (size_t)1024 * 1024 * 2;
constexpr size_t OFF_WDN = OFF_WUP + (size_t)5632 * 1024 * 2;
constexpr size_t OFF_SSM = OFF_WDN + (size_t)1024 * DFF * 2;
constexpr size_t OFF_AR = OFF_SSM, OFF_AI = OFF_SSM + 8192, OFF_BB = OFF_SSM + 16384;
constexpr size_t OFF_E = OFF_BB + 131072;
constexpr size_t OFF_HA0 = OFF_E + (size_t)8 * 32 * 16 * 128 * 4;
constexpr size_t OFF_HG0 = OFF_HA0 + (size_t)NRB * 2 * DFF * 4;
constexpr size_t OFF_HA1 = OFF_HG0 + (size_t)NRB * 2 * DFF * 4;
constexpr size_t WS_END = OFF_HA1 + (size_t)NRB * 2 * DFF * 4;
static_assert(OFF_VTS + (size_t)128 * 144 * 128 * 2 <= OFF_W, "KV overlay overflow");
static_assert(WS_END <= (size_t)256 * 1024 * 1024, "workspace too large");

constexpr size_t OFF_BAR = WS_END;
constexpr size_t WS_TOTAL = OFF_BAR + 16384;
static_assert(WS_TOTAL <= (size_t)256 * 1024 * 1024, "workspace too large");
constexpr size_t OFF_SLAB_WO = OFF_P;
constexpr size_t OFF_SLAB_DN = OFF_B;
static_assert((size_t)11 * MS * DM * 4 <= (size_t)MT * DM * 2, "down slabs must fit the X1b region");
constexpr size_t OFF_SLAB_GLU = OFF_KP;
constexpr size_t OFF_SLAB_ATT = OFF_KP + (size_t)4 * MS * 2048 * 4;
static_assert(OFF_SLAB_ATT + (size_t)4 * MS * DM * 4 <= OFF_W, "GLU/attn slabs must fit the dead K/V + x1 region");
constexpr size_t OFF_PRE1 = OFF_B;
constexpr size_t OFF_PRE2 = OFF_C;
constexpr int GEMM_LDS = 131072;
constexpr int LDS_BYTES = GEMM_LDS + 16;
constexpr int NTHR = 512, NWAVE = 8;

struct Params {
  const float* in[28];
  float* out;
  unsigned char* ws;
};

typedef __bf16 bf16v2_t __attribute__((ext_vector_type(2)));
typedef float f32x2 __attribute__((ext_vector_type(2)));
__device__ __forceinline__ unsigned pk2(float lo, float hi) { f32x2 v = {lo, hi}; bf16v2_t b = __builtin_convertvector(v, bf16v2_t); return __builtin_bit_cast(unsigned, b); }
__device__ __forceinline__ bf16_t f2bf(float x) { return (bf16_t)(pk2(x, 0.f) & 0xffffu); }
__device__ __forceinline__ float bf2f(unsigned v16) { return __uint_as_float(v16 << 16); }
__device__ __forceinline__ float bflo(unsigned w) { return __uint_as_float(w << 16); }
__device__ __forceinline__ float bfhi(unsigned w) { return __uint_as_float(w & 0xffff0000u); }
__device__ __forceinline__ float rcp_nr(float d) { const float r = __builtin_amdgcn_rcpf(d); return fmaf(r, fmaf(-d, r, 1.f), r); }
__device__ __forceinline__ float sigmoidf_(float x) { return rcp_nr(1.f + __expf(fminf(-x, 80.f))); }
__device__ __forceinline__ float gelu_tanh(float x) { float z = 1.5957691216057308f * (x + 0.044715f * x * x * x); return x * rcp_nr(1.f + __expf(fminf(-z, 80.f))); }
__device__ __forceinline__ float wave_sum(float v) {
#pragma unroll
  for (int o = 1; o < 64; o <<= 1) v += __shfl_xor(v, o);
  return v;
}
__device__ __forceinline__ u32x2 pk4(f32x4 v) { u32x2 r; r.x = pk2(v.x, v.y); r.y = pk2(v.z, v.w); return r; }
__device__ __forceinline__ f32x4 unpk4(u32x2 w) { f32x4 r; r.x = bflo(w.x); r.y = bfhi(w.x); r.z = bflo(w.y); r.w = bfhi(w.y); return r; }


#define LAS __attribute__((address_space(3)))
namespace pg8 {
constexpr int BM = 256, BK = 64, HALF = 128, HTB = HALF * BK * 2, NXCD = 8, WGM = 8;
__device__ __forceinline__ int lds_byte(int r, int c) { const int st = (r >> 4) * 2 + (c >> 5), rr = r & 15, cc = c & 31, ob = rr * 64 + cc * 2; return st * 1024 + (ob ^ (((ob >> 9) & 1) << 5)); }
__device__ __forceinline__ void stage_rc(int b, int& R, int& C) { const int st = b / 1024, sb = b % 1024, swz = sb ^ (((sb >> 9) & 1) << 5); R = (st >> 1) * 16 + swz / 64; C = (st & 1) * 32 + (swz % 64) / 2; }
struct Unit { int pm, pn, k0, nk, slice; };
struct StaticOrder {
    int nM, nN, nwg, G, c;
    __device__ __forceinline__ void init(int M, int N, int G_, int c_) { nM = M / BM; nN = N / BM; nwg = nM * nN; G = G_; c = c_; }
    int nsplit, nslice_items, nt, glu;
    __device__ __forceinline__ bool next(int i, int& pm, int& pn, int& k0, int& nk, int& slice, int& src) const {
        const long L = (long)i * G + c;
        pm = 0; pn = 0; k0 = 0; nk = nt; slice = -1; src = 0;
        if (L < nwg) {
            int wgid = (int)L; { const int q = nwg / NXCD, r = nwg % NXCD, xcd = wgid % NXCD, off = wgid / NXCD; wgid = (xcd < r ? xcd * (q + 1) : r * (q + 1) + (xcd - r) * q) + off; }
            const int nig = WGM * nN, gid = wgid / nig, fm = gid * WGM, gsz = (nM - fm) < WGM ? (nM - fm) : WGM;
            pm = fm + ((wgid % nig) % gsz); pn = (wgid % nig) / gsz; return true;
        }
        if (nsplit == 0) return false;
        int sidx = (int)(L - nwg);
        if (sidx >= nslice_items) return false;
        int ncol = nN;
        if (glu && sidx >= 64) { sidx -= 64; src = 1; ncol = 4; }
        const int tl = sidx / nsplit; slice = sidx - tl * nsplit; pm = 64 + tl / ncol; pn = tl % ncol; nk = nt / nsplit; k0 = slice * nk; return true;
    }
};
}

enum { EPI_IN = 0, EPI_GLU = 1, EPI_ATT = 2, EPI_WO = 3, EPI_UP = 4, EPI_DOWN = 5 };

__device__ __forceinline__ float dpp_ror1(float v) { return __int_as_float(__builtin_amdgcn_update_dpp(0, __float_as_int(v), 0x121, 0xf, 0xf, false)); }
__device__ __forceinline__ float dpp_ror2(float v) { return __int_as_float(__builtin_amdgcn_update_dpp(0, __float_as_int(v), 0x122, 0xf, 0xf, false)); }
__device__ __forceinline__ float dpp_shr1_old(float old, float v) { return __int_as_float(__builtin_amdgcn_update_dpp(__float_as_int(old), __float_as_int(v), 0x111, 0xf, 0xf, false)); }
__device__ __forceinline__ float dpp_shr2_old(float old, float v) { return __int_as_float(__builtin_amdgcn_update_dpp(__float_as_int(old), __float_as_int(v), 0x112, 0xf, 0xf, false)); }
__device__ __forceinline__ f32x4 shr1v(f32x4 o, f32x4 v) { return f32x4{dpp_shr1_old(o.x, v.x), dpp_shr1_old(o.y, v.y), dpp_shr1_old(o.z, v.z), dpp_shr1_old(o.w, v.w)}; }
__device__ __forceinline__ f32x4 shr2v(f32x4 o, f32x4 v) { return f32x4{dpp_shr2_old(o.x, v.x), dpp_shr2_old(o.y, v.y), dpp_shr2_old(o.z, v.z), dpp_shr2_old(o.w, v.w)}; }
__device__ __forceinline__ f32x4 ror1v(f32x4 v) { return f32x4{dpp_ror1(v.x), dpp_ror1(v.y), dpp_ror1(v.z), dpp_ror1(v.w)}; }
__device__ __forceinline__ f32x4 ror2v(f32x4 v) { return f32x4{dpp_ror2(v.x), dpp_ror2(v.y), dpp_ror2(v.z), dpp_ror2(v.w)}; }

template <int EPI>
__device__ __forceinline__ void epilogue(const Params& p, f32x4 (&acc)[2][2][4][2], const int pm, const int pn, const int wr, const int wc, const int fr, const int fq) {
  unsigned char* ws = p.ws;
  bf16_t* P = (bf16_t*)(ws + OFF_P);
  if constexpr (EPI == EPI_IN) {
    bf16_t* Kp = (bf16_t*)(ws + OFF_KP); bf16_t* Ks = (bf16_t*)(ws + OFF_KS);
    bf16_t* Vtp = (bf16_t*)(ws + OFF_VTP); bf16_t* Vts = (bf16_t*)(ws + OFF_VTS);
#pragma unroll
    for (int bj = 0; bj < 2; ++bj) {
      const int col0 = pn * 256 + bj * 128;
      const int col = col0 + wc * 32 + fq * 8;
#pragma unroll
      for (int ai = 0; ai < 2; ++ai)
#pragma unroll
        for (int m = 0; m < 4; ++m) {
          const int row = pm * 256 + ai * 128 + wr * 64 + m * 16 + fr;
          f32x4 v0 = acc[ai][bj][m][0], v1 = acc[ai][bj][m][1];
          if (col0 < 1024) {
            const u32x2 lo = pk4(v0), hi = pk4(v1);
            *(u32x4*)(P + (size_t)row * PW + col) = u32x4{lo.x, lo.y, hi.x, hi.y};
          } else if (col0 >= 1280) {
            v0.x = sigmoidf_(v0.x); v0.y = sigmoidf_(v0.y); v0.z = sigmoidf_(v0.z); v0.w = sigmoidf_(v0.w);
            v1.x = sigmoidf_(v1.x); v1.y = sigmoidf_(v1.y); v1.z = sigmoidf_(v1.z); v1.w = sigmoidf_(v1.w);
            const u32x2 lo = pk4(v0), hi = pk4(v1);
            *(u32x4*)(P + (size_t)row * PW + col - 256) = u32x4{lo.x, lo.y, hi.x, hi.y};
          } else if (col0 == 1024) {
            const int cc = col - 1024;
            const u32x2 lo = pk4(v0), hi = pk4(v1);
            if (row < MP) {
              *(u32x4*)(Kp + (size_t)row * 128 + cc) = u32x4{lo.x, lo.y, hi.x, hi.y};
              const int pos = row & 2047;
              if (pos >= 1920) { float* o = p.out + O_KP + ((size_t)(row >> 11) * 128 + (pos - 1920)) * 128 + cc; *(f32x4*)o = v0; *(f32x4*)(o + 4) = v1; }
            } else {
              const int sx = row - MP, b = sx >> 2, tt = sx & 3;
              *(u32x4*)(Ks + ((size_t)b * 144 + 128 + tt) * 128 + cc) = u32x4{lo.x, lo.y, hi.x, hi.y};
              float* o = p.out + O_KS + ((size_t)b * 128 + 124 + tt) * 128 + cc; *(f32x4*)o = v0; *(f32x4*)(o + 4) = v1;
            }
          } else {
            const int cc = col - 1152, kv = cc >> 6, d = cc & 63;
            if (row < MP) {
              const int b = row >> 11, pos = row & 2047;
              bf16_t* dst = Vtp + ((size_t)(b * 2 + kv) * 64 + d) * 2048 + pos;
              dst[0] = f2bf(v0.x); dst[2048] = f2bf(v0.y); dst[4096] = f2bf(v0.z); dst[6144] = f2bf(v0.w);
              dst[8192] = f2bf(v1.x); dst[10240] = f2bf(v1.y); dst[12288] = f2bf(v1.z); dst[14336] = f2bf(v1.w);
              if (pos >= 1920) { float* o = p.out + O_VP + ((size_t)b * 128 + (pos - 1920)) * 128 + cc; *(f32x4*)o = v0; *(f32x4*)(o + 4) = v1; }
            } else {
              const int sx = row - MP, b = sx >> 2, tt = sx & 3;
              bf16_t* dst = Vts + ((size_t)(b * 2 + kv) * 64 + d) * 144 + 128 + tt;
              dst[0] = f2bf(v0.x); dst[144] = f2bf(v0.y); dst[288] = f2bf(v0.z); dst[432] = f2bf(v0.w);
              dst[576] = f2bf(v1.x); dst[720] = f2bf(v1.y); dst[864] = f2bf(v1.z); dst[1008] = f2bf(v1.w);
              float* o = p.out + O_VS + ((size_t)b * 128 + 124 + tt) * 128 + cc; *(f32x4*)o = v0; *(f32x4*)(o + 4) = v1;
            }
          }
        }
    }
  } else if constexpr (EPI == EPI_GLU) {
    bf16_t* Mg = (bf16_t*)(ws + OFF_MG);
#pragma unroll
    for (int ai = 0; ai < 2; ++ai)
#pragma unroll
      for (int m = 0; m < 4; ++m) {
        const int row = pm * 256 + ai * 128 + wr * 64 + m * 16 + fr;
#pragma unroll
        for (int bj = 0; bj < 2; ++bj) {
          const int j0 = pn * 128 + bj * 64 + wc * 16 + fq * 4;
          const f32x4 ya = acc[ai][bj][m][0], yb = acc[ai][bj][m][1];
          const f32x4 gs = unpk4(*(const u32x2*)(P + (size_t)row * PW + 1024 + j0));
          f32x4 sv;
          sv.x = gs.x * ya.x * sigmoidf_(yb.x); sv.y = gs.y * ya.y * sigmoidf_(yb.y);
          sv.z = gs.z * ya.z * sigmoidf_(yb.z); sv.w = gs.w * ya.w * sigmoidf_(yb.w);
          *(u32x2*)(Mg + (size_t)row * DM + j0) = pk4(sv);
        }
      }
  } else if constexpr (EPI == EPI_ATT) {
    bf16_t* Mg = (bf16_t*)(ws + OFF_MG);
#pragma unroll
    for (int ai = 0; ai < 2; ++ai)
#pragma unroll
      for (int m = 0; m < 4; ++m) {
        const int row = pm * 256 + ai * 128 + wr * 64 + m * 16 + fr;
#pragma unroll
        for (int bj = 0; bj < 2; ++bj) {
          const int col = pn * 256 + bj * 128 + wc * 32 + fq * 8;
          const u32x4 gw4 = *(const u32x4*)(P + (size_t)row * PW + 2048 + col);
          const u32x4 sw4 = *(const u32x4*)(Mg + (size_t)row * DM + col);
          const f32x4 ga0 = unpk4(u32x2{gw4.x, gw4.y}), ga1 = unpk4(u32x2{gw4.z, gw4.w});
          const f32x4 s0 = unpk4(u32x2{sw4.x, sw4.y}), s1 = unpk4(u32x2{sw4.z, sw4.w});
          f32x4 v0 = acc[ai][bj][m][0], v1 = acc[ai][bj][m][1];
          v0.x = s0.x + ga0.x * v0.x; v0.y = s0.y + ga0.y * v0.y; v0.z = s0.z + ga0.z * v0.z; v0.w = s0.w + ga0.w * v0.w;
          v1.x = s1.x + ga1.x * v1.x; v1.y = s1.y + ga1.y * v1.y; v1.z = s1.z + ga1.z * v1.z; v1.w = s1.w + ga1.w * v1.w;
          const u32x2 lo = pk4(v0), hi = pk4(v1);
          *(u32x4*)(Mg + (size_t)row * DM + col) = u32x4{lo.x, lo.y, hi.x, hi.y};
        }
      }
  } else if constexpr (EPI == EPI_WO || EPI == EPI_DOWN) {
    const bf16_t* X1b = (const bf16_t*)(ws + OFF_X1B);
#pragma unroll
    for (int ai = 0; ai < 2; ++ai)
#pragma unroll
      for (int m = 0; m < 4; ++m) {
        const int row = pm * 256 + ai * 128 + wr * 64 + m * 16 + fr;
#pragma unroll
        for (int bj = 0; bj < 2; ++bj) {
          const int col = pn * 256 + bj * 128 + wc * 32 + fq * 8;
          f32x4 x0, x1;
          if constexpr (EPI == EPI_WO) { const float* xp = p.in[0] + (size_t)row * DM + col; x0 = *(const f32x4*)xp; x1 = *(const f32x4*)(xp + 4); }
          else { const u32x4 xw = *(const u32x4*)(X1b + (size_t)row * DM + col); x0 = unpk4(u32x2{xw.x, xw.y}); x1 = unpk4(u32x2{xw.z, xw.w}); }
          f32x4 v0 = acc[ai][bj][m][0], v1 = acc[ai][bj][m][1];
          v0.x += ALPHA_F * x0.x; v0.y += ALPHA_F * x0.y; v0.z += ALPHA_F * x0.z; v0.w += ALPHA_F * x0.w;
          v1.x += ALPHA_F * x1.x; v1.y += ALPHA_F * x1.y; v1.z += ALPHA_F * x1.z; v1.w += ALPHA_F * x1.w;
          const u32x2 lo = pk4(v0), hi = pk4(v1);
          *(u32x4*)((bf16_t*)(ws + (EPI == EPI_WO ? OFF_PRE1 : OFF_PRE2)) + (size_t)row * DM + col) = u32x4{lo.x, lo.y, hi.x, hi.y};
        }
      }
  } else {
    bf16_t* H = (bf16_t*)(ws + OFF_H);
    float* HA0 = (float*)(ws + OFF_HA0); float* HG0 = (float*)(ws + OFF_HG0); float* HA1 = (float*)(ws + OFF_HA1);
    const bool prompt = (pm < MP / 256);
#pragma unroll
    for (int bj = 0; bj < 2; ++bj) {
      const int j0 = pn * 128 + bj * 64 + wc * 16 + fq * 4;
      const f32x4 w0 = *(const f32x4*)(p.in[23] + j0), w1 = *(const f32x4*)(p.in[23] + DFF + j0), w2 = *(const f32x4*)(p.in[23] + 2 * DFF + j0);
      const f32x4 cb = *(const f32x4*)(p.in[24] + j0);
#pragma unroll
      for (int ai = 0; ai < 2; ++ai) {
        const int rblk = pm * 256 + ai * 128 + wr * 64;
#pragma unroll
        for (int m = 0; m < 4; ++m) {
          const int row = rblk + m * 16 + fr;
          const f32x4 a0 = acc[ai][bj][m][0], g = acc[ai][bj][m][1];
          f32x4 am1, am2; bool defer = false;
          if (prompt) {
            f32x4 o1 = f32x4{0.f, 0.f, 0.f, 0.f}, o2 = o1;
            if (m > 0) { o1 = ror1v(acc[ai][bj][m > 0 ? m - 1 : 0][0]); o2 = ror2v(acc[ai][bj][m > 0 ? m - 1 : 0][0]); }
            am1 = shr1v(o1, a0); am2 = shr2v(o2, a0);
            if (m == 0 && fr < 2 && (row & 2047) >= 2) defer = true;
            if (m == 3 && fr >= 14) *(f32x4*)(HA1 + ((size_t)(rblk >> 6) * 2 + (fr - 14)) * DFF + j0) = a0;
            const int pos = row & 2047;
            if (pos >= 2046) *(f32x4*)(p.out + O_CP + ((size_t)(row >> 11) * 2 + (pos - 2046)) * DFF + j0) = a0;
          } else {
            const int sidx = row - MP, b = sidx >> 2, tt = sidx & 3;
            const f32x4 st0 = *(const f32x4*)(p.in[6] + ((size_t)b * 2 + 0) * DFF + j0);
            const f32x4 st1 = *(const f32x4*)(p.in[6] + ((size_t)b * 2 + 1) * DFF + j0);
            const f32x4 s1 = ror1v(a0), s2 = ror2v(a0);
            am1 = (tt >= 1) ? s1 : st1;
            am2 = (tt >= 2) ? s2 : ((tt == 1) ? st1 : st0);
            if (tt >= 2) *(f32x4*)(p.out + O_CS + ((size_t)b * 2 + (tt - 2)) * DFF + j0) = a0;
          }
          if (!defer) {
            f32x4 h;
            h.x = gelu_tanh(cb.x + w0.x * am2.x + w1.x * am1.x + w2.x * a0.x) * g.x;
            h.y = gelu_tanh(cb.y + w0.y * am2.y + w1.y * am1.y + w2.y * a0.y) * g.y;
            h.z = gelu_tanh(cb.z + w0.z * am2.z + w1.z * am1.z + w2.z * a0.z) * g.z;
            h.w = gelu_tanh(cb.w + w0.w * am2.w + w1.w * am1.w + w2.w * a0.w) * g.w;
            *(u32x2*)(H + (size_t)row * DFF + j0) = pk4(h);
          } else {
            *(f32x4*)(HA0 + ((size_t)(rblk >> 6) * 2 + fr) * DFF + j0) = a0;
            *(f32x4*)(HG0 + ((size_t)(rblk >> 6) * 2 + fr) * DFF + j0) = g;
          }
        }
      }
    }
  }
}

template <int EPI>
__device__ __forceinline__ void gemm_phase(const Params& p, const bf16_t* __restrict__ gA, const bf16_t* __restrict__ gBt, const int K, const int N, LAS unsigned char* lds,
                                           const bf16_t* __restrict__ gA2 = nullptr, const bf16_t* __restrict__ gBt2 = nullptr) {
    using namespace pg8;
    int tid_ = threadIdx.x; asm volatile("" : "+v"(tid_));
    const int tid = tid_, wid = __builtin_amdgcn_readfirstlane(tid >> 6), lane = tid & 63, wr = wid >> 2, wc = wid & 3, fr = lane & 15, fq = lane >> 4;
    const int nt = K / BK;
    constexpr bool SPLIT = (EPI == EPI_WO || EPI == EPI_DOWN || EPI == EPI_GLU);
    constexpr bool PROMPT_ONLY = SPLIT || (EPI == EPI_ATT);
    constexpr int NSPLIT = (EPI == EPI_WO) ? 8 : (EPI == EPI_DOWN ? 11 : 4);
    StaticOrder S; S.init(PROMPT_ONLY ? MP : MT, N, gridDim.x, blockIdx.x);
    const int nN_ = N / BM;
    S.nt = nt; S.nsplit = SPLIT ? NSPLIT : 0; S.glu = (EPI == EPI_GLU) ? 1 : 0;
    S.nslice_items = (EPI == EPI_GLU) ? 96 : 2 * nN_ * NSPLIT;
    unsigned voff[2];
#pragma unroll
    for (int i = 0; i < 2; ++i) { int R, C; stage_rc(tid * 16 + i * 8192, R, C); voff[i] = (unsigned)(R * K + C) * 2u; }
    const size_t kstep = (size_t)(BK * 2);
    const size_t hstep = (size_t)HALF * K * 2;
    const size_t tstep = 2 * hstep;
    const unsigned ldsw = (unsigned)wid * 1024u;
    const int aoff = lds_byte(wr * 64 + fr, fq * 8), boff = lds_byte(wc * 32 + fr, fq * 8);
#define PG8_SA(b, h) (((b) * 2 + (h)) * HTB)
#define PG8_SB(b, h) ((4 + (b) * 2 + (h)) * HTB)
#define PG8_STAGE(bufoff, gbase) do { _Pragma("unroll") for (int _i = 0; _i < 2; ++_i) \
        __builtin_amdgcn_global_load_lds((const unsigned*)((const char*)(gbase) + voff[_i]), (LAS unsigned*)(lds + (bufoff) + ldsw + _i * 8192), 16, 0, 0); } while (0)
#define PG8_LDA(dst, b, h) do { _Pragma("unroll") for (int m = 0; m < 4; ++m) _Pragma("unroll") for (int k = 0; k < 2; ++k) dst[m][k] = *(const LAS bf16x8*)(lds + PG8_SA(b, h) + aoff + m * 2048 + k * 1024); } while (0)
#define PG8_LDB(dst, b, h) do { _Pragma("unroll") for (int n = 0; n < 2; ++n) _Pragma("unroll") for (int k = 0; k < 2; ++k) dst[n][k] = *(const LAS bf16x8*)(lds + PG8_SB(b, h) + boff + n * 2048 + k * 1024); } while (0)
#define PG8_MMA(ai, bj, At, Bt) do { __builtin_amdgcn_s_setprio(1); _Pragma("unroll") for (int m = 0; m < 4; ++m) _Pragma("unroll") for (int n = 0; n < 2; ++n) _Pragma("unroll") for (int k = 0; k < 2; ++k) \
        acc[ai][bj][m][n] = __builtin_amdgcn_mfma_f32_16x16x32_bf16(Bt[n][k], At[m][k], acc[ai][bj][m][n], 0, 0, 0); __builtin_amdgcn_s_setprio(0); } while (0)
#define PG8_WAIT_V(n) asm volatile("s_waitcnt vmcnt(" #n ")" ::: "memory")
#define PG8_WAIT_L(n) asm volatile("s_waitcnt lgkmcnt(" #n ")" ::: "memory")
#define PG8_BAR __builtin_amdgcn_s_barrier()
#define PG8_SCHED __builtin_amdgcn_sched_barrier(0)
    int ui = 0, cur_pm, cur_pn, cur_k0, cur_nk, cur_slice, cur_src, nxt_pm, nxt_pn, nxt_k0, nxt_nk, nxt_slice, nxt_src;
    if (!S.next(0, cur_pm, cur_pn, cur_k0, cur_nk, cur_slice, cur_src)) return;
    f32x4 acc[2][2][4][2];
#pragma unroll
    for (int a = 0; a < 2; ++a)
#pragma unroll
        for (int b = 0; b < 2; ++b)
#pragma unroll
            for (int m = 0; m < 4; ++m)
#pragma unroll
                for (int n = 0; n < 2; ++n) acc[a][b][m][n] = (f32x4){0.f, 0.f, 0.f, 0.f};
    bf16x8 At[4][2], B0[2][2], B1[2][2];
    const char* cA = (const char*)((EPI == EPI_GLU && cur_src) ? gA2 : gA) + (size_t)cur_pm * tstep + (size_t)cur_k0 * kstep;
    const char* cB = (const char*)((EPI == EPI_GLU && cur_src) ? gBt2 : gBt) + (size_t)cur_pn * tstep + (size_t)cur_k0 * kstep;
    PG8_STAGE(PG8_SB(0, 0), cB); PG8_STAGE(PG8_SB(0, 1), cB + hstep); PG8_STAGE(PG8_SA(0, 0), cA); PG8_STAGE(PG8_SA(0, 1), cA + hstep);
    if (wr == 1) PG8_BAR;
    PG8_WAIT_V(2); PG8_BAR;
    PG8_STAGE(PG8_SB(1, 0), cB + kstep); PG8_STAGE(PG8_SA(1, 0), cA + kstep); PG8_STAGE(PG8_SB(1, 1), cB + hstep + kstep);
    PG8_WAIT_V(6); PG8_BAR;
    for (;;) {
        const bool has_next = S.next(ui + 1, nxt_pm, nxt_pn, nxt_k0, nxt_nk, nxt_slice, nxt_src);
        const char* nA = has_next ? (const char*)((EPI == EPI_GLU && nxt_src) ? gA2 : gA) + (size_t)nxt_pm * tstep + (size_t)nxt_k0 * kstep : cA;
        const char* nB = has_next ? (const char*)((EPI == EPI_GLU && nxt_src) ? gBt2 : gBt) + (size_t)nxt_pn * tstep + (size_t)nxt_k0 * kstep : cB;
        const int cnk = cur_nk;
        for (int t = 0; t < cnk; t += 2) {
            const bool last = (t == cnk - 2);
            const char* a1 = cA + (size_t)(t + 1) * kstep;
            const char* a2 = last ? nA : cA + (size_t)(t + 2) * kstep; const char* b2 = last ? nB : cB + (size_t)(t + 2) * kstep;
            const char* a3 = a2 + kstep; const char* b3 = b2 + kstep;
            PG8_LDB(B0, 0, 0); PG8_LDB(B1, 0, 1); PG8_SCHED; PG8_LDA(At, 0, 0); PG8_STAGE(PG8_SA(1, 1), a1 + hstep);
            PG8_WAIT_V(8); PG8_WAIT_L(0); PG8_BAR; PG8_MMA(0, 0, At, B0); PG8_MMA(0, 1, At, B1); PG8_BAR; PG8_SCHED;
            PG8_LDA(At, 0, 1); PG8_STAGE(PG8_SB(0, 0), b2); PG8_STAGE(PG8_SB(0, 1), b2 + hstep); PG8_STAGE(PG8_SA(0, 0), a2);
            PG8_WAIT_V(8); PG8_WAIT_L(0); PG8_BAR; PG8_MMA(1, 0, At, B0); PG8_MMA(1, 1, At, B1); PG8_BAR; PG8_SCHED;
            PG8_LDB(B0, 1, 0); PG8_LDB(B1, 1, 1); PG8_SCHED; PG8_LDA(At, 1, 0); PG8_STAGE(PG8_SA(0, 1), a2 + hstep);
            PG8_WAIT_V(8); PG8_WAIT_L(0); PG8_BAR; PG8_MMA(0, 0, At, B0); PG8_MMA(0, 1, At, B1); PG8_BAR; PG8_SCHED;
            PG8_LDA(At, 1, 1); PG8_STAGE(PG8_SB(1, 0), b3); PG8_STAGE(PG8_SB(1, 1), b3 + hstep); PG8_STAGE(PG8_SA(1, 0), a3);
            PG8_WAIT_V(8); PG8_WAIT_L(0); PG8_BAR; PG8_MMA(1, 0, At, B0); PG8_MMA(1, 1, At, B1); PG8_BAR; PG8_SCHED;
        }
        if (wr == 0) PG8_BAR;
        if (SPLIT && cur_slice >= 0) {
            const int ldc = (EPI == EPI_GLU && cur_src == 0) ? 2048 : DM;
            float* SL = (float*)(p.ws + (EPI == EPI_WO ? OFF_SLAB_WO : (EPI == EPI_DOWN ? OFF_SLAB_DN : (cur_src ? OFF_SLAB_ATT : OFF_SLAB_GLU)))) + (size_t)cur_slice * MS * ldc;
#pragma unroll
            for (int ai = 0; ai < 2; ++ai)
#pragma unroll
                for (int m = 0; m < 4; ++m) {
                    const int rs = (cur_pm - 64) * 256 + ai * 128 + wr * 64 + m * 16 + fr;
#pragma unroll
                    for (int bj = 0; bj < 2; ++bj)
#pragma unroll
                        for (int n = 0; n < 2; ++n) *(f32x4*)(SL + (size_t)rs * ldc + cur_pn * 256 + bj * 128 + wc * 32 + ((EPI == EPI_GLU && cur_src == 0) ? (n * 16 + fq * 4) : (fq * 8 + n * 4))) = acc[ai][bj][m][n];
                }
        } else epilogue<EPI>(p, acc, cur_pm, cur_pn, wr, wc, fr, fq);
        if (!has_next) break;
#pragma unroll
        for (int a = 0; a < 2; ++a)
#pragma unroll
            for (int b = 0; b < 2; ++b)
#pragma unroll
                for (int m = 0; m < 4; ++m)
#pragma unroll
                    for (int n = 0; n < 2; ++n) acc[a][b][m][n] = (f32x4){0.f, 0.f, 0.f, 0.f};
        cur_pm = nxt_pm; cur_pn = nxt_pn; cur_k0 = nxt_k0; cur_nk = nxt_nk; cur_slice = nxt_slice; cur_src = nxt_src; cA = nA; cB = nB; ++ui;
        if (wr == 1) PG8_BAR;
    }
    PG8_WAIT_V(0);
    PG8_BAR;
#undef PG8_SA
#undef PG8_SB
#undef PG8_STAGE
#undef PG8_LDA
#undef PG8_LDB
#undef PG8_MMA
#undef PG8_WAIT_V
#undef PG8_WAIT_L
#undef PG8_BAR
#undef PG8_SCHED
}

template <int MODE>
__device__ __forceinline__ int dest_row(int n, int HH) {
  if (MODE == 0) return (n & ~31) + ((n >> 2) & 1) * 16 + ((n >> 3) & 3) * 4 + (n & 3);
  const int part = n >= HH ? 1 : 0, j = n - part * HH;
  const int tj = j >> 7, jl = j & 127, bj = jl >> 6, wcj = (jl >> 4) & 3, w = jl & 15;
  return tj * 256 + bj * 128 + wcj * 32 + part * 16 + w;
}
template <int MODE>
__device__ __forceinline__ void transpose_item(const float* __restrict__ W, int K, int N, bf16_t* __restrict__ WT, int HH, float* scr, int item, int lane) {
  const int nblk = N / 32, kb = item / nblk, nb = item - kb * nblk, k0 = 32 * kb, n0 = 32 * nb;
#pragma unroll 8
  for (int i = 0; i < 16; ++i) { const int kk = 2 * i + (lane >> 5); scr[kk * 33 + (lane & 31)] = W[(size_t)(k0 + kk) * N + n0 + (lane & 31)]; }
  asm volatile("s_waitcnt lgkmcnt(0)" ::: "memory");
  const int c = lane & 3;
#pragma unroll
  for (int j = 0; j < 2; ++j) {
    const int n = (lane >> 2) + 16 * j; const float* sp = scr + (8 * c) * 33 + n;
    u32x4 o; o.x = pk2(sp[0], sp[33]); o.y = pk2(sp[66], sp[99]); o.z = pk2(sp[132], sp[165]); o.w = pk2(sp[198], sp[231]);
    *(u32x4*)(WT + (size_t)dest_row<MODE>(n0 + n, HH) * K + k0 + 8 * c) = o;
  }
  asm volatile("s_waitcnt lgkmcnt(0)" ::: "memory");
}

__device__ __forceinline__ void prep_phase(const Params& p, char* lds) {
  unsigned char* ws = p.ws;
  const int tid = threadIdx.x, lane = tid & 63, wid = tid >> 6;
  const int gt = blockIdx.x * NTHR + tid, NGT = gridDim.x * NTHR;
  const int gw = blockIdx.x * NWAVE + wid, NGW = gridDim.x * NWAVE;
  {
    bf16_t* Xb = (bf16_t*)(ws + OFF_B);
    const int nchunk = MT * DM / 8, npc = MP * DM / 8;
    const int nmain = (nchunk / (4 * NGT)) * (4 * NGT);
    for (int i0 = gt; i0 < nmain / 4; i0 += NGT) {
      f32x4 a[4], b[4];
#pragma unroll
      for (int q = 0; q < 4; ++q) {
        const int i = i0 + q * (nmain / 4);
        const float* sp = (i < npc) ? p.in[0] + (size_t)i * 8 : p.in[1] + (size_t)(i - npc) * 8;
        a[q] = *(const f32x4*)sp; b[q] = *(const f32x4*)(sp + 4);
      }
#pragma unroll
      for (int q = 0; q < 4; ++q) {
        const int i = i0 + q * (nmain / 4);
        u32x4 o; o.x = pk2(a[q].x, a[q].y); o.y = pk2(a[q].z, a[q].w); o.z = pk2(b[q].x, b[q].y); o.w = pk2(b[q].z, b[q].w);
        *(u32x4*)(Xb + (size_t)i * 8) = o;
      }
    }
    for (int i = nmain + gt; i < nchunk; i += NGT) {
      const float* sp = (i < npc) ? p.in[0] + (size_t)i * 8 : p.in[1] + (size_t)(i - npc) * 8;
      const f32x4 a = *(const f32x4*)sp, b = *(const f32x4*)(sp + 4);
      u32x4 o; o.x = pk2(a.x, a.y); o.y = pk2(a.z, a.w); o.z = pk2(b.x, b.y); o.w = pk2(b.z, b.w);
      *(u32x4*)(Xb + (size_t)i * 8) = o;
    }
  }
  {
    float* scr = (float*)(lds + wid * 8704);
    constexpr int I_IN = 32 * 104, I_GLU = 16 * 64, I_ATT = 16 * 32, I_O = 32 * 32, I_UP = 32 * 176, I_DN = 88 * 32;
    constexpr int NIT = I_IN + I_GLU + I_ATT + I_O + I_UP + I_DN;
    for (int it = gw; it < NIT; it += NGW) {
      int r = it;
      if (r < I_IN) { transpose_item<0>(p.in[7], 1024, DIN, (bf16_t*)(ws + OFF_WIN), 0, scr, r, lane); continue; } r -= I_IN;
      if (r < I_GLU) { transpose_item<1>(p.in[16], 512, 2048, (bf16_t*)(ws + OFF_WGLU), 1024, scr, r, lane); continue; } r -= I_GLU;
      if (r < I_ATT) { transpose_item<0>(p.in[18], 512, 1024, (bf16_t*)(ws + OFF_WATT), 0, scr, r, lane); continue; } r -= I_ATT;
      if (r < I_O) { transpose_item<0>(p.in[19], 1024, 1024, (bf16_t*)(ws + OFF_WO), 0, scr, r, lane); continue; } r -= I_O;
      if (r < I_UP) { transpose_item<1>(p.in[22], 1024, 5632, (bf16_t*)(ws + OFF_WUP), DFF, scr, r, lane); continue; } r -= I_UP;
      transpose_item<0>(p.in[25], DFF, 1024, (bf16_t*)(ws + OFF_WDN), 0, scr, r, lane);
    }
  }
  {
    bf16_t* Ks = (bf16_t*)(ws + OFF_KS); bf16_t* Vts = (bf16_t*)(ws + OFF_VTS);
    const float* ck = p.in[2]; const float* cv = p.in[3];
    for (int i = gt; i < 128 * 128 * 16; i += NGT) {
      const int c8 = i & 15, w = (i >> 4) & 127, b = i >> 11;
      const float* s = ck + ((size_t)b * 128 + w) * 128 + c8 * 8;
      const f32x4 a = *(const f32x4*)s, bq = *(const f32x4*)(s + 4);
      u32x4 o; o.x = pk2(a.x, a.y); o.y = pk2(a.z, a.w); o.z = pk2(bq.x, bq.y); o.w = pk2(bq.z, bq.w);
      *(u32x4*)(Ks + ((size_t)b * 144 + w) * 128 + c8 * 8) = o;
    }
    for (int i = gt; i < 128 * 12 * 16; i += NGT) {
      const int c8 = i & 15, r = (i >> 4) % 12, b = i / 192;
      *(u32x4*)(Ks + ((size_t)b * 144 + 132 + r) * 128 + c8 * 8) = u32x4{0u, 0u, 0u, 0u};
    }
    for (int i = gt; i < 128 * 16 * 128; i += NGT) {
      const int kvd = i & 127, w8 = (i >> 7) & 15, b = i >> 11;
      const float* s = cv + ((size_t)b * 128 + w8 * 8) * 128 + kvd;
      u32x4 o; o.x = pk2(s[0], s[128]); o.y = pk2(s[256], s[384]); o.z = pk2(s[512], s[640]); o.w = pk2(s[768], s[896]);
      *(u32x4*)(Vts + ((size_t)b * 128 + kvd) * 144 + w8 * 8) = o;
    }
    for (int i = gt; i < 128 * 128 * 3; i += NGT) {
      const int q = i % 3, r = i / 3;
      *(u32x2*)(Vts + (size_t)r * 144 + 132 + q * 4) = u32x2{0u, 0u};
    }
    for (int i = gt; i < 128 * 124 * 32; i += NGT) {
      const int c4 = i & 31, w = (i >> 5) % 124, b = i / (124 * 32);
      const size_t so = ((size_t)b * 128 + w + 4) * 128 + c4 * 4, dof = ((size_t)b * 128 + w) * 128 + c4 * 4;
      *(f32x4*)(p.out + O_KS + dof) = *(const f32x4*)(ck + so);
      *(f32x4*)(p.out + O_VS + dof) = *(const f32x4*)(cv + so);
    }
  }
  {
    float* AR = (float*)(ws + OFF_AR); float* AI = (float*)(ws + OFF_AI); bf16_t* BB = (bf16_t*)(ws + OFF_BB);
    for (int i = gt; i < 2048; i += NGT) {
      const int g = i >> 6, pp = i & 63;
      const float lr = p.in[8][i], li = p.in[9][i], dt = expf(p.in[10][g]);
      const float mag = expf(lr * dt), ang = li * dt;
      const float abr = mag * cosf(ang), abi = mag * sinf(ang);
      const float den = lr * lr + li * li, nr = abr - 1.f;
      const float cr = (nr * lr + abi * li) / den, ci = (abi * lr - nr * li) / den;
      AR[i] = abr; AI[i] = abi;
      const float* br = p.in[11] + (size_t)i * 16; const float* bi = p.in[12] + (size_t)i * 16;
      bf16_t* dre = BB + ((size_t)g * 128 + pp) * 16; bf16_t* dim_ = BB + ((size_t)g * 128 + 64 + pp) * 16;
#pragma unroll
      for (int c = 0; c < 16; ++c) {
        dre[c] = f2bf(cr * br[c] - ci * bi[c]);
        dim_[c] = f2bf(cr * bi[c] + ci * br[c]);
      }
    }
  }
}

#define CMUL_ACC(dr, di, ar_, ai_, br_, bi_) do { const float t_r = (ar_) * (br_) - (ai_) * (bi_); const float t_i = (ar_) * (bi_) + (ai_) * (br_); dr += t_r; di += t_i; } while (0)

template <int MODE>
__device__ __forceinline__ void scan_unit(const Params& p, int u, int lane, bf16_t* Hs) {
  unsigned char* ws = p.ws;
  const int pl = lane & 15, q4 = lane >> 4;
  const bf16_t* P = (const bf16_t*)(ws + OFF_P);
  const float* AR = (const float*)(ws + OFF_AR); const float* AI = (const float*)(ws + OFF_AI);
  const bf16_t* BB = (const bf16_t*)(ws + OFF_BB);
  float* E = (float*)(ws + OFF_E);
  int g, s = 0, c = 0, R0, ntile;
  if (MODE == 2) { g = u & 31; const int ti = u >> 5; R0 = MP + ti * 16; ntile = 1; s = ti; }
  else { c = u & 15; g = (u >> 4) & 31; s = u >> 9; R0 = s * 2048 + c * 128; ntile = 8; }
  float ar[4], ai[4], a4r[4], a4i[4], a8r[4], a8i[4], a128r[4], a128i[4];
#pragma unroll
  for (int q = 0; q < 4; ++q) {
    const float r1 = AR[g * 64 + q * 16 + pl], i1 = AI[g * 64 + q * 16 + pl];
    ar[q] = r1; ai[q] = i1;
    const float r2 = r1 * r1 - i1 * i1, i2 = 2.f * r1 * i1;
    const float r4 = r2 * r2 - i2 * i2, i4 = 2.f * r2 * i2;
    const float r8 = r4 * r4 - i4 * i4, i8 = 2.f * r4 * i4;
    a4r[q] = r4; a4i[q] = i4; a8r[q] = r8; a8i[q] = i8;
    const float r16 = r8 * r8 - i8 * i8, i16 = 2.f * r8 * i8;
    const float r32 = r16 * r16 - i16 * i16, i32 = 2.f * r16 * i16;
    const float r64 = r32 * r32 - i32 * i32, i64 = 2.f * r32 * i32;
    a128r[q] = r64 * r64 - i64 * i64; a128i[q] = 2.f * r64 * i64;
  }
  bf16x4 bb[8];
#pragma unroll
  for (int pt = 0; pt < 8; ++pt) bb[pt] = *(const bf16x4*)(BB + ((size_t)g * 128 + pt * 16 + pl) * 16 + q4 * 4);
  bf16x8 cm[4]; bf16x4 dmv;
  if (MODE != 0) {
#pragma unroll
    for (int ks = 0; ks < 4; ++ks) {
      const float* src = ((ks < 2) ? p.in[13] : p.in[14]) + ((size_t)g * 16 + pl) * 64 + (ks & 1) * 32 + q4 * 8;
      const float sg = (ks < 2) ? 1.f : -1.f;
      const f32x4 x0 = *(const f32x4*)src, x1 = *(const f32x4*)(src + 4);
      u32x4 o; o.x = pk2(sg * x0.x, sg * x0.y); o.y = pk2(sg * x0.z, sg * x0.w); o.z = pk2(sg * x1.x, sg * x1.y); o.w = pk2(sg * x1.z, sg * x1.w);
      cm[ks] = __builtin_bit_cast(bf16x8, o);
    }
    const float dv = p.in[15][g * 16 + pl];
    u32x2 o;
    o.x = pk2((q4 * 4 + 0 == pl) ? dv : 0.f, (q4 * 4 + 1 == pl) ? dv : 0.f);
    o.y = pk2((q4 * 4 + 2 == pl) ? dv : 0.f, (q4 * 4 + 3 == pl) ? dv : 0.f);
    dmv = __builtin_bit_cast(bf16x4, o);
  }
  float hr[4], hi[4];
#pragma unroll
  for (int q = 0; q < 4; ++q) { hr[q] = 0.f; hi[q] = 0.f; }
  if (MODE == 1) {
    const float* Eb = E + ((size_t)(s * 32 + g) * 16) * 128;
#pragma unroll
    for (int bt = 0; bt < 3; ++bt) {
      if (bt * 5 < c) {
        float er[5][4], ei[5][4];
#pragma unroll
        for (int k = 0; k < 5; ++k)
#pragma unroll
          for (int q = 0; q < 4; ++q) { er[k][q] = Eb[(bt * 5 + k) * 128 + q * 16 + pl]; ei[k][q] = Eb[(bt * 5 + k) * 128 + 64 + q * 16 + pl]; }
#pragma unroll
        for (int k = 0; k < 5; ++k) {
          const bool on = (bt * 5 + k) < c;
#pragma unroll
          for (int q = 0; q < 4; ++q) {
            const float nr_ = a128r[q] * hr[q] - a128i[q] * hi[q] + er[k][q];
            const float ni_ = a128r[q] * hi[q] + a128i[q] * hr[q] + ei[k][q];
            hr[q] = on ? nr_ : hr[q]; hi[q] = on ? ni_ : hi[q];
          }
        }
      }
    }
  }
  if (MODE == 2) {
    const int b = s * 4 + q4;
#pragma unroll
    for (int q = 0; q < 4; ++q) {
      hr[q] = p.in[4][((size_t)b * 32 + g) * 64 + q * 16 + pl];
      hi[q] = p.in[5][((size_t)b * 32 + g) * 64 + q * 16 + pl];
    }
  }
  const bf16_t* up = P + (size_t)(R0 + pl) * PW + g * 16 + q4 * 4;
  bf16x4 uf_next = *(const bf16x4*)up;
#pragma unroll 2
  for (int tile = 0; tile < ntile; ++tile) {
    const int Rt = R0 + tile * 16;
    const bf16x4 uf = uf_next;
    if (tile + 1 < ntile) uf_next = *(const bf16x4*)(up + (size_t)(tile + 1) * 16 * PW);
    f32x4 xr[4], xi[4];
    const f32x4 z4 = f32x4{0.f, 0.f, 0.f, 0.f};
#pragma unroll
    for (int q = 0; q < 4; ++q) {
      xr[q] = __builtin_amdgcn_mfma_f32_16x16x16bf16_1k(uf, bb[q], z4, 0, 0, 0);
      xi[q] = __builtin_amdgcn_mfma_f32_16x16x16bf16_1k(uf, bb[q + 4], z4, 0, 0, 0);
    }
#pragma unroll
    for (int q = 0; q < 4; ++q) {
      float s0r = xr[q].x, s0i = xi[q].x, s1r = xr[q].y, s1i = xi[q].y, s2r = xr[q].z, s2i = xi[q].z, s3r = xr[q].w, s3i = xi[q].w;
      if (MODE == 2 || q4 == 0) CMUL_ACC(s0r, s0i, ar[q], ai[q], hr[q], hi[q]);
      CMUL_ACC(s1r, s1i, ar[q], ai[q], s0r, s0i);
      CMUL_ACC(s2r, s2i, ar[q], ai[q], s1r, s1i);
      CMUL_ACC(s3r, s3i, ar[q], ai[q], s2r, s2i);
      if (MODE != 2) {
        float Ir = s3r, Ii = s3i;
        float tr = __shfl_up(Ir, 16), ti = __shfl_up(Ii, 16);
        if (q4 >= 1) CMUL_ACC(Ir, Ii, a4r[q], a4i[q], tr, ti);
        tr = __shfl_up(Ir, 32); ti = __shfl_up(Ii, 32);
        if (q4 >= 2) CMUL_ACC(Ir, Ii, a8r[q], a8i[q], tr, ti);
        float cr = __shfl_up(Ir, 16), ci = __shfl_up(Ii, 16);
        if (q4 == 0) { cr = 0.f; ci = 0.f; }
        float t1r = ar[q] * cr - ai[q] * ci, t1i = ar[q] * ci + ai[q] * cr; s0r += t1r; s0i += t1i;
        float t2r = ar[q] * t1r - ai[q] * t1i, t2i = ar[q] * t1i + ai[q] * t1r; s1r += t2r; s1i += t2i;
        float t3r = ar[q] * t2r - ai[q] * t2i, t3i = ar[q] * t2i + ai[q] * t2r; s2r += t3r; s2i += t3i;
        float t4r = ar[q] * t3r - ai[q] * t3i, t4i = ar[q] * t3i + ai[q] * t3r; s3r += t4r; s3i += t4i;
        hr[q] = __shfl(s3r, 48 + pl); hi[q] = __shfl(s3i, 48 + pl);
      } else {
        hr[q] = s3r; hi[q] = s3i;
      }
      xr[q] = f32x4{s0r, s1r, s2r, s3r}; xi[q] = f32x4{s0i, s1i, s2i, s3i};
    }
    if (MODE != 0) {
#pragma unroll
      for (int q = 0; q < 4; ++q) {
        Hs[(q4 * 4 + 0) * 136 + q * 16 + pl] = f2bf(xr[q].x); Hs[(q4 * 4 + 1) * 136 + q * 16 + pl] = f2bf(xr[q].y);
        Hs[(q4 * 4 + 2) * 136 + q * 16 + pl] = f2bf(xr[q].z); Hs[(q4 * 4 + 3) * 136 + q * 16 + pl] = f2bf(xr[q].w);
        Hs[(q4 * 4 + 0) * 136 + 64 + q * 16 + pl] = f2bf(xi[q].x); Hs[(q4 * 4 + 1) * 136 + 64 + q * 16 + pl] = f2bf(xi[q].y);
        Hs[(q4 * 4 + 2) * 136 + 64 + q * 16 + pl] = f2bf(xi[q].z); Hs[(q4 * 4 + 3) * 136 + 64 + q * 16 + pl] = f2bf(xi[q].w);
      }
      asm volatile("s_waitcnt lgkmcnt(0)" ::: "memory");
      f32x4 y = z4;
#pragma unroll
      for (int ks = 0; ks < 4; ++ks) {
        const bf16x8 hf = *(const bf16x8*)(Hs + pl * 136 + ks * 32 + q4 * 8);
        y = __builtin_amdgcn_mfma_f32_16x16x32_bf16(hf, cm[ks], y, 0, 0, 0);
      }
      y = __builtin_amdgcn_mfma_f32_16x16x16bf16_1k(uf, dmv, y, 0, 0, 0);
      asm volatile("s_waitcnt lgkmcnt(0)" ::: "memory");
      bf16_t* GY = (bf16_t*)(ws + OFF_GY);
      bf16_t* dst = GY + (size_t)(Rt + q4 * 4) * 512 + g * 16 + pl;
      dst[0] = f2bf(gelu_tanh(y.x)); dst[512] = f2bf(gelu_tanh(y.y)); dst[1024] = f2bf(gelu_tanh(y.z)); dst[1536] = f2bf(gelu_tanh(y.w));
    }
  }
  if (MODE == 0) {
    if (q4 == 0) {
      float* Eb = E + ((size_t)(s * 32 + g) * 16 + c) * 128;
#pragma unroll
      for (int q = 0; q < 4; ++q) { Eb[q * 16 + pl] = hr[q]; Eb[64 + q * 16 + pl] = hi[q]; }
    }
  } else if (MODE == 1) {
    if (c == 15 && q4 == 0) {
#pragma unroll
      for (int q = 0; q < 4; ++q) {
        p.out[O_HRP + ((size_t)s * 32 + g) * 64 + q * 16 + pl] = hr[q];
        p.out[O_HIP + ((size_t)s * 32 + g) * 64 + q * 16 + pl] = hi[q];
      }
    }
  } else {
    const int b = s * 4 + q4;
#pragma unroll
    for (int q = 0; q < 4; ++q) {
      p.out[O_HRS + ((size_t)b * 32 + g) * 64 + q * 16 + pl] = hr[q];
      p.out[O_HIS + ((size_t)b * 32 + g) * 64 + q * 16 + pl] = hi[q];
    }
  }
}

__device__ __forceinline__ void scan_end_unit(const Params& p, int u, int lane) {
  unsigned char* ws = p.ws;
  const int pl = lane & 15, q4 = lane >> 4;
  const bf16_t* P = (const bf16_t*)(ws + OFF_P);
  const float* AR = (const float*)(ws + OFF_AR); const float* AI = (const float*)(ws + OFF_AI);
  const bf16_t* BB = (const bf16_t*)(ws + OFF_BB);
  float* E = (float*)(ws + OFF_E);
  const int c = u & 15, g = (u >> 4) & 31, s = u >> 9, R0 = s * 2048 + c * 128;
  float ar[4], ai[4], wr_[4], wi_[4], a16r[4], a16i[4];
#pragma unroll
  for (int q = 0; q < 4; ++q) {
    const float r1 = AR[g * 64 + q * 16 + pl], i1 = AI[g * 64 + q * 16 + pl];
    ar[q] = r1; ai[q] = i1;
    const float r2 = r1 * r1 - i1 * i1, i2 = 2.f * r1 * i1;
    const float r4 = r2 * r2 - i2 * i2, i4 = 2.f * r2 * i2;
    const float r8 = r4 * r4 - i4 * i4, i8 = 2.f * r4 * i4;
    const float r12 = r8 * r4 - i8 * i4, i12 = r8 * i4 + i8 * r4;
    a16r[q] = r8 * r8 - i8 * i8; a16i[q] = 2.f * r8 * i8;
    wr_[q] = (q4 == 0) ? r12 : (q4 == 1) ? r8 : (q4 == 2) ? r4 : 1.f;
    wi_[q] = (q4 == 0) ? i12 : (q4 == 1) ? i8 : (q4 == 2) ? i4 : 0.f;
  }
  bf16x4 bb[8];
#pragma unroll
  for (int pt = 0; pt < 8; ++pt) bb[pt] = *(const bf16x4*)(BB + ((size_t)g * 128 + pt * 16 + pl) * 16 + q4 * 4);
  float er[4], ei[4];
#pragma unroll
  for (int q = 0; q < 4; ++q) { er[q] = 0.f; ei[q] = 0.f; }
  const bf16_t* up = P + (size_t)(R0 + pl) * PW + g * 16 + q4 * 4;
  bf16x4 uf_next = *(const bf16x4*)up;
  const f32x4 z4 = f32x4{0.f, 0.f, 0.f, 0.f};
#pragma unroll 2
  for (int tile = 0; tile < 8; ++tile) {
    const bf16x4 uf = uf_next;
    if (tile + 1 < 8) uf_next = *(const bf16x4*)(up + (size_t)(tile + 1) * 16 * PW);
#pragma unroll
    for (int q = 0; q < 4; ++q) {
      const f32x4 xr = __builtin_amdgcn_mfma_f32_16x16x16bf16_1k(uf, bb[q], z4, 0, 0, 0);
      const f32x4 xi = __builtin_amdgcn_mfma_f32_16x16x16bf16_1k(uf, bb[q + 4], z4, 0, 0, 0);
      float tr = xr.x, ti = xi.x, nr_, ni_;
      nr_ = ar[q] * tr - ai[q] * ti + xr.y; ni_ = ar[q] * ti + ai[q] * tr + xi.y; tr = nr_; ti = ni_;
      nr_ = ar[q] * tr - ai[q] * ti + xr.z; ni_ = ar[q] * ti + ai[q] * tr + xi.z; tr = nr_; ti = ni_;
      nr_ = ar[q] * tr - ai[q] * ti + xr.w; ni_ = ar[q] * ti + ai[q] * tr + xi.w; tr = nr_; ti = ni_;
      float sr = wr_[q] * tr - wi_[q] * ti, si = wr_[q] * ti + wi_[q] * tr;
      sr += __shfl_xor(sr, 16); si += __shfl_xor(si, 16);
      sr += __shfl_xor(sr, 32); si += __shfl_xor(si, 32);
      nr_ = a16r[q] * er[q] - a16i[q] * ei[q] + sr; ni_ = a16r[q] * ei[q] + a16i[q] * er[q] + si;
      er[q] = nr_; ei[q] = ni_;
    }
  }
  if (q4 == 0) {
    float* Eb = E + ((size_t)(s * 32 + g) * 16 + c) * 128;
#pragma unroll
    for (int q = 0; q < 4; ++q) { Eb[q * 16 + pl] = er[q]; Eb[64 + q * 16 + pl] = ei[q]; }
  }
}

template <bool LDSRC>
__device__ __forceinline__ void attn_core(const Params& p, const int lane, const char* kptr, const int kstride, const char* vptr, const int vstride,
                                          const int kt0, const int has_prev, const int row_q, const int h_q, const int i_q) {
  unsigned char* ws = p.ws;
  const int pl = lane & 15, q4 = lane >> 4;
  const bf16_t* P = (const bf16_t*)(ws + OFF_P);
  const float sink = p.in[17][h_q];
  const bf16_t* qp = P + (size_t)row_q * PW + 512 + h_q * 64 + q4 * 8;
  const bf16x8 qf0 = *(const bf16x8*)qp, qf1 = *(const bf16x8*)(qp + 32);
  u32x4 vfr[LDSRC ? 1 : 5][4];
  if constexpr (!LDSRC) {
#pragma unroll
    for (int pp = 0; pp < 5; ++pp) {
      int TA = kt0 + 2 * pp, TB = kt0 + ((2 * pp + 1 < 9) ? 2 * pp + 1 : 2 * pp);
      if (!has_prev) { if (TA < 8) TA = 8; if (TB < 8) TB = 8; }
#pragma unroll
      for (int dt = 0; dt < 4; ++dt) {
        const char* vp = vptr + (dt * 16 + pl) * vstride + q4 * 8;
        const u32x2 va = *(const u32x2*)(vp + TA * 32), vb = *(const u32x2*)(vp + TB * 32);
        vfr[pp][dt] = u32x4{va.x, va.y, vb.x, vb.y};
      }
    }
  }
  f32x4 sa[9];
#pragma unroll
  for (int kt = 0; kt < 9; ++kt) {
    int T = kt0 + kt; if (!has_prev && T < 8) T = 8;
    const char* kp = kptr + (T * 16 + pl) * kstride + q4 * 16;
    bf16x8 k0, k1;
    if constexpr (LDSRC) { k0 = *(const LAS bf16x8*)(const LAS char*)kp; k1 = *(const LAS bf16x8*)(const LAS char*)(kp + 64); }
    else { k0 = *(const bf16x8*)kp; k1 = *(const bf16x8*)(kp + 64); }
    f32x4 a = f32x4{0.f, 0.f, 0.f, 0.f};
    a = __builtin_amdgcn_mfma_f32_16x16x32_bf16(k0, qf0, a, 0, 0, 0);
    a = __builtin_amdgcn_mfma_f32_16x16x32_bf16(k1, qf1, a, 0, 0, 0);
    sa[kt] = a;
  }
  const int lo = has_prev ? (i_q + 1) : ((i_q + 1) > 128 ? (i_q + 1) : 128);
  const unsigned span = (unsigned)(i_q + 128 - lo);
  const int dbase = q4 * 4 - lo;
  float mx = -INFINITY;
#pragma unroll
  for (int kt = 0; kt < 9; ++kt) {
#pragma unroll
    for (int r = 0; r < 4; ++r) {
      const int d = (kt0 + kt) * 16 + r + dbase;
      const float v = ((unsigned)d <= span) ? sa[kt][r] : -INFINITY;
      sa[kt][r] = v; mx = fmaxf(mx, v);
    }
  }
  mx = fmaxf(mx, __shfl_xor(mx, 16)); mx = fmaxf(mx, __shfl_xor(mx, 32));
  const float mfin = fmaxf(mx * 0.125f, sink);
  const float cl = 0.125f * 1.4426950408889634f, ml = mfin * 1.4426950408889634f;
  float sum = 0.f;
#pragma unroll
  for (int kt = 0; kt < 9; ++kt) {
#pragma unroll
    for (int r = 0; r < 4; ++r) { const float e = __builtin_amdgcn_exp2f(fmaf(sa[kt][r], cl, -ml)); sa[kt][r] = e; sum += e; }
  }
  sum += __shfl_xor(sum, 16); sum += __shfl_xor(sum, 32);
  const float inv = 1.f / (sum + __builtin_amdgcn_exp2f((sink - mfin) * 1.4426950408889634f));
  f32x4 oa[4];
#pragma unroll
  for (int dt = 0; dt < 4; ++dt) oa[dt] = f32x4{0.f, 0.f, 0.f, 0.f};
#pragma unroll
  for (int pp = 0; pp < 5; ++pp) {
    const int kA = 2 * pp, kB = (2 * pp + 1 < 9) ? 2 * pp + 1 : 2 * pp;
    u32x4 pw;
    pw.x = pk2(sa[kA][0] * inv, sa[kA][1] * inv); pw.y = pk2(sa[kA][2] * inv, sa[kA][3] * inv);
    if (2 * pp + 1 < 9) { pw.z = pk2(sa[kB][0] * inv, sa[kB][1] * inv); pw.w = pk2(sa[kB][2] * inv, sa[kB][3] * inv); }
    else { pw.z = 0u; pw.w = 0u; }
    const bf16x8 pf = __builtin_bit_cast(bf16x8, pw);
    if constexpr (LDSRC) {
      int TA = kt0 + 2 * pp, TB = kt0 + ((2 * pp + 1 < 9) ? 2 * pp + 1 : 2 * pp);
      if (!has_prev) { if (TA < 8) TA = 8; if (TB < 8) TB = 8; }
#pragma unroll
      for (int dt = 0; dt < 4; ++dt) {
        const char* vp = vptr + (dt * 16 + pl) * vstride + q4 * 8;
        const u32x2 va = *(const LAS u32x2*)(const LAS char*)(vp + TA * 32), vb = *(const LAS u32x2*)(const LAS char*)(vp + TB * 32);
        oa[dt] = __builtin_amdgcn_mfma_f32_16x16x32_bf16(__builtin_bit_cast(bf16x8, u32x4{va.x, va.y, vb.x, vb.y}), pf, oa[dt], 0, 0, 0);
      }
    } else {
#pragma unroll
      for (int dt = 0; dt < 4; ++dt) oa[dt] = __builtin_amdgcn_mfma_f32_16x16x32_bf16(__builtin_bit_cast(bf16x8, vfr[pp][dt]), pf, oa[dt], 0, 0, 0);
    }
  }
  bf16_t* O = (bf16_t*)(ws + OFF_O);
#pragma unroll
  for (int dt = 0; dt < 4; ++dt) *(u32x2*)(O + (size_t)row_q * 512 + h_q * 64 + dt * 16 + q4 * 4) = pk4(oa[dt]);
}

__device__ __forceinline__ void attn_sample_unit(const Params& p, int us, int lane) {
  const int pl = lane & 15, kv = us & 1, b = us >> 1, tt = pl >> 2, g = pl & 3;
  const bf16_t* Ks = (const bf16_t*)(p.ws + OFF_KS); const bf16_t* Vts = (const bf16_t*)(p.ws + OFF_VTS);
  attn_core<false>(p, lane, (const char*)(Ks + (size_t)b * 144 * 128 + kv * 64), 256, (const char*)(Vts + (size_t)(b * 2 + kv) * 64 * 144), 288,
                   0, 1, MP + b * 4 + tt, kv * 4 + g, tt);
}

constexpr int ATT_KSTR = 144, ATT_VSTR = 528, ATT_VOFF = 256 * ATT_KSTR;
__device__ __forceinline__ void attn_block_unit(const Params& p, int bu, char* lds, int tid) {
  const int b = bu >> 5, kv = (bu >> 4) & 1, blk = bu & 15, lane = tid & 63, wid = tid >> 6;
  const bf16_t* Kp = (const bf16_t*)(p.ws + OFF_KP); const bf16_t* Vtp = (const bf16_t*)(p.ws + OFF_VTP);
  char* K_l = lds; char* Vt_l = lds + ATT_VOFF;
  u32x4 kr[4], vr[4];
#pragma unroll
  for (int i = 0; i < 4; ++i) {
    const int piece = tid + i * NTHR, key = piece >> 3, c = piece & 7;
    if (blk > 0 || key >= 128) kr[i] = *(const u32x4*)(Kp + ((size_t)b * 2048 + (size_t)(blk - 1) * 128 + key) * 128 + kv * 64 + c * 8);
    const int d = piece >> 5, c2 = piece & 31;
    if (blk > 0 || c2 >= 16) vr[i] = *(const u32x4*)(Vtp + ((size_t)(b * 2 + kv) * 64 + d) * 2048 + (size_t)(blk - 1) * 128 + c2 * 8);
  }
#pragma unroll
  for (int i = 0; i < 4; ++i) {
    const int piece = tid + i * NTHR, key = piece >> 3, c = piece & 7;
    if (blk > 0 || key >= 128) *(u32x4*)(K_l + key * ATT_KSTR + c * 16) = kr[i];
    const int d = piece >> 5, c2 = piece & 31;
    if (blk > 0 || c2 >= 16) *(u32x4*)(Vt_l + d * ATT_VSTR + c2 * 16) = vr[i];
  }
  __syncthreads();
  const int pl = lane & 15;
#pragma unroll 1
  for (int g = 0; g < 4; ++g) {
    asm volatile("" ::: "memory");
    attn_core<true>(p, lane, K_l, ATT_KSTR, Vt_l, ATT_VSTR, wid, blk > 0, b * 2048 + blk * 128 + wid * 16 + pl, kv * 4 + g, wid * 16 + pl);
  }
  __syncthreads();
}

template <int WHICH, int NRW>
__device__ __forceinline__ void ln_rows(const Params& p, const int row0, const int lane, const f32x4 (&gv)[4], const f32x4 (&bv)[4]) {
  bf16_t* X1b = (bf16_t*)(p.ws + OFF_X1B);
  f32x4 v[NRW][4];
#pragma unroll
  for (int h = 0; h < NRW; ++h) {
    const int row = row0 + h;
    if (row < MP) {
      const bf16_t* xr = (const bf16_t*)(p.ws + (WHICH == 1 ? OFF_PRE1 : OFF_PRE2)) + (size_t)row * DM;
#pragma unroll
      for (int j = 0; j < 4; ++j) v[h][j] = unpk4(*(const u32x2*)(xr + j * 256 + lane * 4));
    } else {
      const float* SL = (const float*)(p.ws + (WHICH == 1 ? OFF_SLAB_WO : OFF_SLAB_DN)) + (size_t)(row - MP) * DM;
      constexpr int NS = (WHICH == 1) ? 8 : 11;
#pragma unroll
      for (int j = 0; j < 4; ++j) {
        f32x4 a;
        if (WHICH == 1) a = *(const f32x4*)(p.in[1] + (size_t)(row - MP) * DM + j * 256 + lane * 4) * ALPHA_F;
        else a = unpk4(*(const u32x2*)(X1b + (size_t)row * DM + j * 256 + lane * 4)) * ALPHA_F;
#pragma unroll
        for (int q = 0; q < NS; ++q) a += *(const f32x4*)(SL + (size_t)q * MS * DM + j * 256 + lane * 4);
        v[h][j] = a;
      }
    }
  }
  float s[NRW], s2[NRW];
#pragma unroll
  for (int h = 0; h < NRW; ++h) { s[h] = 0.f;
#pragma unroll
    for (int j = 0; j < 4; ++j) s[h] += (v[h][j].x + v[h][j].y) + (v[h][j].z + v[h][j].w); }
#pragma unroll
  for (int o = 1; o < 64; o <<= 1) {
#pragma unroll
    for (int h = 0; h < NRW; ++h) s[h] += __shfl_xor(s[h], o);
  }
#pragma unroll
  for (int h = 0; h < NRW; ++h) { const float mean = s[h] * (1.f / DM); s2[h] = 0.f;
#pragma unroll
    for (int j = 0; j < 4; ++j) { v[h][j] = v[h][j] - mean; s2[h] += (v[h][j].x * v[h][j].x + v[h][j].y * v[h][j].y) + (v[h][j].z * v[h][j].z + v[h][j].w * v[h][j].w); } }
#pragma unroll
  for (int o = 1; o < 64; o <<= 1) {
#pragma unroll
    for (int h = 0; h < NRW; ++h) s2[h] += __shfl_xor(s2[h], o);
  }
#pragma unroll
  for (int h = 0; h < NRW; ++h) {
    const int row = row0 + h;
    const float rstd = rsqrtf(s2[h] * (1.f / DM) + LN_EPS_F);
#pragma unroll
    for (int j = 0; j < 4; ++j) {
      const f32x4 o = v[h][j] * rstd * gv[j] + bv[j];
      if (WHICH == 1) *(u32x2*)(X1b + (size_t)row * DM + j * 256 + lane * 4) = pk4(o);
      else *(f32x4*)(p.out + (size_t)row * DM + j * 256 + lane * 4) = o;
    }
  }
}
template <int WHICH>
__device__ __forceinline__ void ln_phase(const Params& p) {
  const int lane = threadIdx.x & 63, wid = threadIdx.x >> 6;
  const int gw = blockIdx.x * NWAVE + wid, NGW = gridDim.x * NWAVE;
  const float* gam = p.in[WHICH == 1 ? 20 : 26]; const float* bet = p.in[WHICH == 1 ? 21 : 27];
  f32x4 gv[4], bv[4];
#pragma unroll
  for (int j = 0; j < 4; ++j) { gv[j] = *(const f32x4*)(gam + j * 256 + lane * 4); bv[j] = *(const f32x4*)(bet + j * 256 + lane * 4); }
  for (int rp = gw; rp < MP / 2; rp += NGW) ln_rows<WHICH, 2>(p, rp * 2, lane, gv, bv);
  for (int row = MP + gw; row < MT; row += NGW) ln_rows<WHICH, 1>(p, row, lane, gv, bv);
}

__device__ __forceinline__ void fixup_phase(const Params& p) {
  unsigned char* ws = p.ws;
  const int gt = blockIdx.x * NTHR + threadIdx.x, NGT = gridDim.x * NTHR;
  const float* HA0 = (const float*)(ws + OFF_HA0); const float* HG0 = (const float*)(ws + OFF_HG0); const float* HA1 = (const float*)(ws + OFF_HA1);
  bf16_t* H = (bf16_t*)(ws + OFF_H);
  constexpr int NJ4 = DFF / 4;
  for (int i = gt; i < NRB * 2 * NJ4; i += NGT) {
    const int j4 = i % NJ4, rl = (i / NJ4) & 1, rb = i / (2 * NJ4);
    if ((rb & 31) == 0) continue;
    const int j0 = j4 * 4;
    const f32x4 a0 = *(const f32x4*)(HA0 + ((size_t)rb * 2 + rl) * DFF + j0);
    const f32x4 g = *(const f32x4*)(HG0 + ((size_t)rb * 2 + rl) * DFF + j0);
    const f32x4 pm1 = *(const f32x4*)(HA1 + ((size_t)(rb - 1) * 2 + 1) * DFF + j0);
    const f32x4 pm2 = *(const f32x4*)(HA1 + ((size_t)(rb - 1) * 2 + 0) * DFF + j0);
    f32x4 am1, am2;
    if (rl == 0) { am1 = pm1; am2 = pm2; }
    else { am1 = *(const f32x4*)(HA0 + ((size_t)rb * 2 + 0) * DFF + j0); am2 = pm1; }
    const f32x4 w0 = *(const f32x4*)(p.in[23] + j0), w1 = *(const f32x4*)(p.in[23] + DFF + j0), w2 = *(const f32x4*)(p.in[23] + 2 * DFF + j0);
    const f32x4 cb = *(const f32x4*)(p.in[24] + j0);
    f32x4 h;
    h.x = gelu_tanh(cb.x + w0.x * am2.x + w1.x * am1.x + w2.x * a0.x) * g.x;
    h.y = gelu_tanh(cb.y + w0.y * am2.y + w1.y * am1.y + w2.y * a0.y) * g.y;
    h.z = gelu_tanh(cb.z + w0.z * am2.z + w1.z * am1.z + w2.z * a0.z) * g.z;
    h.w = gelu_tanh(cb.w + w0.w * am2.w + w1.w * am1.w + w2.w * a0.w) * g.w;
    *(u32x2*)(H + ((size_t)rb * 64 + rl) * DFF + j0) = pk4(h);
  }
}

#define XB_TMO      128
#define XB_XCNT(j)  (256  + 64 * (j))
#define XB_XSUB(j)  (1280 + 64 * (j))
#define XB_XGEN(j)  (2304 + 64 * (j))
#define XB_TOP      3328
#define XB_TOPGEN   3392
#define XCD_BAR_WORDS 3456
#define XB_SPIN_CAP (1u << 18)
__device__ __forceinline__ unsigned xb_ld(unsigned* p)              { return __hip_atomic_load(p, __ATOMIC_RELAXED, __HIP_MEMORY_SCOPE_AGENT); }
__device__ __forceinline__ unsigned xb_add(unsigned* p, unsigned v) { return __hip_atomic_fetch_add(p, v, __ATOMIC_RELAXED, __HIP_MEMORY_SCOPE_AGENT); }
__device__ __forceinline__ unsigned xb_xcc_id() { return (unsigned)__builtin_amdgcn_s_getreg((3 << 11) | 20) & 0xFu; }
#define XB_SPIN(cond, bar) do { unsigned _sp = 0; while (cond) { __builtin_amdgcn_s_sleep(1); \
    if ((++_sp & 255u) == 0u) { if (xb_ld(&(bar)[XB_TMO])) break; if (_sp > XB_SPIN_CAP) { atomicAdd(&(bar)[XB_TMO], 1u); break; } } } } while (0)
#define XB_EXIT 64
__device__ unsigned g_xbar[XCD_BAR_WORDS + 64];
struct XcdBarrier { unsigned* bar; unsigned x; volatile LAS unsigned* st; };
__device__ __forceinline__ XcdBarrier xcd_barrier_post(unsigned* bar, volatile LAS unsigned* st) {
    XcdBarrier b; b.bar = bar; b.x = xb_xcc_id(); b.st = st;
    if (threadIdx.x == 0) (void)xb_add(&bar[XB_XCNT(b.x)], 1u);
    return b;
}
__device__ __forceinline__ void xcd_barrier_complete(unsigned* bar, unsigned x, unsigned& nloc, unsigned& nx) {
    const unsigned G = gridDim.x * gridDim.y * gridDim.z;
    unsigned sum, cnt, mine, sp = 0u;
    for (;;) {
        sum = 0u; cnt = 0u; mine = 0u;
#pragma unroll
        for (unsigned j = 0; j < 16; ++j) { const unsigned c = xb_ld(&bar[XB_XCNT(j)]); sum += c; cnt += (c > 0u) ? 1u : 0u; mine = (j == x) ? c : mine; }
        if (sum == G) break;
        __builtin_amdgcn_s_sleep(1);
        if ((++sp & 255u) == 0u) { if (xb_ld(&bar[XB_TMO])) break; if (sp > XB_SPIN_CAP) { atomicAdd(&bar[XB_TMO], 1u); break; } }
    }
    nloc = mine > 0u ? mine : 1u; nx = cnt > 0u ? cnt : 1u;
}
__device__ __forceinline__ void xcd_barrier(const XcdBarrier& b) {
    asm volatile("s_waitcnt vmcnt(0)" ::: "memory");
    __syncthreads();
    if (threadIdx.x == 0) {
        unsigned* bar = b.bar;
        __builtin_amdgcn_s_waitcnt(0);
        unsigned nloc = b.st[0], nx = b.st[1];
        if (nloc == 0u) { xcd_barrier_complete(bar, b.x, nloc, nx); b.st[0] = nloc; b.st[1] = nx; }
        const unsigned old = xb_add(&bar[XB_XSUB(b.x)], 1u);
        const unsigned gen = old / nloc;
        if (old + 1u == (gen + 1u) * nloc) {
            __builtin_amdgcn_fence(__ATOMIC_RELEASE, "agent");
            asm volatile("s_waitcnt vmcnt(0)" ::: "memory");
            const unsigned og = xb_add(&bar[XB_TOP], 1u);
            const unsigned tg = og / nx;
            if (og + 1u == (tg + 1u) * nx) xb_add(&bar[XB_TOPGEN], 1u);
            else XB_SPIN(xb_ld(&bar[XB_TOPGEN]) == tg, bar);
            __builtin_amdgcn_fence(__ATOMIC_ACQUIRE, "agent");
            xb_add(&bar[XB_XGEN(b.x)], 1u);
            asm volatile("s_waitcnt vmcnt(0)" ::: "memory");
        } else {
            XB_SPIN(xb_ld(&bar[XB_XGEN(b.x)]) == gen, bar);
            __builtin_amdgcn_fence(__ATOMIC_ACQUIRE, "agent");
            asm volatile("s_waitcnt vmcnt(0)" ::: "memory");
        }
    }
    __syncthreads();
}
#define GSYNC() xcd_barrier(xb)

__device__ __forceinline__ void sample_merge(const Params& p) {
  unsigned char* ws = p.ws;
  const bf16_t* P = (const bf16_t*)(ws + OFF_P); bf16_t* Mg = (bf16_t*)(ws + OFF_MG);
  const float* SLG = (const float*)(ws + OFF_SLAB_GLU); const float* SLA = (const float*)(ws + OFF_SLAB_ATT);
  for (int i = blockIdx.x * NTHR + threadIdx.x; i < MS * (DM / 4); i += gridDim.x * NTHR) {
    const int r = i >> 8, j = (i & 255) * 4;
    const int tj = j >> 7, jl = j & 127, va = tj * 256 + (jl >> 6) * 128 + ((jl >> 4) & 3) * 32 + (jl & 15);
    f32x4 ya = f32x4{0.f, 0.f, 0.f, 0.f}, yb = ya, at = ya;
#pragma unroll
    for (int q = 0; q < 4; ++q) {
      ya += *(const f32x4*)(SLG + ((size_t)q * MS + r) * 2048 + va);
      yb += *(const f32x4*)(SLG + ((size_t)q * MS + r) * 2048 + va + 16);
      at += *(const f32x4*)(SLA + ((size_t)q * MS + r) * DM + j);
    }
    const size_t row = (size_t)MP + r;
    const f32x4 gs = unpk4(*(const u32x2*)(P + row * PW + 1024 + j)), ga = unpk4(*(const u32x2*)(P + row * PW + 2048 + j));
    f32x4 sv;
    sv.x = gs.x * ya.x * sigmoidf_(yb.x); sv.y = gs.y * ya.y * sigmoidf_(yb.y); sv.z = gs.z * ya.z * sigmoidf_(yb.z); sv.w = gs.w * ya.w * sigmoidf_(yb.w);
    sv = unpk4(pk4(sv));
    sv.x += ga.x * at.x; sv.y += ga.y * at.y; sv.z += ga.z * at.z; sv.w += ga.w * at.w;
    *(u32x2*)(Mg + row * DM + j) = pk4(sv);
  }
}

__global__ void __launch_bounds__(512) fwd_megakernel(Params p) {
  extern __shared__ __attribute__((aligned(16))) char lds[];
  volatile LAS unsigned* xst = (volatile LAS unsigned*)(lds + GEMM_LDS);
  if (threadIdx.x == 0) { xst[0] = 0u; xst[1] = 0u; }
  __syncthreads();
  XcdBarrier xb = xcd_barrier_post(g_xbar, xst);
  unsigned char* ws = p.ws;
  LAS unsigned char* glds = (LAS unsigned char*)lds;
  const int lane = threadIdx.x & 63, wid = threadIdx.x >> 6;
  const int gw = blockIdx.x * NWAVE + wid, NGW = gridDim.x * NWAVE;

  prep_phase(p, lds);
  GSYNC();
  gemm_phase<EPI_IN>(p, (const bf16_t*)(ws + OFF_B), (const bf16_t*)(ws + OFF_WIN), 1024, DIN, glds);
  GSYNC();
  {
    for (int bu = blockIdx.x; bu < 256; bu += gridDim.x) attn_block_unit(p, bu, lds, threadIdx.x);
    bf16_t* Hs = (bf16_t*)(lds + wid * 4352);
    constexpr int N_S1 = 8 * 32 * 16, N_SS = 32 * 32, N_AT = 256;
#pragma unroll 1
    for (int u = blockIdx.x * 16 + wid; u < 4096; u += ((u & 15) + NWAVE < 15) ? NWAVE : (gridDim.x * 16 - (u & 15) + wid)) {
      asm volatile("" ::: "memory");
      scan_end_unit(p, u, lane);
    }
    for (int i = gw; i < 2 * N_SS; i += NGW) { if ((i & 1) == 0) scan_unit<2>(p, i >> 1, lane, Hs); }
    for (int i = gw; i < 8 * N_AT; i += NGW) { if ((i & 7) == 1) attn_sample_unit(p, i >> 3, lane); }
    asm volatile("s_waitcnt vmcnt(0)" ::: "memory");
    __syncthreads();
#pragma unroll 1
    for (int u = blockIdx.x * 16 + wid; u < 4096; u += ((u & 15) + NWAVE < 16) ? NWAVE : (gridDim.x * 16 - (u & 15) + wid)) {
      asm volatile("" ::: "memory");
      scan_unit<1>(p, u, lane, Hs);
    }
  }
  GSYNC();
  gemm_phase<EPI_GLU>(p, (const bf16_t*)(ws + OFF_GY), (const bf16_t*)(ws + OFF_WGLU), 512, 2048, glds, (const bf16_t*)(ws + OFF_O), (const bf16_t*)(ws + OFF_WATT));
  GSYNC();
  gemm_phase<EPI_ATT>(p, (const bf16_t*)(ws + OFF_O), (const bf16_t*)(ws + OFF_WATT), 512, 1024, glds);
  sample_merge(p);
  GSYNC();
  gemm_phase<EPI_WO>(p, (const bf16_t*)(ws + OFF_MG), (const bf16_t*)(ws + OFF_WO), 1024, 1024, glds);
  GSYNC();
  ln_phase<1>(p);
  GSYNC();
  gemm_phase<EPI_UP>(p, (const bf16_t*)(ws + OFF_X1B), (const bf16_t*)(ws + OFF_WUP), 1024, 5632, glds);
  GSYNC();
  fixup_phase(p);
  GSYNC();
  gemm_phase<EPI_DOWN>(p, (const bf16_t*)(ws + OFF_H), (const bf16_t*)(ws + OFF_WDN), DFF, 1024, glds);
  GSYNC();
  ln_phase<2>(p);
  __syncthreads();
  if (threadIdx.x == 0) {
    unsigned* bar = g_xbar;
    const unsigned old = xb_add(&bar[XB_EXIT], 1u);
    if (old == gridDim.x - 1u) {
#pragma unroll
      for (int j = 0; j < 16; ++j) {
        __hip_atomic_store(&bar[XB_XCNT(j)], 0u, __ATOMIC_RELAXED, __HIP_MEMORY_SCOPE_AGENT);
        __hip_atomic_store(&bar[XB_XSUB(j)], 0u, __ATOMIC_RELAXED, __HIP_MEMORY_SCOPE_AGENT);
        __hip_atomic_store(&bar[XB_XGEN(j)], 0u, __ATOMIC_RELAXED, __HIP_MEMORY_SCOPE_AGENT);
      }
      __hip_atomic_store(&bar[XB_TOP], 0u, __ATOMIC_RELAXED, __HIP_MEMORY_SCOPE_AGENT);
      __hip_atomic_store(&bar[XB_TOPGEN], 0u, __ATOMIC_RELAXED, __HIP_MEMORY_SCOPE_AGENT);
      __hip_atomic_store(&bar[XB_TMO], 0u, __ATOMIC_RELAXED, __HIP_MEMORY_SCOPE_AGENT);
      __hip_atomic_store(&bar[XB_EXIT], 0u, __ATOMIC_RELAXED, __HIP_MEMORY_SCOPE_AGENT);
    }
  }
}

extern "C" void kernel_launch(void* const* d_in, const int* in_sizes, int n_in, void* d_out, int out_size, void* d_ws, size_t ws_size, hipStream_t stream) {
  static int grid_blocks = 0;
  if (grid_blocks == 0) {
    if (n_in != 28 || ws_size < WS_TOTAL) { fprintf(stderr, "kernel_launch: unexpected n_in %d or ws_size %zu (< %zu)\n", n_in, ws_size, (size_t)WS_TOTAL); grid_blocks = -1; return; }
    int dev = 0, cus = 0, per_cu = 0;
    (void)hipGetDevice(&dev);
    (void)hipDeviceGetAttribute(&cus, hipDeviceAttributeMultiprocessorCount, dev);
    (void)hipFuncSetAttribute((const void*)fwd_megakernel, hipFuncAttributeMaxDynamicSharedMemorySize, LDS_BYTES);
    (void)hipOccupancyMaxActiveBlocksPerMultiprocessor(&per_cu, (const void*)fwd_megakernel, NTHR, LDS_BYTES);
    if (per_cu < 1) { fprintf(stderr, "kernel_launch: occupancy query returned %d\n", per_cu); per_cu = 1; }
    if (per_cu > 1) per_cu = 1;
    grid_blocks = cus * per_cu;
    fprintf(stderr, "kernel_launch: cus %d per_cu %d grid %d\n", cus, per_cu, grid_blocks);
  }
  if (grid_blocks < 0) return;
  Params p{};
  for (int i = 0; i < 28; ++i) p.in[i] = (const float*)d_in[i];
  p.out = (float*)d_out; p.ws = (unsigned char*)d_ws;
  void* args[] = {&p};
  hipError_t e = hipLaunchCooperativeKernel((const void*)fwd_megakernel, dim3(grid_blocks), dim3(NTHR), args, LDS_BYTES, stream);
  if (e != hipSuccess) fprintf(stderr, "cooperative launch failed: %s (grid %d)\n", hipGetErrorString(e), grid_blocks);
}
```

```cpp
#include <hip/hip_runtime.h>
#include <hip/hip_cooperative_groups.h>
#include <cstdio>
#include <cstdint>
namespace cg = cooperative_groups;

typedef unsigned short bf16_t;
typedef short bf16x8 __attribute__((ext_vector_type(8)));
typedef short bf16x4 __attribute__((ext_vector_type(4)));
typedef float f32x4 __attribute__((ext_vector_type(4)));
typedef unsigned u32x2 __attribute__((ext_vector_type(2)));
typedef unsigned u32x4 __attribute__((ext_vector_type(4)));

constexpr int MP = 16384, MS = 512, MT = MP + MS;
constexpr int DM = 1024, DIN = 3328, PW = 3072, DFF = 2816;
constexpr int NRB = MP / 64;
constexpr float ALPHA_F = 1.189207115002721f;
constexpr float LN_EPS_F = 1e-5f;

constexpr size_t O_YP = 0, O_YS = 16777216, O_KP = 17301504, O_VP = 17432576, O_KS = 17563648, O_VS = 19660800,
                 O_HRP = 21757952, O_HIP = 21774336, O_HRS = 21790720, O_HIS = 22052864, O_CP = 22315008, O_CS = 22360064;

constexpr size_t OFF_P = 0;
constexpr size_t OFF_H = 0;
constexpr size_t OFF_B = (size_t)MT * PW * 2;
constexpr size_t OFF_GY = OFF_B, OFF_O = OFF_B + (size_t)MT * 512 * 2;
constexpr size_t OFF_C = OFF_B + (size_t)MT * DM * 2;
constexpr size_t OFF_MG = OFF_C;
constexpr size_t OFF_X1B = OFF_C + (size_t)MT * DM * 2;
constexpr size_t OFF_KP = OFF_C + (size_t)MT * DM * 2;
constexpr size_t OFF_VTP = OFF_KP + (size_t)8 * 2048 * 128 * 2;
constexpr size_t OFF_KS = OFF_VTP + (size_t)8 * 2048 * 128 * 2;
constexpr size_t OFF_VTS = OFF_KS + (size_t)128 * 144 * 128 * 2;
constexpr size_t OFF_W = OFF_C + (size_t)MT * DM * 4;
constexpr size_t OFF_WIN = OFF_W;
constexpr size_t OFF_WGLU = OFF_WIN + (size_t)DIN * 1024 * 2;
constexpr size_t OFF_WATT = OFF_WGLU + (size_t)2048 * 512 * 2;
constexpr size_t OFF_WO = OFF_WATT + (size_t)1024 * 512 * 2;
constexpr size_t OFF_WUP = OFF_WO + (size_t)1024 * 1024 * 2;
constexpr size_t OFF_WDN = OFF_WUP + (size_t)5632 * 1024 * 2;
constexpr size_t OFF_SSM = OFF_WDN + (size_t)1024 * DFF * 2;
constexpr size_t OFF_AR = OFF_SSM, OFF_AI = OFF_SSM + 8192, OFF_BB = OFF_SSM + 16384;
constexpr size_t OFF_E = OFF_BB + 131072;
constexpr size_t OFF_HA0 = OFF_E + (size_t)8 * 32 * 16 * 128 * 4;
constexpr size_t OFF_HG0 = OFF_HA0 + (size_t)NRB * 2 * DFF * 4;
constexpr size_t OFF_HA1 = OFF_HG0 + (size_t)NRB * 2 * DFF * 4;
constexpr size_t WS_END = OFF_HA1 + (size_t)NRB * 2 * DFF * 4;
static_assert(OFF_VTS + (size_t)128 * 144 * 128 * 2 <= OFF_W, "KV overlay overflow");
static_assert(WS_END <= (size_t)256 * 1024 * 1024, "workspace too large");

constexpr size_t OFF_BAR = WS_END;
constexpr size_t WS_TOTAL = OFF_BAR + 16384;
static_assert(WS_TOTAL <= (size_t)256 * 1024 * 1024, "workspace too large");
constexpr size_t OFF_SLAB_WO = OFF_P;
constexpr size_t OFF_SLAB_DN = OFF_B;
static_assert((size_t)11 * MS * DM * 4 <= (size_t)MT * DM * 2, "down slabs must fit the X1b region");
constexpr size_t OFF_SLAB_GLU = OFF_KP;
constexpr size_t OFF_SLAB_ATT = OFF_KP + (size_t)4 * MS * 2048 * 4;
static_assert(OFF_SLAB_ATT + (size_t)4 * MS * DM * 4 <= OFF_W, "GLU/attn slabs must fit the dead K/V + x1 region");
constexpr size_t OFF_PRE1 = OFF_B;
constexpr size_t OFF_PRE2 = OFF_C;
constexpr int GEMM_LDS = 131072;
constexpr int LDS_BYTES = GEMM_LDS + 16;
constexpr int NTHR = 512, NWAVE = 8;

struct Params {
  const float* in[28];
  float* out;
  unsigned char* ws;
};

typedef __bf16 bf16v2_t __attribute__((ext_vector_type(2)));
typedef float f32x2 __attribute__((ext_vector_type(2)));
__device__ __forceinline__ unsigned pk2(float lo, float hi) { f32x2 v = {lo, hi}; bf16v2_t b = __builtin_convertvector(v, bf16v2_t); return __builtin_bit_cast(unsigned, b); }
__device__ __forceinline__ bf16_t f2bf(float x) { return (bf16_t)(pk2(x, 0.f) & 0xffffu); }
__device__ __forceinline__ float bf2f(unsigned v16) { return __uint_as_float(v16 << 16); }
__device__ __forceinline__ float bflo(unsigned w) { return __uint_as_float(w << 16); }
__device__ __forceinline__ float bfhi(unsigned w) { return __uint_as_float(w & 0xffff0000u); }
__device__ __forceinline__ float rcp_nr(float d) { const float r = __builtin_amdgcn_rcpf(d); return fmaf(r, fmaf(-d, r, 1.f), r); }
__device__ __forceinline__ float sigmoidf_(float x) { return rcp_nr(1.f + __expf(fminf(-x, 80.f))); }
__device__ __forceinline__ float gelu_tanh(float x) { float z = 1.5957691216057308f * (x + 0.044715f * x * x * x); return x * rcp_nr(1.f + __expf(fminf(-z, 80.f))); }
__device__ __forceinline__ float wave_sum(float v) {
#pragma unroll
  for (int o = 1; o < 64; o <<= 1) v += __shfl_xor(v, o);
  return v;
}
__device__ __forceinline__ u32x2 pk4(f32x4 v) { u32x2 r; r.x = pk2(v.x, v.y); r.y = pk2(v.z, v.w); return r; }
__device__ __forceinline__ f32x4 unpk4(u32x2 w) { f32x4 r; r.x = bflo(w.x); r.y = bfhi(w.x); r.z = bflo(w.y); r.w = bfhi(w.y); return r; }


#define LAS __attribute__((address_space(3)))
namespace pg8 {
constexpr int BM = 256, BK = 64, HALF = 128, HTB = HALF * BK * 2, NXCD = 8, WGM = 8;
__device__ __forceinline__ int lds_byte(int r, int c) { const int st = (r >> 4) * 2 + (c >> 5), rr = r & 15, cc = c & 31, ob = rr * 64 + cc * 2; return st * 1024 + (ob ^ (((ob >> 9) & 1) << 5)); }
__device__ __forceinline__ void stage_rc(int b, int& R, int& C) { const int st = b / 1024, sb = b % 1024, swz = sb ^ (((sb >> 9) & 1) << 5); R = (st >> 1) * 16 + swz / 64; C = (st & 1) * 32 + (swz % 64) / 2; }
struct Unit { int pm, pn, k0, nk, slice; };
struct StaticOrder {
    int nM, nN, nwg, G, c;
    __device__ __forceinline__ void init(int M, int N, int G_, int c_) { nM = M / BM; nN = N / BM; nwg = nM * nN; G = G_; c = c_; }
    int nsplit, nslice_items, nt, glu;
    __device__ __forceinline__ bool next(int i, int& pm, int& pn, int& k0, int& nk, int& slice, int& src) const {
        const long L = (long)i * G + c;
        pm = 0; pn = 0; k0 = 0; nk = nt; slice = -1; src = 0;
        if (L < nwg) {
            int wgid = (int)L; { const int q = nwg / NXCD, r = nwg % NXCD, xcd = wgid % NXCD, off = wgid / NXCD; wgid = (xcd < r ? xcd * (q + 1) : r * (q + 1) + (xcd - r) * q) + off; }
            const int nig = WGM * nN, gid = wgid / nig, fm = gid * WGM, gsz = (nM - fm) < WGM ? (nM - fm) : WGM;
            pm = fm + ((wgid % nig) % gsz); pn = (wgid % nig) / gsz; return true;
        }
        if (nsplit == 0) return false;
        int sidx = (int)(L - nwg);
        if (sidx >= nslice_items) return false;
        int ncol = nN;
        if (glu && sidx >= 64) { sidx -= 64; src = 1; ncol = 4; }
        const int tl = sidx / nsplit; slice = sidx - tl * nsplit; pm = 64 + tl / ncol; pn = tl % ncol; nk = nt / nsplit; k0 = slice * nk; return true;
    }
};
}

enum { EPI_IN = 0, EPI_GLU = 1, EPI_ATT = 2, EPI_WO = 3, EPI_UP = 4, EPI_DOWN = 5 };

__device__ __forceinline__ float dpp_ror1(float v) { return __int_as_float(__builtin_amdgcn_update_dpp(0, __float_as_int(v), 0x121, 0xf, 0xf, false)); }
__device__ __forceinline__ float dpp_ror2(float v) { return __int_as_float(__builtin_amdgcn_update_dpp(0, __float_as_int(v), 0x122, 0xf, 0xf, false)); }
__device__ __forceinline__ float dpp_shr1_old(float old, float v) { return __int_as_float(__builtin_amdgcn_update_dpp(__float_as_int(old), __float_as_int(v), 0x111, 0xf, 0xf, false)); }
__device__ __forceinline__ float dpp_shr2_old(float old, float v) { return __int_as_float(__builtin_amdgcn_update_dpp(__float_as_int(old), __float_as_int(v), 0x112, 0xf, 0xf, false)); }
__device__ __forceinline__ f32x4 shr1v(f32x4 o, f32x4 v) { return f32x4{dpp_shr1_old(o.x, v.x), dpp_shr1_old(o.y, v.y), dpp_shr1_old(o.z, v.z), dpp_shr1_old(o.w, v.w)}; }
__device__ __forceinline__ f32x4 shr2v(f32x4 o, f32x4 v) { return f32x4{dpp_shr2_old(o.x, v.x), dpp_shr2_old(o.y, v.y), dpp_shr2_old(o.z, v.z), dpp_shr2_old(o.w, v.w)}; }
__device__ __forceinline__ f32x4 ror1v(f32x4 v) { return f32x4{dpp_ror1(v.x), dpp_ror1(v.y), dpp_ror1(v.z), dpp_ror1(v.w)}; }
__device__ __forceinline__ f32x4 ror2v(f32x4 v) { return f32x4{dpp_ror2(v.x), dpp_ror2(v.y), dpp_ror2(v.z), dpp_ror2(v.w)}; }

template <int EPI>
__device__ __forceinline__ void epilogue(const Params& p, f32x4 (&acc)[2][2][4][2], const int pm, const int pn, const int wr, const int wc, const int fr, const int fq) {
  unsigned char* ws = p.ws;
  bf16_t* P = (bf16_t*)(ws + OFF_P);
  if constexpr (EPI == EPI_IN) {
    bf16_t* Kp = (bf16_t*)(ws + OFF_KP); bf16_t* Ks = (bf16_t*)(ws + OFF_KS);
    bf16_t* Vtp = (bf16_t*)(ws + OFF_VTP); bf16_t* Vts = (bf16_t*)(ws + OFF_VTS);
#pragma unroll
    for (int bj = 0; bj < 2; ++bj) {
      const int col0 = pn * 256 + bj * 128;
      const int col = col0 + wc * 32 + fq * 8;
#pragma unroll
      for (int ai = 0; ai < 2; ++ai)
#pragma unroll
        for (int m = 0; m < 4; ++m) {
          const int row = pm * 256 + ai * 128 + wr * 64 + m * 16 + fr;
          f32x4 v0 = acc[ai][bj][m][0], v1 = acc[ai][bj][m][1];
          if (col0 < 1024) {
            const u32x2 lo = pk4(v0), hi = pk4(v1);
            *(u32x4*)(P + (size_t)row * PW + col) = u32x4{lo.x, lo.y, hi.x, hi.y};
          } else if (col0 >= 1280) {
            v0.x = sigmoidf_(v0.x); v0.y = sigmoidf_(v0.y); v0.z = sigmoidf_(v0.z); v0.w = sigmoidf_(v0.w);
            v1.x = sigmoidf_(v1.x); v1.y = sigmoidf_(v1.y); v1.z = sigmoidf_(v1.z); v1.w = sigmoidf_(v1.w);
            const u32x2 lo = pk4(v0), hi = pk4(v1);
            *(u32x4*)(P + (size_t)row * PW + col - 256) = u32x4{lo.x, lo.y, hi.x, hi.y};
          } else if (col0 == 1024) {
            const int cc = col - 1024;
            const u32x2 lo = pk4(v0), hi = pk4(v1);
            if (row < MP) {
              *(u32x4*)(Kp + (size_t)row * 128 + cc) = u32x4{lo.x, lo.y, hi.x, hi.y};
              const int pos = row & 2047;
              if (pos >= 1920) { float* o = p.out + O_KP + ((size_t)(row >> 11) * 128 + (pos - 1920)) * 128 + cc; *(f32x4*)o = v0; *(f32x4*)(o + 4) = v1; }
            } else {
              const int sx = row - MP, b = sx >> 2, tt = sx & 3;
              *(u32x4*)(Ks + ((size_t)b * 144 + 128 + tt) * 128 + cc) = u32x4{lo.x, lo.y, hi.x, hi.y};
              float* o = p.out + O_KS + ((size_t)b * 128 + 124 + tt) * 128 + cc; *(f32x4*)o = v0; *(f32x4*)(o + 4) = v1;
            }
          } else {
            const int cc = col - 1152, kv = cc >> 6, d = cc & 63;
            if (row < MP) {
              const int b = row >> 11, pos = row & 2047;
              bf16_t* dst = Vtp + ((size_t)(b * 2 + kv) * 64 + d) * 2048 + pos;
              dst[0] = f2bf(v0.x); dst[2048] = f2bf(v0.y); dst[4096] = f2bf(v0.z); dst[6144] = f2bf(v0.w);
              dst[8192] = f2bf(v1.x); dst[10240] = f2bf(v1.y); dst[12288] = f2bf(v1.z); dst[14336] = f2bf(v1.w);
              if (pos >= 1920) { float* o = p.out + O_VP + ((size_t)b * 128 + (pos - 1920)) * 128 + cc; *(f32x4*)o = v0; *(f32x4*)(o + 4) = v1; }
            } else {
              const int sx = row - MP, b = sx >> 2, tt = sx & 3;
              bf16_t* dst = Vts + ((size_t)(b * 2 + kv) * 64 + d) * 144 + 128 + tt;
              dst[0] = f2bf(v0.x); dst[144] = f2bf(v0.y); dst[288] = f2bf(v0.z); dst[432] = f2bf(v0.w);
              dst[576] = f2bf(v1.x); dst[720] = f2bf(v1.y); dst[864] = f2bf(v1.z); dst[1008] = f2bf(v1.w);
              float* o = p.out + O_VS + ((size_t)b * 128 + 124 + tt) * 128 + cc; *(f32x4*)o = v0; *(f32x4*)(o + 4) = v1;
            }
          }
        }
    }
  } else if constexpr (EPI == EPI_GLU) {
    bf16_t* Mg = (bf16_t*)(ws + OFF_MG);
#pragma unroll
    for (int ai = 0; ai < 2; ++ai)
#pragma unroll
      for (int m = 0; m < 4; ++m) {
        const int row = pm * 256 + ai * 128 + wr * 64 + m * 16 + fr;
        const int j0 = pn * 128 + wc * 32 + fq * 8;
        const u32x4 gw4 = *(const u32x4*)(P + (size_t)row * PW + 1024 + j0);
        u32x2 o[2];
#pragma unroll
        for (int bj = 0; bj < 2; ++bj) {
          const f32x4 ya = acc[ai][bj][m][0], yb = acc[ai][bj][m][1];
          const f32x4 gs = unpk4(bj == 0 ? u32x2{gw4.x, gw4.y} : u32x2{gw4.z, gw4.w});
          f32x4 sv;
          sv.x = gs.x * ya.x * sigmoidf_(yb.x); sv.y = gs.y * ya.y * sigmoidf_(yb.y);
          sv.z = gs.z * ya.z * sigmoidf_(yb.z); sv.w = gs.w * ya.w * sigmoidf_(yb.w);
          o[bj] = pk4(sv);
        }
        *(u32x4*)(Mg + (size_t)row * DM + j0) = u32x4{o[0].x, o[0].y, o[1].x, o[1].y};
      }
  } else if constexpr (EPI == EPI_ATT) {
    bf16_t* Mg = (bf16_t*)(ws + OFF_MG);
#pragma unroll
    for (int ai = 0; ai < 2; ++ai)
#pragma unroll
      for (int m = 0; m < 4; ++m) {
        const int row = pm * 256 + ai * 128 + wr * 64 + m * 16 + fr;
#pragma unroll
        for (int bj = 0; bj < 2; ++bj) {
          const int col = pn * 256 + bj * 128 + wc * 32 + fq * 8;
          const u32x4 gw4 = *(const u32x4*)(P + (size_t)row * PW + 2048 + col);
          const u32x4 sw4 = *(const u32x4*)(Mg + (size_t)row * DM + col);
          const f32x4 ga0 = unpk4(u32x2{gw4.x, gw4.y}), ga1 = unpk4(u32x2{gw4.z, gw4.w});
          const f32x4 s0 = unpk4(u32x2{sw4.x, sw4.y}), s1 = unpk4(u32x2{sw4.z, sw4.w});
          f32x4 v0 = acc[ai][bj][m][0], v1 = acc[ai][bj][m][1];
          v0.x = s0.x + ga0.x * v0.x; v0.y = s0.y + ga0.y * v0.y; v0.z = s0.z + ga0.z * v0.z; v0.w = s0.w + ga0.w * v0.w;
          v1.x = s1.x + ga1.x * v1.x; v1.y = s1.y + ga1.y * v1.y; v1.z = s1.z + ga1.z * v1.z; v1.w = s1.w + ga1.w * v1.w;
          const u32x2 lo = pk4(v0), hi = pk4(v1);
          *(u32x4*)(Mg + (size_t)row * DM + col) = u32x4{lo.x, lo.y, hi.x, hi.y};
        }
      }
  } else if constexpr (EPI == EPI_WO || EPI == EPI_DOWN) {
    const bf16_t* X1b = (const bf16_t*)(ws + OFF_X1B);
#pragma unroll
    for (int ai = 0; ai < 2; ++ai)
#pragma unroll
      for (int m = 0; m < 4; ++m) {
        const int row = pm * 256 + ai * 128 + wr * 64 + m * 16 + fr;
#pragma unroll
        for (int bj = 0; bj < 2; ++bj) {
          const int col = pn * 256 + bj * 128 + wc * 32 + fq * 8;
          f32x4 x0, x1;
          if constexpr (EPI == EPI_WO) { const float* xp = p.in[0] + (size_t)row * DM + col; x0 = *(const f32x4*)xp; x1 = *(const f32x4*)(xp + 4); }
          else { const u32x4 xw = *(const u32x4*)(X1b + (size_t)row * DM + col); x0 = unpk4(u32x2{xw.x, xw.y}); x1 = unpk4(u32x2{xw.z, xw.w}); }
          f32x4 v0 = acc[ai][bj][m][0], v1 = acc[ai][bj][m][1];
          v0.x += ALPHA_F * x0.x; v0.y += ALPHA_F * x0.y; v0.z += ALPHA_F * x0.z; v0.w += ALPHA_F * x0.w;
          v1.x += ALPHA_F * x1.x; v1.y += ALPHA_F * x1.y; v1.z += ALPHA_F * x1.z; v1.w += ALPHA_F * x1.w;
          const u32x2 lo = pk4(v0), hi = pk4(v1);
          *(u32x4*)((bf16_t*)(ws + (EPI == EPI_WO ? OFF_PRE1 : OFF_PRE2)) + (size_t)row * DM + col) = u32x4{lo.x, lo.y, hi.x, hi.y};
        }
      }
  } else {
    bf16_t* H = (bf16_t*)(ws + OFF_H);
    float* HA0 = (float*)(ws + OFF_HA0); float* HG0 = (float*)(ws + OFF_HG0); float* HA1 = (float*)(ws + OFF_HA1);
    const bool prompt = (pm < MP / 256);
    const int jb = pn * 128 + wc * 32 + fq * 8;
    f32x4 w0[2], w1[2], w2[2], cb[2];
#pragma unroll
    for (int bj = 0; bj < 2; ++bj) {
      w0[bj] = *(const f32x4*)(p.in[23] + jb + bj * 4); w1[bj] = *(const f32x4*)(p.in[23] + DFF + jb + bj * 4); w2[bj] = *(const f32x4*)(p.in[23] + 2 * DFF + jb + bj * 4);
      cb[bj] = *(const f32x4*)(p.in[24] + jb + bj * 4);
    }
#pragma unroll
    for (int ai = 0; ai < 2; ++ai) {
      const int rblk = pm * 256 + ai * 128 + wr * 64;
#pragma unroll
      for (int m = 0; m < 4; ++m) {
        const int row = rblk + m * 16 + fr;
        u32x2 ho[2]; bool defer = false;
#pragma unroll
        for (int bj = 0; bj < 2; ++bj) {
          const int j0 = jb + bj * 4;
          const f32x4 a0 = acc[ai][bj][m][0], g = acc[ai][bj][m][1];
          f32x4 am1, am2;
          if (prompt) {
            f32x4 o1 = f32x4{0.f, 0.f, 0.f, 0.f}, o2 = o1;
            if (m > 0) { o1 = ror1v(acc[ai][bj][m > 0 ? m - 1 : 0][0]); o2 = ror2v(acc[ai][bj][m > 0 ? m - 1 : 0][0]); }
            am1 = shr1v(o1, a0); am2 = shr2v(o2, a0);
            if (m == 0 && fr < 2 && (row & 2047) >= 2) defer = true;
            if (m == 3 && fr >= 14) *(f32x4*)(HA1 + ((size_t)(rblk >> 6) * 2 + (fr - 14)) * DFF + j0) = a0;
            const int pos = row & 2047;
            if (pos >= 2046) *(f32x4*)(p.out + O_CP + ((size_t)(row >> 11) * 2 + (pos - 2046)) * DFF + j0) = a0;
          } else {
            const int sidx = row - MP, b = sidx >> 2, tt = sidx & 3;
            const f32x4 st0 = *(const f32x4*)(p.in[6] + ((size_t)b * 2 + 0) * DFF + j0);
            const f32x4 st1 = *(const f32x4*)(p.in[6] + ((size_t)b * 2 + 1) * DFF + j0);
            const f32x4 s1 = ror1v(a0), s2 = ror2v(a0);
            am1 = (tt >= 1) ? s1 : st1;
            am2 = (tt >= 2) ? s2 : ((tt == 1) ? st1 : st0);
            if (tt >= 2) *(f32x4*)(p.out + O_CS + ((size_t)b * 2 + (tt - 2)) * DFF + j0) = a0;
          }
          f32x4 h;
          h.x = gelu_tanh(cb[bj].x + w0[bj].x * am2.x + w1[bj].x * am1.x + w2[bj].x * a0.x) * g.x;
          h.y = gelu_tanh(cb[bj].y + w0[bj].y * am2.y + w1[bj].y * am1.y + w2[bj].y * a0.y) * g.y;
          h.z = gelu_tanh(cb[bj].z + w0[bj].z * am2.z + w1[bj].z * am1.z + w2[bj].z * a0.z) * g.z;
          h.w = gelu_tanh(cb[bj].w + w0[bj].w * am2.w + w1[bj].w * am1.w + w2[bj].w * a0.w) * g.w;
          ho[bj] = pk4(h);
          if (defer) {
            *(f32x4*)(HA0 + ((size_t)(rblk >> 6) * 2 + fr) * DFF + j0) = a0;
            *(f32x4*)(HG0 + ((size_t)(rblk >> 6) * 2 + fr) * DFF + j0) = g;
          }
        }
        if (!defer) *(u32x4*)(H + (size_t)row * DFF + jb) = u32x4{ho[0].x, ho[0].y, ho[1].x, ho[1].y};
      }
    }
  }
}

template <int EPI>
__device__ __forceinline__ void gemm_phase(const Params& p, const bf16_t* __restrict__ gA, const bf16_t* __restrict__ gBt, const int K, const int N, LAS unsigned char* lds,
                                           const bf16_t* __restrict__ gA2 = nullptr, const bf16_t* __restrict__ gBt2 = nullptr) {
    using namespace pg8;
    int tid_ = threadIdx.x; asm volatile("" : "+v"(tid_));
    const int tid = tid_, wid = __builtin_amdgcn_readfirstlane(tid >> 6), lane = tid & 63, wr = wid >> 2, wc = wid & 3, fr = lane & 15, fq = lane >> 4;
    const int nt = K / BK;
    constexpr bool SPLIT = (EPI == EPI_WO || EPI == EPI_DOWN || EPI == EPI_GLU);
    constexpr bool PROMPT_ONLY = SPLIT || (EPI == EPI_ATT);
    constexpr int NSPLIT = (EPI == EPI_WO) ? 8 : (EPI == EPI_DOWN ? 11 : 4);
    StaticOrder S; S.init(PROMPT_ONLY ? MP : MT, N, gridDim.x, blockIdx.x);
    const int nN_ = N / BM;
    S.nt = nt; S.nsplit = SPLIT ? NSPLIT : 0; S.glu = (EPI == EPI_GLU) ? 1 : 0;
    S.nslice_items = (EPI == EPI_GLU) ? 96 : 2 * nN_ * NSPLIT;
    unsigned voff[2];
#pragma unroll
    for (int i = 0; i < 2; ++i) { int R, C; stage_rc(tid * 16 + i * 8192, R, C); voff[i] = (unsigned)(R * K + C) * 2u; }
    const size_t kstep = (size_t)(BK * 2);
    const size_t hstep = (size_t)HALF * K * 2;
    const size_t tstep = 2 * hstep;
    const unsigned ldsw = (unsigned)wid * 1024u;
    const int aoff = lds_byte(wr * 64 + fr, fq * 8), boff = lds_byte(wc * 32 + fr, fq * 8);
#define PG8_SA(b, h) (((b) * 2 + (h)) * HTB)
#define PG8_SB(b, h) ((4 + (b) * 2 + (h)) * HTB)
#define PG8_STAGE(bufoff, gbase) do { _Pragma("unroll") for (int _i = 0; _i < 2; ++_i) \
        __builtin_amdgcn_global_load_lds((const unsigned*)((const char*)(gbase) + voff[_i]), (LAS unsigned*)(lds + (bufoff) + ldsw + _i * 8192), 16, 0, 0); } while (0)
#define PG8_LDA(dst, b, h) do { _Pragma("unroll") for (int m = 0; m < 4; ++m) _Pragma("unroll") for (int k = 0; k < 2; ++k) dst[m][k] = *(const LAS bf16x8*)(lds + PG8_SA(b, h) + aoff + m * 2048 + k * 1024); } while (0)
#define PG8_LDB(dst, b, h) do { _Pragma("unroll") for (int n = 0; n < 2; ++n) _Pragma("unroll") for (int k = 0; k < 2; ++k) dst[n][k] = *(const LAS bf16x8*)(lds + PG8_SB(b, h) + boff + n * 2048 + k * 1024); } while (0)
#define PG8_MMA(ai, bj, At, Bt) do { __builtin_amdgcn_s_setprio(1); _Pragma("unroll") for (int m = 0; m < 4; ++m) _Pragma("unroll") for (int n = 0; n < 2; ++n) _Pragma("unroll") for (int k = 0; k < 2; ++k) \
        acc[ai][bj][m][n] = __builtin_amdgcn_mfma_f32_16x16x32_bf16(Bt[n][k], At[m][k], acc[ai][bj][m][n], 0, 0, 0); __builtin_amdgcn_s_setprio(0); } while (0)
#define PG8_WAIT_V(n) asm volatile("s_waitcnt vmcnt(" #n ")" ::: "memory")
#define PG8_WAIT_L(n) asm volatile("s_waitcnt lgkmcnt(" #n ")" ::: "memory")
#define PG8_BAR __builtin_amdgcn_s_barrier()
#define PG8_SCHED __builtin_amdgcn_sched_barrier(0)
    int ui = 0, cur_pm, cur_pn, cur_k0, cur_nk, cur_slice, cur_src, nxt_pm, nxt_pn, nxt_k0, nxt_nk, nxt_slice, nxt_src;
    if (!S.next(0, cur_pm, cur_pn, cur_k0, cur_nk, cur_slice, cur_src)) return;
    f32x4 acc[2][2][4][2];
#pragma unroll
    for (int a = 0; a < 2; ++a)
#pragma unroll
        for (int b = 0; b < 2; ++b)
#pragma unroll
            for (int m = 0; m < 4; ++m)
#pragma unroll
                for (int n = 0; n < 2; ++n) acc[a][b][m][n] = (f32x4){0.f, 0.f, 0.f, 0.f};
    bf16x8 At[4][2], B0[2][2], B1[2][2];
    const char* cA = (const char*)((EPI == EPI_GLU && cur_src) ? gA2 : gA) + (size_t)cur_pm * tstep + (size_t)cur_k0 * kstep;
    const char* cB = (const char*)((EPI == EPI_GLU && cur_src) ? gBt2 : gBt) + (size_t)cur_pn * tstep + (size_t)cur_k0 * kstep;
    PG8_STAGE(PG8_SB(0, 0), cB); PG8_STAGE(PG8_SB(0, 1), cB + hstep); PG8_STAGE(PG8_SA(0, 0), cA); PG8_STAGE(PG8_SA(0, 1), cA + hstep);
    if (wr == 1) PG8_BAR;
    PG8_WAIT_V(2); PG8_BAR;
    PG8_STAGE(PG8_SB(1, 0), cB + kstep); PG8_STAGE(PG8_SA(1, 0), cA + kstep); PG8_STAGE(PG8_SB(1, 1), cB + hstep + kstep);
    PG8_WAIT_V(6); PG8_BAR;
    for (;;) {
        const bool has_next = S.next(ui + 1, nxt_pm, nxt_pn, nxt_k0, nxt_nk, nxt_slice, nxt_src);
        const char* nA = has_next ? (const char*)((EPI == EPI_GLU && nxt_src) ? gA2 : gA) + (size_t)nxt_pm * tstep + (size_t)nxt_k0 * kstep : cA;
        const char* nB = has_next ? (const char*)((EPI == EPI_GLU && nxt_src) ? gBt2 : gBt) + (size_t)nxt_pn * tstep + (size_t)nxt_k0 * kstep : cB;
        const int cnk = cur_nk;
        for (int t = 0; t < cnk; t += 2) {
            const bool last = (t == cnk - 2);
            const char* a1 = cA + (size_t)(t + 1) * kstep;
            const char* a2 = last ? nA : cA + (size_t)(t + 2) * kstep; const char* b2 = last ? nB : cB + (size_t)(t + 2) * kstep;
            const char* a3 = a2 + kstep; const char* b3 = b2 + kstep;
            PG8_LDB(B0, 0, 0); PG8_LDB(B1, 0, 1); PG8_SCHED; PG8_LDA(At, 0, 0); PG8_STAGE(PG8_SA(1, 1), a1 + hstep);
            PG8_WAIT_V(8); PG8_WAIT_L(0); PG8_BAR; PG8_MMA(0, 0, At, B0); PG8_MMA(0, 1, At, B1); PG8_BAR; PG8_SCHED;
            PG8_LDA(At, 0, 1); PG8_STAGE(PG8_SB(0, 0), b2); PG8_STAGE(PG8_SB(0, 1), b2 + hstep); PG8_STAGE(PG8_SA(0, 0), a2);
            PG8_WAIT_V(8); PG8_WAIT_L(0); PG8_BAR; PG8_MMA(1, 0, At, B0); PG8_MMA(1, 1, At, B1); PG8_BAR; PG8_SCHED;
            PG8_LDB(B0, 1, 0); PG8_LDB(B1, 1, 1); PG8_SCHED; PG8_LDA(At, 1, 0); PG8_STAGE(PG8_SA(0, 1), a2 + hstep);
            PG8_WAIT_V(8); PG8_WAIT_L(0); PG8_BAR; PG8_MMA(0, 0, At, B0); PG8_MMA(0, 1, At, B1); PG8_BAR; PG8_SCHED;
            PG8_LDA(At, 1, 1); PG8_STAGE(PG8_SB(1, 0), b3); PG8_STAGE(PG8_SB(1, 1), b3 + hstep); PG8_STAGE(PG8_SA(1, 0), a3);
            PG8_WAIT_V(8); PG8_WAIT_L(0); PG8_BAR; PG8_MMA(1, 0, At, B0); PG8_MMA(1, 1, At, B1); PG8_BAR; PG8_SCHED;
        }
        if (wr == 0) PG8_BAR;
        if (SPLIT && cur_slice >= 0) {
            const int ldc = (EPI == EPI_GLU && cur_src == 0) ? 2048 : DM;
            float* SL = (float*)(p.ws + (EPI == EPI_WO ? OFF_SLAB_WO : (EPI == EPI_DOWN ? OFF_SLAB_DN : (cur_src ? OFF_SLAB_ATT : OFF_SLAB_GLU)))) + (size_t)cur_slice * MS * ldc;
#pragma unroll
            for (int ai = 0; ai < 2; ++ai)
#pragma unroll
                for (int m = 0; m < 4; ++m) {
                    const int rs = (cur_pm - 64) * 256 + ai * 128 + wr * 64 + m * 16 + fr;
#pragma unroll
                    for (int bj = 0; bj < 2; ++bj)
#pragma unroll
                        for (int n = 0; n < 2; ++n) *(f32x4*)(SL + (size_t)rs * ldc + cur_pn * 256 + bj * 128 + wc * 32 + ((EPI == EPI_GLU && cur_src == 0) ? (n * 16 + fq * 4) : (fq * 8 + n * 4))) = acc[ai][bj][m][n];
                }
        } else epilogue<EPI>(p, acc, cur_pm, cur_pn, wr, wc, fr, fq);
        if (!has_next) break;
#pragma unroll
        for (int a = 0; a < 2; ++a)
#pragma unroll
            for (int b = 0; b < 2; ++b)
#pragma unroll
                for (int m = 0; m < 4; ++m)
#pragma unroll
                    for (int n = 0; n < 2; ++n) acc[a][b][m][n] = (f32x4){0.f, 0.f, 0.f, 0.f};
        cur_pm = nxt_pm; cur_pn = nxt_pn; cur_k0 = nxt_k0; cur_nk = nxt_nk; cur_slice = nxt_slice; cur_src = nxt_src; cA = nA; cB = nB; ++ui;
        if (wr == 1) PG8_BAR;
    }
    PG8_WAIT_V(0);
    PG8_BAR;
#undef PG8_SA
#undef PG8_SB
#undef PG8_STAGE
#undef PG8_LDA
#undef PG8_LDB
#undef PG8_MMA
#undef PG8_WAIT_V
#undef PG8_WAIT_L
#undef PG8_BAR
#undef PG8_SCHED
}

template <int MODE>
__device__ __forceinline__ int dest_row(int n, int HH) {
  if (MODE == 0) return (n & ~31) + ((n >> 2) & 1) * 16 + ((n >> 3) & 3) * 4 + (n & 3);
  const int part = n >= HH ? 1 : 0, j = n - part * HH;
  const int tj = j >> 7, jl = j & 127, wcj = jl >> 5, fqj = (jl >> 3) & 3, bj = (jl >> 2) & 1, jj = jl & 3;
  return tj * 256 + bj * 128 + wcj * 32 + part * 16 + fqj * 4 + jj;
}
template <int MODE>
__device__ __forceinline__ void transpose_item(const float* __restrict__ W, int K, int N, bf16_t* __restrict__ WT, int HH, float* scr, int item, int lane) {
  const int nblk = N / 32, kb = item / nblk, nb = item - kb * nblk, k0 = 32 * kb, n0 = 32 * nb;
#pragma unroll 8
  for (int i = 0; i < 16; ++i) { const int kk = 2 * i + (lane >> 5); scr[kk * 33 + (lane & 31)] = W[(size_t)(k0 + kk) * N + n0 + (lane & 31)]; }
  asm volatile("s_waitcnt lgkmcnt(0)" ::: "memory");
  const int c = lane & 3;
#pragma unroll
  for (int j = 0; j < 2; ++j) {
    const int n = (lane >> 2) + 16 * j; const float* sp = scr + (8 * c) * 33 + n;
    u32x4 o; o.x = pk2(sp[0], sp[33]); o.y = pk2(sp[66], sp[99]); o.z = pk2(sp[132], sp[165]); o.w = pk2(sp[198], sp[231]);
    *(u32x4*)(WT + (size_t)dest_row<MODE>(n0 + n, HH) * K + k0 + 8 * c) = o;
  }
  asm volatile("s_waitcnt lgkmcnt(0)" ::: "memory");
}

__device__ __forceinline__ void prep_phase(const Params& p, char* lds) {
  unsigned char* ws = p.ws;
  const int tid = threadIdx.x, lane = tid & 63, wid = tid >> 6;
  const int gt = blockIdx.x * NTHR + tid, NGT = gridDim.x * NTHR;
  const int gw = blockIdx.x * NWAVE + wid, NGW = gridDim.x * NWAVE;
  {
    bf16_t* Xb = (bf16_t*)(ws + OFF_B);
    const int nchunk = MT * DM / 8, npc = MP * DM / 8;
    const int nmain = (nchunk / (4 * NGT)) * (4 * NGT);
    for (int i0 = gt; i0 < nmain / 4; i0 += NGT) {
      f32x4 a[4], b[4];
#pragma unroll
      for (int q = 0; q < 4; ++q) {
        const int i = i0 + q * (nmain / 4);
        const float* sp = (i < npc) ? p.in[0] + (size_t)i * 8 : p.in[1] + (size_t)(i - npc) * 8;
        a[q] = *(const f32x4*)sp; b[q] = *(const f32x4*)(sp + 4);
      }
#pragma unroll
      for (int q = 0; q < 4; ++q) {
        const int i = i0 + q * (nmain / 4);
        u32x4 o; o.x = pk2(a[q].x, a[q].y); o.y = pk2(a[q].z, a[q].w); o.z = pk2(b[q].x, b[q].y); o.w = pk2(b[q].z, b[q].w);
        *(u32x4*)(Xb + (size_t)i * 8) = o;
      }
    }
    for (int i = nmain + gt; i < nchunk; i += NGT) {
      const float* sp = (i < npc) ? p.in[0] + (size_t)i * 8 : p.in[1] + (size_t)(i - npc) * 8;
      const f32x4 a = *(const f32x4*)sp, b = *(const f32x4*)(sp + 4);
      u32x4 o; o.x = pk2(a.x, a.y); o.y = pk2(a.z, a.w); o.z = pk2(b.x, b.y); o.w = pk2(b.z, b.w);
      *(u32x4*)(Xb + (size_t)i * 8) = o;
    }
  }
  {
    float* scr = (float*)(lds + wid * 8704);
    constexpr int I_IN = 32 * 104, I_GLU = 16 * 64, I_ATT = 16 * 32, I_O = 32 * 32, I_UP = 32 * 176, I_DN = 88 * 32;
    constexpr int NIT = I_IN + I_GLU + I_ATT + I_O + I_UP + I_DN;
    for (int it = gw; it < NIT; it += NGW) {
      int r = it;
      if (r < I_IN) { transpose_item<0>(p.in[7], 1024, DIN, (bf16_t*)(ws + OFF_WIN), 0, scr, r, lane); continue; } r -= I_IN;
      if (r < I_GLU) { transpose_item<1>(p.in[16], 512, 2048, (bf16_t*)(ws + OFF_WGLU), 1024, scr, r, lane); continue; } r -= I_GLU;
      if (r < I_ATT) { transpose_item<0>(p.in[18], 512, 1024, (bf16_t*)(ws + OFF_WATT), 0, scr, r, lane); continue; } r -= I_ATT;
      if (r < I_O) { transpose_item<0>(p.in[19], 1024, 1024, (bf16_t*)(ws + OFF_WO), 0, scr, r, lane); continue; } r -= I_O;
      if (r < I_UP) { transpose_item<1>(p.in[22], 1024, 5632, (bf16_t*)(ws + OFF_WUP), DFF, scr, r, lane); continue; } r -= I_UP;
      transpose_item<0>(p.in[25], DFF, 1024, (bf16_t*)(ws + OFF_WDN), 0, scr, r, lane);
    }
  }
  {
    bf16_t* Ks = (bf16_t*)(ws + OFF_KS); bf16_t* Vts = (bf16_t*)(ws + OFF_VTS);
    const float* ck = p.in[2]; const float* cv = p.in[3];
    for (int i = gt; i < 128 * 128 * 16; i += NGT) {
      const int c8 = i & 15, w = (i >> 4) & 127, b = i >> 11;
      const float* s = ck + ((size_t)b * 128 + w) * 128 + c8 * 8;
      const f32x4 a = *(const f32x4*)s, bq = *(const f32x4*)(s + 4);
      u32x4 o; o.x = pk2(a.x, a.y); o.y = pk2(a.z, a.w); o.z = pk2(bq.x, bq.y); o.w = pk2(bq.z, bq.w);
      *(u32x4*)(Ks + ((size_t)b * 144 + w) * 128 + c8 * 8) = o;
    }
    for (int i = gt; i < 128 * 12 * 16; i += NGT) {
      const int c8 = i & 15, r = (i >> 4) % 12, b = i / 192;
      *(u32x4*)(Ks + ((size_t)b * 144 + 132 + r) * 128 + c8 * 8) = u32x4{0u, 0u, 0u, 0u};
    }
    for (int i = gt; i < 128 * 16 * 128; i += NGT) {
      const int kvd = i & 127, w8 = (i >> 7) & 15, b = i >> 11;
      const float* s = cv + ((size_t)b * 128 + w8 * 8) * 128 + kvd;
      u32x4 o; o.x = pk2(s[0], s[128]); o.y = pk2(s[256], s[384]); o.z = pk2(s[512], s[640]); o.w = pk2(s[768], s[896]);
      *(u32x4*)(Vts + ((size_t)b * 128 + kvd) * 144 + w8 * 8) = o;
    }
    for (int i = gt; i < 128 * 128 * 3; i += NGT) {
      const int q = i % 3, r = i / 3;
      *(u32x2*)(Vts + (size_t)r * 144 + 132 + q * 4) = u32x2{0u, 0u};
    }
    for (int i = gt; i < 128 * 124 * 32; i += NGT) {
      const int c4 = i & 31, w = (i >> 5) % 124, b = i / (124 * 32);
      const size_t so = ((size_t)b * 128 + w + 4) * 128 + c4 * 4, dof = ((size_t)b * 128 + w) * 128 + c4 * 4;
      *(f32x4*)(p.out + O_KS + dof) = *(const f32x4*)(ck + so);
      *(f32x4*)(p.out + O_VS + dof) = *(const f32x4*)(cv + so);
    }
  }
  {
    float* AR = (float*)(ws + OFF_AR); float* AI = (float*)(ws + OFF_AI); bf16_t* BB = (bf16_t*)(ws + OFF_BB);
    for (int i = gt; i < 2048; i += NGT) {
      const int g = i >> 6, pp = i & 63;
      const float lr = p.in[8][i], li = p.in[9][i], dt = expf(p.in[10][g]);
      const float mag = expf(lr * dt), ang = li * dt;
      const float abr = mag * cosf(ang), abi = mag * sinf(ang);
      const float den = lr * lr + li * li, nr = abr - 1.f;
      const float cr = (nr * lr + abi * li) / den, ci = (abi * lr - nr * li) / den;
      AR[i] = abr; AI[i] = abi;
      const float* br = p.in[11] + (size_t)i * 16; const float* bi = p.in[12] + (size_t)i * 16;
      bf16_t* dre = BB + ((size_t)g * 128 + pp) * 16; bf16_t* dim_ = BB + ((size_t)g * 128 + 64 + pp) * 16;
#pragma unroll
      for (int c = 0; c < 16; ++c) {
        dre[c] = f2bf(cr * br[c] - ci * bi[c]);
        dim_[c] = f2bf(cr * bi[c] + ci * br[c]);
      }
    }
  }
}

#define CMUL_ACC(dr, di, ar_, ai_, br_, bi_) do { const float t_r = (ar_) * (br_) - (ai_) * (bi_); const float t_i = (ar_) * (bi_) + (ai_) * (br_); dr += t_r; di += t_i; } while (0)

template <int MODE>
__device__ __forceinline__ void scan_unit(const Params& p, int u, int lane, bf16_t* Hs) {
  unsigned char* ws = p.ws;
  const int pl = lane & 15, q4 = lane >> 4;
  const bf16_t* P = (const bf16_t*)(ws + OFF_P);
  const float* AR = (const float*)(ws + OFF_AR); const float* AI = (const float*)(ws + OFF_AI);
  const bf16_t* BB = (const bf16_t*)(ws + OFF_BB);
  float* E = (float*)(ws + OFF_E);
  int g, s = 0, c = 0, R0, ntile;
  if (MODE == 2) { g = u & 31; const int ti = u >> 5; R0 = MP + ti * 16; ntile = 1; s = ti; }
  else { c = u & 15; g = (u >> 4) & 31; s = u >> 9; R0 = s * 2048 + c * 128; ntile = 8; }
  float ar[4], ai[4], a4r[4], a4i[4], a8r[4], a8i[4], a128r[4], a128i[4];
#pragma unroll
  for (int q = 0; q < 4; ++q) {
    const float r1 = AR[g * 64 + q * 16 + pl], i1 = AI[g * 64 + q * 16 + pl];
    ar[q] = r1; ai[q] = i1;
    const float r2 = r1 * r1 - i1 * i1, i2 = 2.f * r1 * i1;
    const float r4 = r2 * r2 - i2 * i2, i4 = 2.f * r2 * i2;
    const float r8 = r4 * r4 - i4 * i4, i8 = 2.f * r4 * i4;
    a4r[q] = r4; a4i[q] = i4; a8r[q] = r8; a8i[q] = i8;
    const float r16 = r8 * r8 - i8 * i8, i16 = 2.f * r8 * i8;
    const float r32 = r16 * r16 - i16 * i16, i32 = 2.f * r16 * i16;
    const float r64 = r32 * r32 - i32 * i32, i64 = 2.f * r32 * i32;
    a128r[q] = r64 * r64 - i64 * i64; a128i[q] = 2.f * r64 * i64;
  }
  bf16x4 bb[8];
#pragma unroll
  for (int pt = 0; pt < 8; ++pt) bb[pt] = *(const bf16x4*)(BB + ((size_t)g * 128 + pt * 16 + pl) * 16 + q4 * 4);
  bf16x8 cm[4]; bf16x4 dmv;
  if (MODE != 0) {
#pragma unroll
    for (int ks = 0; ks < 4; ++ks) {
      const float* src = ((ks < 2) ? p.in[13] : p.in[14]) + ((size_t)g * 16 + pl) * 64 + (ks & 1) * 32 + q4 * 8;
      const float sg = (ks < 2) ? 1.f : -1.f;
      const f32x4 x0 = *(const f32x4*)src, x1 = *(const f32x4*)(src + 4);
      u32x4 o; o.x = pk2(sg * x0.x, sg * x0.y); o.y = pk2(sg * x0.z, sg * x0.w); o.z = pk2(sg * x1.x, sg * x1.y); o.w = pk2(sg * x1.z, sg * x1.w);
      cm[ks] = __builtin_bit_cast(bf16x8, o);
    }
    const float dv = p.in[15][g * 16 + pl];
    u32x2 o;
    o.x = pk2((q4 * 4 + 0 == pl) ? dv : 0.f, (q4 * 4 + 1 == pl) ? dv : 0.f);
    o.y = pk2((q4 * 4 + 2 == pl) ? dv : 0.f, (q4 * 4 + 3 == pl) ? dv : 0.f);
    dmv = __builtin_bit_cast(bf16x4, o);
  }
  float hr[4], hi[4];
#pragma unroll
  for (int q = 0; q < 4; ++q) { hr[q] = 0.f; hi[q] = 0.f; }
  if (MODE == 1) {
    const float* Eb = E + ((size_t)(s * 32 + g) * 16) * 128;
#pragma unroll
    for (int bt = 0; bt < 3; ++bt) {
      if (bt * 5 < c) {
        float er[5][4], ei[5][4];
#pragma unroll
        for (int k = 0; k < 5; ++k)
#pragma unroll
          for (int q = 0; q < 4; ++q) { er[k][q] = Eb[(bt * 5 + k) * 128 + q * 16 + pl]; ei[k][q] = Eb[(bt * 5 + k) * 128 + 64 + q * 16 + pl]; }
#pragma unroll
        for (int k = 0; k < 5; ++k) {
          const bool on = (bt * 5 + k) < c;
#pragma unroll
          for (int q = 0; q < 4; ++q) {
            const float nr_ = a128r[q] * hr[q] - a128i[q] * hi[q] + er[k][q];
            const float ni_ = a128r[q] * hi[q] + a128i[q] * hr[q] + ei[k][q];
            hr[q] = on ? nr_ : hr[q]; hi[q] = on ? ni_ : hi[q];
          }
        }
      }
    }
  }
  if (MODE == 2) {
    const int b = s * 4 + q4;
#pragma unroll
    for (int q = 0; q < 4; ++q) {
      hr[q] = p.in[4][((size_t)b * 32 + g) * 64 + q * 16 + pl];
      hi[q] = p.in[5][((size_t)b * 32 + g) * 64 + q * 16 + pl];
    }
  }
  const bf16_t* up = P + (size_t)(R0 + pl) * PW + g * 16 + q4 * 4;
  bf16x4 uf_next = *(const bf16x4*)up;
#pragma unroll 2
  for (int tile = 0; tile < ntile; ++tile) {
    const int Rt = R0 + tile * 16;
    const bf16x4 uf = uf_next;
    if (tile + 1 < ntile) uf_next = *(const bf16x4*)(up + (size_t)(tile + 1) * 16 * PW);
    f32x4 xr[4], xi[4];
    const f32x4 z4 = f32x4{0.f, 0.f, 0.f, 0.f};
#pragma unroll
    for (int q = 0; q < 4; ++q) {
      xr[q] = __builtin_amdgcn_mfma_f32_16x16x16bf16_1k(uf, bb[q], z4, 0, 0, 0);
      xi[q] = __builtin_amdgcn_mfma_f32_16x16x16bf16_1k(uf, bb[q + 4], z4, 0, 0, 0);
    }
#pragma unroll
    for (int q = 0; q < 4; ++q) {
      float s0r = xr[q].x, s0i = xi[q].x, s1r = xr[q].y, s1i = xi[q].y, s2r = xr[q].z, s2i = xi[q].z, s3r = xr[q].w, s3i = xi[q].w;
      if (MODE == 2 || q4 == 0) CMUL_ACC(s0r, s0i, ar[q], ai[q], hr[q], hi[q]);
      CMUL_ACC(s1r, s1i, ar[q], ai[q], s0r, s0i);
      CMUL_ACC(s2r, s2i, ar[q], ai[q], s1r, s1i);
      CMUL_ACC(s3r, s3i, ar[q], ai[q], s2r, s2i);
      if (MODE != 2) {
        float Ir = s3r, Ii = s3i;
        float tr = __shfl_up(Ir, 16), ti = __shfl_up(Ii, 16);
        if (q4 >= 1) CMUL_ACC(Ir, Ii, a4r[q], a4i[q], tr, ti);
        tr = __shfl_up(Ir, 32); ti = __shfl_up(Ii, 32);
        if (q4 >= 2) CMUL_ACC(Ir, Ii, a8r[q], a8i[q], tr, ti);
        float cr = __shfl_up(Ir, 16), ci = __shfl_up(Ii, 16);
        if (q4 == 0) { cr = 0.f; ci = 0.f; }
        float t1r = ar[q] * cr - ai[q] * ci, t1i = ar[q] * ci + ai[q] * cr; s0r += t1r; s0i += t1i;
        float t2r = ar[q] * t1r - ai[q] * t1i, t2i = ar[q] * t1i + ai[q] * t1r; s1r += t2r; s1i += t2i;
        float t3r = ar[q] * t2r - ai[q] * t2i, t3i = ar[q] * t2i + ai[q] * t2r; s2r += t3r; s2i += t3i;
        float t4r = ar[q] * t3r - ai[q] * t3i, t4i = ar[q] * t3i + ai[q] * t3r; s3r += t4r; s3i += t4i;
        hr[q] = __shfl(s3r, 48 + pl); hi[q] = __shfl(s3i, 48 + pl);
      } else {
        hr[q] = s3r; hi[q] = s3i;
      }
      xr[q] = f32x4{s0r, s1r, s2r, s3r}; xi[q] = f32x4{s0i, s1i, s2i, s3i};
    }
    if (MODE != 0) {
#pragma unroll
      for (int q = 0; q < 4; ++q) {
        Hs[(q4 * 4 + 0) * 136 + q * 16 + pl] = f2bf(xr[q].x); Hs[(q4 * 4 + 1) * 136 + q * 16 + pl] = f2bf(xr[q].y);
        Hs[(q4 * 4 + 2) * 136 + q * 16 + pl] = f2bf(xr[q].z); Hs[(q4 * 4 + 3) * 136 + q * 16 + pl] = f2bf(xr[q].w);
        Hs[(q4 * 4 + 0) * 136 + 64 + q * 16 + pl] = f2bf(xi[q].x); Hs[(q4 * 4 + 1) * 136 + 64 + q * 16 + pl] = f2bf(xi[q].y);
        Hs[(q4 * 4 + 2) * 136 + 64 + q * 16 + pl] = f2bf(xi[q].z); Hs[(q4 * 4 + 3) * 136 + 64 + q * 16 + pl] = f2bf(xi[q].w);
      }
      asm volatile("s_waitcnt lgkmcnt(0)" ::: "memory");
      f32x4 y = z4;
#pragma unroll
      for (int ks = 0; ks < 4; ++ks) {
        const bf16x8 hf = *(const bf16x8*)(Hs + pl * 136 + ks * 32 + q4 * 8);
        y = __builtin_amdgcn_mfma_f32_16x16x32_bf16(hf, cm[ks], y, 0, 0, 0);
      }
      y = __builtin_amdgcn_mfma_f32_16x16x16bf16_1k(uf, dmv, y, 0, 0, 0);
      asm volatile("s_waitcnt lgkmcnt(0)" ::: "memory");
      bf16_t* GY = (bf16_t*)(ws + OFF_GY);
      bf16_t* dst = GY + (size_t)(Rt + q4 * 4) * 512 + g * 16 + pl;
      dst[0] = f2bf(gelu_tanh(y.x)); dst[512] = f2bf(gelu_tanh(y.y)); dst[1024] = f2bf(gelu_tanh(y.z)); dst[1536] = f2bf(gelu_tanh(y.w));
    }
  }
  if (MODE == 0) {
    if (q4 == 0) {
      float* Eb = E + ((size_t)(s * 32 + g) * 16 + c) * 128;
#pragma unroll
      for (int q = 0; q < 4; ++q) { Eb[q * 16 + pl] = hr[q]; Eb[64 + q * 16 + pl] = hi[q]; }
    }
  } else if (MODE == 1) {
    if (c == 15 && q4 == 0) {
#pragma unroll
      for (int q = 0; q < 4; ++q) {
        p.out[O_HRP + ((size_t)s * 32 + g) * 64 + q * 16 + pl] = hr[q];
        p.out[O_HIP + ((size_t)s * 32 + g) * 64 + q * 16 + pl] = hi[q];
      }
    }
  } else {
    const int b = s * 4 + q4;
#pragma unroll
    for (int q = 0; q < 4; ++q) {
      p.out[O_HRS + ((size_t)b * 32 + g) * 64 + q * 16 + pl] = hr[q];
      p.out[O_HIS + ((size_t)b * 32 + g) * 64 + q * 16 + pl] = hi[q];
    }
  }
}

__device__ __forceinline__ void scan_end_unit(const Params& p, int u, int lane) {
  unsigned char* ws = p.ws;
  const int pl = lane & 15, q4 = lane >> 4;
  const bf16_t* P = (const bf16_t*)(ws + OFF_P);
  const float* AR = (const float*)(ws + OFF_AR); const float* AI = (const float*)(ws + OFF_AI);
  const bf16_t* BB = (const bf16_t*)(ws + OFF_BB);
  float* E = (float*)(ws + OFF_E);
  const int c = u & 15, g = (u >> 4) & 31, s = u >> 9, R0 = s * 2048 + c * 128;
  float ar[4], ai[4], wr_[4], wi_[4], a16r[4], a16i[4];
#pragma unroll
  for (int q = 0; q < 4; ++q) {
    const float r1 = AR[g * 64 + q * 16 + pl], i1 = AI[g * 64 + q * 16 + pl];
    ar[q] = r1; ai[q] = i1;
    const float r2 = r1 * r1 - i1 * i1, i2 = 2.f * r1 * i1;
    const float r4 = r2 * r2 - i2 * i2, i4 = 2.f * r2 * i2;
    const float r8 = r4 * r4 - i4 * i4, i8 = 2.f * r4 * i4;
    const float r12 = r8 * r4 - i8 * i4, i12 = r8 * i4 + i8 * r4;
    a16r[q] = r8 * r8 - i8 * i8; a16i[q] = 2.f * r8 * i8;
    wr_[q] = (q4 == 0) ? r12 : (q4 == 1) ? r8 : (q4 == 2) ? r4 : 1.f;
    wi_[q] = (q4 == 0) ? i12 : (q4 == 1) ? i8 : (q4 == 2) ? i4 : 0.f;
  }
  bf16x4 bb[8];
#pragma unroll
  for (int pt = 0; pt < 8; ++pt) bb[pt] = *(const bf16x4*)(BB + ((size_t)g * 128 + pt * 16 + pl) * 16 + q4 * 4);
  float er[4], ei[4];
#pragma unroll
  for (int q = 0; q < 4; ++q) { er[q] = 0.f; ei[q] = 0.f; }
  const bf16_t* up = P + (size_t)(R0 + pl) * PW + g * 16 + q4 * 4;
  bf16x4 uf_next = *(const bf16x4*)up;
  const f32x4 z4 = f32x4{0.f, 0.f, 0.f, 0.f};
#pragma unroll 2
  for (int tile = 0; tile < 8; ++tile) {
    const bf16x4 uf = uf_next;
    if (tile + 1 < 8) uf_next = *(const bf16x4*)(up + (size_t)(tile + 1) * 16 * PW);
#pragma unroll
    for (int q = 0; q < 4; ++q) {
      const f32x4 xr = __builtin_amdgcn_mfma_f32_16x16x16bf16_1k(uf, bb[q], z4, 0, 0, 0);
      const f32x4 xi = __builtin_amdgcn_mfma_f32_16x16x16bf16_1k(uf, bb[q + 4], z4, 0, 0, 0);
      float tr = xr.x, ti = xi.x, nr_, ni_;
      nr_ = ar[q] * tr - ai[q] * ti + xr.y; ni_ = ar[q] * ti + ai[q] * tr + xi.y; tr = nr_; ti = ni_;
      nr_ = ar[q] * tr - ai[q] * ti + xr.z; ni_ = ar[q] * ti + ai[q] * tr + xi.z; tr = nr_; ti = ni_;
      nr_ = ar[q] * tr - ai[q] * ti + xr.w; ni_ = ar[q] * ti + ai[q] * tr + xi.w; tr = nr_; ti = ni_;
      float sr = wr_[q] * tr - wi_[q] * ti, si = wr_[q] * ti + wi_[q] * tr;
      sr += __shfl_xor(sr, 16); si += __shfl_xor(si, 16);
      sr += __shfl_xor(sr, 32); si += __shfl_xor(si, 32);
      nr_ = a16r[q] * er[q] - a16i[q] * ei[q] + sr; ni_ = a16r[q] * ei[q] + a16i[q] * er[q] + si;
      er[q] = nr_; ei[q] = ni_;
    }
  }
  if (q4 == 0) {
    float* Eb = E + ((size_t)(s * 32 + g) * 16 + c) * 128;
#pragma unroll
    for (int q = 0; q < 4; ++q) { Eb[q * 16 + pl] = er[q]; Eb[64 + q * 16 + pl] = ei[q]; }
  }
}

template <bool LDSRC>
__device__ __forceinline__ void attn_core(const Params& p, const int lane, const char* kptr, const int kstride, const char* vptr, const int vstride,
                                          const int kt0, const int has_prev, const int row_q, const int h_q, const int i_q) {
  unsigned char* ws = p.ws;
  const int pl = lane & 15, q4 = lane >> 4;
  const bf16_t* P = (const bf16_t*)(ws + OFF_P);
  const float sink = p.in[17][h_q];
  const bf16_t* qp = P + (size_t)row_q * PW + 512 + h_q * 64 + q4 * 8;
  const bf16x8 qf0 = *(const bf16x8*)qp, qf1 = *(const bf16x8*)(qp + 32);
  u32x4 vfr[LDSRC ? 1 : 5][4];
  if constexpr (!LDSRC) {
#pragma unroll
    for (int pp = 0; pp < 5; ++pp) {
      int TA = kt0 + 2 * pp, TB = kt0 + ((2 * pp + 1 < 9) ? 2 * pp + 1 : 2 * pp);
      if (!has_prev) { if (TA < 8) TA = 8; if (TB < 8) TB = 8; }
#pragma unroll
      for (int dt = 0; dt < 4; ++dt) {
        const char* vp = vptr + (dt * 16 + pl) * vstride + q4 * 8;
        const u32x2 va = *(const u32x2*)(vp + TA * 32), vb = *(const u32x2*)(vp + TB * 32);
        vfr[pp][dt] = u32x4{va.x, va.y, vb.x, vb.y};
      }
    }
  }
  f32x4 sa[9];
#pragma unroll
  for (int kt = 0; kt < 9; ++kt) {
    int T = kt0 + kt; if (!has_prev && T < 8) T = 8;
    const char* kp = kptr + (T * 16 + pl) * kstride + q4 * 16;
    bf16x8 k0, k1;
    if constexpr (LDSRC) { k0 = *(const LAS bf16x8*)(const LAS char*)kp; k1 = *(const LAS bf16x8*)(const LAS char*)(kp + 64); }
    else { k0 = *(const bf16x8*)kp; k1 = *(const bf16x8*)(kp + 64); }
    f32x4 a = f32x4{0.f, 0.f, 0.f, 0.f};
    a = __builtin_amdgcn_mfma_f32_16x16x32_bf16(k0, qf0, a, 0, 0, 0);
    a = __builtin_amdgcn_mfma_f32_16x16x32_bf16(k1, qf1, a, 0, 0, 0);
    sa[kt] = a;
  }
  const int lo = has_prev ? (i_q + 1) : ((i_q + 1) > 128 ? (i_q + 1) : 128);
  const unsigned span = (unsigned)(i_q + 128 - lo);
  const int dbase = q4 * 4 - lo;
  float mx = -INFINITY;
#pragma unroll
  for (int kt = 0; kt < 9; ++kt) {
#pragma unroll
    for (int r = 0; r < 4; ++r) {
      const int d = (kt0 + kt) * 16 + r + dbase;
      const float v = ((unsigned)d <= span) ? sa[kt][r] : -INFINITY;
      sa[kt][r] = v; mx = fmaxf(mx, v);
    }
  }
  mx = fmaxf(mx, __shfl_xor(mx, 16)); mx = fmaxf(mx, __shfl_xor(mx, 32));
  const float mfin = fmaxf(mx * 0.125f, sink);
  const float cl = 0.125f * 1.4426950408889634f, ml = mfin * 1.4426950408889634f;
  float sum = 0.f;
#pragma unroll
  for (int kt = 0; kt < 9; ++kt) {
#pragma unroll
    for (int r = 0; r < 4; ++r) { const float e = __builtin_amdgcn_exp2f(fmaf(sa[kt][r], cl, -ml)); sa[kt][r] = e; sum += e; }
  }
  sum += __shfl_xor(sum, 16); sum += __shfl_xor(sum, 32);
  const float inv = 1.f / (sum + __builtin_amdgcn_exp2f((sink - mfin) * 1.4426950408889634f));
  f32x4 oa[4];
#pragma unroll
  for (int dt = 0; dt < 4; ++dt) oa[dt] = f32x4{0.f, 0.f, 0.f, 0.f};
#pragma unroll
  for (int pp = 0; pp < 5; ++pp) {
    const int kA = 2 * pp, kB = (2 * pp + 1 < 9) ? 2 * pp + 1 : 2 * pp;
    u32x4 pw;
    pw.x = pk2(sa[kA][0] * inv, sa[kA][1] * inv); pw.y = pk2(sa[kA][2] * inv, sa[kA][3] * inv);
    if (2 * pp + 1 < 9) { pw.z = pk2(sa[kB][0] * inv, sa[kB][1] * inv); pw.w = pk2(sa[kB][2] * inv, sa[kB][3] * inv); }
    else { pw.z = 0u; pw.w = 0u; }
    const bf16x8 pf = __builtin_bit_cast(bf16x8, pw);
    if constexpr (LDSRC) {
      int TA = kt0 + 2 * pp, TB = kt0 + ((2 * pp + 1 < 9) ? 2 * pp + 1 : 2 * pp);
      if (!has_prev) { if (TA < 8) TA = 8; if (TB < 8) TB = 8; }
#pragma unroll
      for (int dt = 0; dt < 4; ++dt) {
        const char* vp = vptr + (dt * 16 + pl) * vstride + q4 * 8;
        const u32x2 va = *(const LAS u32x2*)(const LAS char*)(vp + TA * 32), vb = *(const LAS u32x2*)(const LAS char*)(vp + TB * 32);
        oa[dt] = __builtin_amdgcn_mfma_f32_16x16x32_bf16(__builtin_bit_cast(bf16x8, u32x4{va.x, va.y, vb.x, vb.y}), pf, oa[dt], 0, 0, 0);
      }
    } else {
#pragma unroll
      for (int dt = 0; dt < 4; ++dt) oa[dt] = __builtin_amdgcn_mfma_f32_16x16x32_bf16(__builtin_bit_cast(bf16x8, vfr[pp][dt]), pf, oa[dt], 0, 0, 0);
    }
  }
  bf16_t* O = (bf16_t*)(ws + OFF_O);
#pragma unroll
  for (int dt = 0; dt < 4; ++dt) *(u32x2*)(O + (size_t)row_q * 512 + h_q * 64 + dt * 16 + q4 * 4) = pk4(oa[dt]);
}

__device__ __forceinline__ void attn_sample_unit(const Params& p, int us, int lane) {
  const int pl = lane & 15, kv = us & 1, b = us >> 1, tt = pl >> 2, g = pl & 3;
  const bf16_t* Ks = (const bf16_t*)(p.ws + OFF_KS); const bf16_t* Vts = (const bf16_t*)(p.ws + OFF_VTS);
  attn_core<false>(p, lane, (const char*)(Ks + (size_t)b * 144 * 128 + kv * 64), 256, (const char*)(Vts + (size_t)(b * 2 + kv) * 64 * 144), 288,
                   0, 1, MP + b * 4 + tt, kv * 4 + g, tt);
}

constexpr int ATT_KSTR = 144, ATT_VSTR = 528, ATT_VOFF = 256 * ATT_KSTR;
__device__ __forceinline__ void attn_block_unit(const Params& p, int bu, char* lds, int tid) {
  const int b = bu >> 5, kv = (bu >> 4) & 1, blk = bu & 15, lane = tid & 63, wid = tid >> 6;
  const bf16_t* Kp = (const bf16_t*)(p.ws + OFF_KP); const bf16_t* Vtp = (const bf16_t*)(p.ws + OFF_VTP);
  char* K_l = lds; char* Vt_l = lds + ATT_VOFF;
  u32x4 kr[4], vr[4];
#pragma unroll
  for (int i = 0; i < 4; ++i) {
    const int piece = tid + i * NTHR, key = piece >> 3, c = piece & 7;
    if (blk > 0 || key >= 128) kr[i] = *(const u32x4*)(Kp + ((size_t)b * 2048 + (size_t)(blk - 1) * 128 + key) * 128 + kv * 64 + c * 8);
    const int d = piece >> 5, c2 = piece & 31;
    if (blk > 0 || c2 >= 16) vr[i] = *(const u32x4*)(Vtp + ((size_t)(b * 2 + kv) * 64 + d) * 2048 + (size_t)(blk - 1) * 128 + c2 * 8);
  }
#pragma unroll
  for (int i = 0; i < 4; ++i) {
    const int piece = tid + i * NTHR, key = piece >> 3, c = piece & 7;
    if (blk > 0 || key >= 128) *(u32x4*)(K_l + key * ATT_KSTR + c * 16) = kr[i];
    const int d = piece >> 5, c2 = piece & 31;
    if (blk > 0 || c2 >= 16) *(u32x4*)(Vt_l + d * ATT_VSTR + c2 * 16) = vr[i];
  }
  __syncthreads();
  const int pl = lane & 15;
#pragma unroll 1
  for (int g = 0; g < 4; ++g) {
    asm volatile("" ::: "memory");
    attn_core<true>(p, lane, K_l, ATT_KSTR, Vt_l, ATT_VSTR, wid, blk > 0, b * 2048 + blk * 128 + wid * 16 + pl, kv * 4 + g, wid * 16 + pl);
  }
  __syncthreads();
}

template <int WHICH, int NRW>
__device__ __forceinline__ void ln_rows(const Params& p, const int row0, const int lane, const f32x4 (&gv)[4], const f32x4 (&bv)[4]) {
  bf16_t* X1b = (bf16_t*)(p.ws + OFF_X1B);
  f32x4 v[NRW][4];
#pragma unroll
  for (int h = 0; h < NRW; ++h) {
    const int row = row0 + h;
    if (row < MP) {
      const bf16_t* xr = (const bf16_t*)(p.ws + (WHICH == 1 ? OFF_PRE1 : OFF_PRE2)) + (size_t)row * DM;
#pragma unroll
      for (int j = 0; j < 4; ++j) v[h][j] = unpk4(*(const u32x2*)(xr + j * 256 + lane * 4));
    } else {
      const float* SL = (const float*)(p.ws + (WHICH == 1 ? OFF_SLAB_WO : OFF_SLAB_DN)) + (size_t)(row - MP) * DM;
      constexpr int NS = (WHICH == 1) ? 8 : 11;
#pragma unroll
      for (int j = 0; j < 4; ++j) {
        f32x4 a;
        if (WHICH == 1) a = *(const f32x4*)(p.in[1] + (size_t)(row - MP) * DM + j * 256 + lane * 4) * ALPHA_F;
        else a = unpk4(*(const u32x2*)(X1b + (size_t)row * DM + j * 256 + lane * 4)) * ALPHA_F;
#pragma unroll
        for (int q = 0; q < NS; ++q) a += *(const f32x4*)(SL + (size_t)q * MS * DM + j * 256 + lane * 4);
        v[h][j] = a;
      }
    }
  }
  float s[NRW], s2[NRW];
#pragma unroll
  for (int h = 0; h < NRW; ++h) { s[h] = 0.f;
#pragma unroll
    for (int j = 0; j < 4; ++j) s[h] += (v[h][j].x + v[h][j].y) + (v[h][j].z + v[h][j].w); }
#pragma unroll
  for (int o = 1; o < 64; o <<= 1) {
#pragma unroll
    for (int h = 0; h < NRW; ++h) s[h] += __shfl_xor(s[h], o);
  }
#pragma unroll
  for (int h = 0; h < NRW; ++h) { const float mean = s[h] * (1.f / DM); s2[h] = 0.f;
#pragma unroll
    for (int j = 0; j < 4; ++j) { v[h][j] = v[h][j] - mean; s2[h] += (v[h][j].x * v[h][j].x + v[h][j].y * v[h][j].y) + (v[h][j].z * v[h][j].z + v[h][j].w * v[h][j].w); } }
#pragma unroll
  for (int o = 1; o < 64; o <<= 1) {
#pragma unroll
    for (int h = 0; h < NRW; ++h) s2[h] += __shfl_xor(s2[h], o);
  }
#pragma unroll
  for (int h = 0; h < NRW; ++h) {
    const int row = row0 + h;
    const float rstd = rsqrtf(s2[h] * (1.f / DM) + LN_EPS_F);
#pragma unroll
    for (int j = 0; j < 4; ++j) {
      const f32x4 o = v[h][j] * rstd * gv[j] + bv[j];
      if (WHICH == 1) *(u32x2*)(X1b + (size_t)row * DM + j * 256 + lane * 4) = pk4(o);
      else *(f32x4*)(p.out + (size_t)row * DM + j * 256 + lane * 4) = o;
    }
  }
}
template <int WHICH>
__device__ __forceinline__ void ln_phase(const Params& p) {
  const int lane = threadIdx.x & 63, wid = threadIdx.x >> 6;
  const int gw = blockIdx.x * NWAVE + wid, NGW = gridDim.x * NWAVE;
  const float* gam = p.in[WHICH == 1 ? 20 : 26]; const float* bet = p.in[WHICH == 1 ? 21 : 27];
  f32x4 gv[4], bv[4];
#pragma unroll
  for (int j = 0; j < 4; ++j) { gv[j] = *(const f32x4*)(gam + j * 256 + lane * 4); bv[j] = *(const f32x4*)(bet + j * 256 + lane * 4); }
  for (int rp = gw; rp < MP / 2; rp += NGW) ln_rows<WHICH, 2>(p, rp * 2, lane, gv, bv);
  for (int row = MP + gw; row < MT; row += NGW) ln_rows<WHICH, 1>(p, row, lane, gv, bv);
}

__device__ __forceinline__ void fixup_phase(const Params& p) {
  unsigned char* ws = p.ws;
  const int gt = blockIdx.x * NTHR + threadIdx.x, NGT = gridDim.x * NTHR;
  const float* HA0 = (const float*)(ws + OFF_HA0); const float* HG0 = (const float*)(ws + OFF_HG0); const float* HA1 = (const float*)(ws + OFF_HA1);
  bf16_t* H = (bf16_t*)(ws + OFF_H);
  constexpr int NJ4 = DFF / 4;
  for (int i = gt; i < NRB * 2 * NJ4; i += NGT) {
    const int j4 = i % NJ4, rl = (i / NJ4) & 1, rb = i / (2 * NJ4);
    if ((rb & 31) == 0) continue;
    const int j0 = j4 * 4;
    const f32x4 a0 = *(const f32x4*)(HA0 + ((size_t)rb * 2 + rl) * DFF + j0);
    const f32x4 g = *(const f32x4*)(HG0 + ((size_t)rb * 2 + rl) * DFF + j0);
    const f32x4 pm1 = *(const f32x4*)(HA1 + ((size_t)(rb - 1) * 2 + 1) * DFF + j0);
    const f32x4 pm2 = *(const f32x4*)(HA1 + ((size_t)(rb - 1) * 2 + 0) * DFF + j0);
    f32x4 am1, am2;
    if (rl == 0) { am1 = pm1; am2 = pm2; }
    else { am1 = *(const f32x4*)(HA0 + ((size_t)rb * 2 + 0) * DFF + j0); am2 = pm1; }
    const f32x4 w0 = *(const f32x4*)(p.in[23] + j0), w1 = *(const f32x4*)(p.in[23] + DFF + j0), w2 = *(const f32x4*)(p.in[23] + 2 * DFF + j0);
    const f32x4 cb = *(const f32x4*)(p.in[24] + j0);
    f32x4 h;
    h.x = gelu_tanh(cb.x + w0.x * am2.x + w1.x * am1.x + w2.x * a0.x) * g.x;
    h.y = gelu_tanh(cb.y + w0.y * am2.y + w1.y * am1.y + w2.y * a0.y) * g.y;
    h.z = gelu_tanh(cb.z + w0.z * am2.z + w1.z * am1.z + w2.z * a0.z) * g.z;
    h.w = gelu_tanh(cb.w + w0.w * am2.w + w1.w * am1.w + w2.w * a0.w) * g.w;
    *(u32x2*)(H + ((size_t)rb * 64 + rl) * DFF + j0) = pk4(h);
  }
}

#define XB_TMO      128
#define XB_XCNT(j)  (256  + 64 * (j))
#define XB_XSUB(j)  (1280 + 64 * (j))
#define XB_XGEN(j)  (2304 + 64 * (j))
#define XB_TOP      3328
#define XB_TOPGEN   3392
#define XCD_BAR_WORDS 3456
#define XB_SPIN_CAP (1u << 18)
__device__ __forceinline__ unsigned xb_ld(unsigned* p)              { return __hip_atomic_load(p, __ATOMIC_RELAXED, __HIP_MEMORY_SCOPE_AGENT); }
__device__ __forceinline__ unsigned xb_add(unsigned* p, unsigned v) { return __hip_atomic_fetch_add(p, v, __ATOMIC_RELAXED, __HIP_MEMORY_SCOPE_AGENT); }
__device__ __forceinline__ unsigned xb_xcc_id() { return (unsigned)__builtin_amdgcn_s_getreg((3 << 11) | 20) & 0xFu; }
#define XB_SPIN(cond, bar) do { unsigned _sp = 0; while (cond) { __builtin_amdgcn_s_sleep(1); \
    if ((++_sp & 255u) == 0u) { if (xb_ld(&(bar)[XB_TMO])) break; if (_sp > XB_SPIN_CAP) { atomicAdd(&(bar)[XB_TMO], 1u); break; } } } } while (0)
#define XB_EXIT 64
__device__ unsigned g_xbar[XCD_BAR_WORDS + 64];
struct XcdBarrier { unsigned* bar; unsigned x; volatile LAS unsigned* st; };
__device__ __forceinline__ XcdBarrier xcd_barrier_post(unsigned* bar, volatile LAS unsigned* st) {
    XcdBarrier b; b.bar = bar; b.x = xb_xcc_id(); b.st = st;
    if (threadIdx.x == 0) (void)xb_add(&bar[XB_XCNT(b.x)], 1u);
    return b;
}
__device__ __forceinline__ void xcd_barrier_complete(unsigned* bar, unsigned x, unsigned& nloc, unsigned& nx) {
    const unsigned G = gridDim.x * gridDim.y * gridDim.z;
    unsigned sum, cnt, mine, sp = 0u;
    for (;;) {
        sum = 0u; cnt = 0u; mine = 0u;
#pragma unroll
        for (unsigned j = 0; j < 16; ++j) { const unsigned c = xb_ld(&bar[XB_XCNT(j)]); sum += c; cnt += (c > 0u) ? 1u : 0u; mine = (j == x) ? c : mine; }
        if (sum == G) break;
        __builtin_amdgcn_s_sleep(1);
        if ((++sp & 255u) == 0u) { if (xb_ld(&bar[XB_TMO])) break; if (sp > XB_SPIN_CAP) { atomicAdd(&bar[XB_TMO], 1u); break; } }
    }
    nloc = mine > 0u ? mine : 1u; nx = cnt > 0u ? cnt : 1u;
}
__device__ __forceinline__ void xcd_barrier(const XcdBarrier& b) {
    asm volatile("s_waitcnt vmcnt(0)" ::: "memory");
    __syncthreads();
    if (threadIdx.x == 0) {
        unsigned* bar = b.bar;
        __builtin_amdgcn_s_waitcnt(0);
        unsigned nloc = b.st[0], nx = b.st[1];
        if (nloc == 0u) { xcd_barrier_complete(bar, b.x, nloc, nx); b.st[0] = nloc; b.st[1] = nx; }
        const unsigned old = xb_add(&bar[XB_XSUB(b.x)], 1u);
        const unsigned gen = old / nloc;
        if (old + 1u == (gen + 1u) * nloc) {
            __builtin_amdgcn_fence(__ATOMIC_RELEASE, "agent");
            asm volatile("s_waitcnt vmcnt(0)" ::: "memory");
            const unsigned og = xb_add(&bar[XB_TOP], 1u);
            const unsigned tg = og / nx;
            if (og + 1u == (tg + 1u) * nx) xb_add(&bar[XB_TOPGEN], 1u);
            else XB_SPIN(xb_ld(&bar[XB_TOPGEN]) == tg, bar);
            __builtin_amdgcn_fence(__ATOMIC_ACQUIRE, "agent");
            xb_add(&bar[XB_XGEN(b.x)], 1u);
            asm volatile("s_waitcnt vmcnt(0)" ::: "memory");
        } else {
            XB_SPIN(xb_ld(&bar[XB_XGEN(b.x)]) == gen, bar);
            __builtin_amdgcn_fence(__ATOMIC_ACQUIRE, "agent");
            asm volatile("s_waitcnt vmcnt(0)" ::: "memory");
        }
    }
    __syncthreads();
}
#define GSYNC() xcd_barrier(xb)

__device__ __forceinline__ void sample_merge(const Params& p) {
  unsigned char* ws = p.ws;
  const bf16_t* P = (const bf16_t*)(ws + OFF_P); bf16_t* Mg = (bf16_t*)(ws + OFF_MG);
  const float* SLG = (const float*)(ws + OFF_SLAB_GLU); const float* SLA = (const float*)(ws + OFF_SLAB_ATT);
  for (int i = blockIdx.x * NTHR + threadIdx.x; i < MS * (DM / 4); i += gridDim.x * NTHR) {
    const int r = i >> 8, j = (i & 255) * 4;
    const int tj = j >> 7, jl = j & 127, va = tj * 256 + ((jl >> 2) & 1) * 128 + (jl >> 5) * 32 + ((jl >> 3) & 3) * 4 + (jl & 3);
    f32x4 ya = f32x4{0.f, 0.f, 0.f, 0.f}, yb = ya, at = ya;
#pragma unroll
    for (int q = 0; q < 4; ++q) {
      ya += *(const f32x4*)(SLG + ((size_t)q * MS + r) * 2048 + va);
      yb += *(const f32x4*)(SLG + ((size_t)q * MS + r) * 2048 + va + 16);
      at += *(const f32x4*)(SLA + ((size_t)q * MS + r) * DM + j);
    }
    const size_t row = (size_t)MP + r;
    const f32x4 gs = unpk4(*(const u32x2*)(P + row * PW + 1024 + j)), ga = unpk4(*(const u32x2*)(P + row * PW + 2048 + j));
    f32x4 sv;
    sv.x = gs.x * ya.x * sigmoidf_(yb.x); sv.y = gs.y * ya.y * sigmoidf_(yb.y); sv.z = gs.z * ya.z * sigmoidf_(yb.z); sv.w = gs.w * ya.w * sigmoidf_(yb.w);
    sv = unpk4(pk4(sv));
    sv.x += ga.x * at.x; sv.y += ga.y * at.y; sv.z += ga.z * at.z; sv.w += ga.w * at.w;
    *(u32x2*)(Mg + row * DM + j) = pk4(sv);
  }
}

__global__ void __launch_bounds__(512) fwd_megakernel(Params p) {
  extern __shared__ __attribute__((aligned(16))) char lds[];
  volatile LAS unsigned* xst = (volatile LAS unsigned*)(lds + GEMM_LDS);
  if (threadIdx.x == 0) { xst[0] = 0u; xst[1] = 0u; }
  __syncthreads();
  XcdBarrier xb = xcd_barrier_post(g_xbar, xst);
  unsigned char* ws = p.ws;
  LAS unsigned char* glds = (LAS unsigned char*)lds;
  const int lane = threadIdx.x & 63, wid = threadIdx.x >> 6;
  const int gw = blockIdx.x * NWAVE + wid, NGW = gridDim.x * NWAVE;

  prep_phase(p, lds);
  GSYNC();
  gemm_phase<EPI_IN>(p, (const bf16_t*)(ws + OFF_B), (const bf16_t*)(ws + OFF_WIN), 1024, DIN, glds);
  GSYNC();
  {
    for (int bu = blockIdx.x; bu < 256; bu += gridDim.x) attn_block_unit(p, bu, lds, threadIdx.x);
    bf16_t* Hs = (bf16_t*)(lds + wid * 4352);
    constexpr int N_S1 = 8 * 32 * 16, N_SS = 32 * 32, N_AT = 256;
#pragma unroll 1
    for (int u = blockIdx.x * 16 + wid; u < 4096; u += ((u & 15) + NWAVE < 15) ? NWAVE : (gridDim.x * 16 - (u & 15) + wid)) {
      asm volatile("" ::: "memory");
      scan_end_unit(p, u, lane);
    }
    for (int i = gw; i < 2 * N_SS; i += NGW) { if ((i & 1) == 0) scan_unit<2>(p, i >> 1, lane, Hs); }
    for (int i = gw; i < 8 * N_AT; i += NGW) { if ((i & 7) == 1) attn_sample_unit(p, i >> 3, lane); }
    asm volatile("s_waitcnt vmcnt(0)" ::: "memory");
    __syncthreads();
#pragma unroll 1
    for (int u = blockIdx.x * 16 + wid; u < 4096; u += ((u & 15) + NWAVE < 16) ? NWAVE : (gridDim.x * 16 - (u & 15) + wid)) {
      asm volatile("" ::: "memory");
      scan_unit<1>(p, u, lane, Hs);
    }
  }
  GSYNC();
  gemm_phase<EPI_GLU>(p, (const bf16_t*)(ws + OFF_GY), (const bf16_t*)(ws + OFF_WGLU), 512, 2048, glds, (const bf16_t*)(ws + OFF_O), (const bf16_t*)(ws + OFF_WATT));
  GSYNC();
  gemm_phase<EPI_ATT>(p, (const bf16_t*)(ws + OFF_O), (const bf16_t*)(ws + OFF_WATT), 512, 1024, glds);
  sample_merge(p);
  GSYNC();
  gemm_phase<EPI_WO>(p, (const bf16_t*)(ws + OFF_MG), (const bf16_t*)(ws + OFF_WO), 1024, 1024, glds);
  GSYNC();
  ln_phase<1>(p);
  GSYNC();
  gemm_phase<EPI_UP>(p, (const bf16_t*)(ws + OFF_X1B), (const bf16_t*)(ws + OFF_WUP), 1024, 5632, glds);
  GSYNC();
  fixup_phase(p);
  GSYNC();
  gemm_phase<EPI_DOWN>(p, (const bf16_t*)(ws + OFF_H), (const bf16_t*)(ws + OFF_WDN), DFF, 1024, glds);
  GSYNC();
  ln_phase<2>(p);
  __syncthreads();
  if (threadIdx.x == 0) {
    unsigned* bar = g_xbar;
    const unsigned old = xb_add(&bar[XB_EXIT], 1u);
    if (old == gridDim.x - 1u) {
#pragma unroll
      for (int j = 0; j < 16; ++j) {
        __hip_atomic_store(&bar[XB_XCNT(j)], 0u, __ATOMIC_RELAXED, __HIP_MEMORY_SCOPE_AGENT);
        __hip_atomic_store(&bar[XB_XSUB(j)], 0u, __ATOMIC_RELAXED, __HIP_MEMORY_SCOPE_AGENT);
        __hip_atomic_store(&bar[XB_XGEN(j)], 0u, __ATOMIC_RELAXED, __HIP_MEMORY_SCOPE_AGENT);
      }
      __hip_atomic_store(&bar[XB_TOP], 0u, __ATOMIC_RELAXED, __HIP_MEMORY_SCOPE_AGENT);
      __hip_atomic_store(&bar[XB_TOPGEN], 0u, __ATOMIC_RELAXED, __HIP_MEMORY_SCOPE_AGENT);
      __hip_atomic_store(&bar[XB_TMO], 0u, __ATOMIC_RELAXED, __HIP_MEMORY_SCOPE_AGENT);
      __hip_atomic_store(&bar[XB_EXIT], 0u, __ATOMIC_RELAXED, __HIP_MEMORY_SCOPE_AGENT);
    }
  }
}

extern "C" void kernel_launch(void* const* d_in, const int* in_sizes, int n_in, void* d_out, int out_size, void* d_ws, size_t ws_size, hipStream_t stream) {
  static int grid_blocks = 0;
  if (grid_blocks == 0) {
    if (n_in != 28 || ws_size < WS_TOTAL) { fprintf(stderr, "kernel_launch: unexpected n_in %d or ws_size %zu (< %zu)\n", n_in, ws_size, (size_t)WS_TOTAL); grid_blocks = -1; return; }
    int dev = 0, cus = 0, per_cu = 0;
    (void)hipGetDevice(&dev);
    (void)hipDeviceGetAttribute(&cus, hipDeviceAttributeMultiprocessorCount, dev);
    (void)hipFuncSetAttribute((const void*)fwd_megakernel, hipFuncAttributeMaxDynamicSharedMemorySize, LDS_BYTES);
    (void)hipOccupancyMaxActiveBlocksPerMultiprocessor(&per_cu, (const void*)fwd_megakernel, NTHR, LDS_BYTES);
    if (per_cu < 1) { fprintf(stderr, "kernel_launch: occupancy query returned %d\n", per_cu); per_cu = 1; }
    if (per_cu > 1) per_cu = 1;
    grid_blocks = cus * per_cu;
    fprintf(stderr, "kernel_launch: cus %d per_cu %d grid %d\n", cus, per_cu, grid_blocks);
  }
  if (grid_blocks < 0) return;
  Params p{};
  for (int i = 0; i < 28; ++i) p.in[i] = (const float*)d_in[i];
  p.out = (float*)d_out; p.ws = (unsigned char*)d_ws;
  void* args[] = {&p};
  hipError_t e = hipLaunchCooperativeKernel((const void*)fwd_megakernel, dim3(grid_blocks), dim3(NTHR), args, LDS_BYTES, stream);
  if (e != hipSuccess) fprintf(stderr, "cooperative launch failed: %s (grid %d)\n", hipGetErrorString(e), grid_blocks);
}
```
